# Optimizing an MI355X kernel written in HIP

```python
import jax, jax.numpy as jnp
from jax import lax
import numpy as np

D_MODEL = 2048
BATCH = 8
SEQ = 4096
DEPTH = 2
DEC_BATCH = 4
DEC_SEQ = 4096
PAST_LEN = 128

MLA_HEADS = 8
QK_NOPE_DIM = 128
QK_ROPE_DIM = 64
V_HEAD_DIM = 128
Q_LORA_RANK = 512
KV_LORA_RANK = 256
ROPE_THETA = 10000.0
Q_BLOCK = 128
MLA_DIM = MLA_HEADS * V_HEAD_DIM
RWKV_HEADS = 16
RWKV_HEAD_DIM = 64
RWKV_DIM = RWKV_HEADS * RWKV_HEAD_DIM
DECAY_LORA = 64
ICLR_LORA = 64
GATE_LORA = 160
N_DIR = 2
RWKV_GN_EPS = 64e-5
D_FF = 5632
CONV_WIDTH = 3
N_BRANCH = 2
N_MOD = 6
NORM_EPS = 1e-6

MLA_IN = Q_LORA_RANK + KV_LORA_RANK + QK_ROPE_DIM
RWKV_IN = 3 * RWKV_DIM + N_DIR * DECAY_LORA + N_DIR * ICLR_LORA + GATE_LORA
D_IN = MLA_IN + RWKV_IN + N_BRANCH * D_MODEL
IN_OFFSETS = (Q_LORA_RANK, Q_LORA_RANK + KV_LORA_RANK, MLA_IN, MLA_IN + RWKV_IN)
RW_OFFSETS = (RWKV_DIM, 2 * RWKV_DIM, 3 * RWKV_DIM, 3 * RWKV_DIM + N_DIR * DECAY_LORA,
              3 * RWKV_DIM + N_DIR * (DECAY_LORA + ICLR_LORA))

kernel_name = "hybrid_mla_rwkv7_bidir_encoder"


def _rmsnorm(x, g):
    xf = x.astype(jnp.float32)
    y = xf * lax.rsqrt(jnp.mean(xf * xf, axis=-1, keepdims=True) + NORM_EPS)
    return (y * g.astype(jnp.float32)).astype(x.dtype)


def _rope_tables(seq_len, dtype):
    inv = 1.0 / (ROPE_THETA ** (jnp.arange(0, QK_ROPE_DIM, 2, dtype=jnp.float32) / QK_ROPE_DIM))
    ang = jnp.arange(seq_len, dtype=jnp.float32)[:, None] * inv[None, :]
    return jnp.cos(ang).astype(dtype), jnp.sin(ang).astype(dtype)


def _rope(x, cos, sin):
    x1, x2 = jnp.split(x, 2, axis=-1)
    return jnp.concatenate([x1 * cos - x2 * sin, x2 * cos + x1 * sin], axis=-1)


def _shift_centered(x):
    xp = jnp.pad(x, ((0, 0), (1, 1), (0, 0)))
    return xp[:, :-2], xp[:, 2:]


def _mla_branch(q_down, kv_down, k_rope, cos, sin, q_norm_g, w_uq, kv_norm_g, w_ukv, w_o_att):
    B, S, _ = q_down.shape
    q = (_rmsnorm(q_down, q_norm_g) @ w_uq).reshape(B, S, MLA_HEADS, QK_NOPE_DIM + QK_ROPE_DIM)
    q_nope, q_rope = q[..., :QK_NOPE_DIM], q[..., QK_NOPE_DIM:]
    q_rope = _rope(q_rope, cos[:, None, :], sin[:, None, :])
    kv = (_rmsnorm(kv_down, kv_norm_g) @ w_ukv).reshape(B, S, MLA_HEADS, QK_NOPE_DIM + V_HEAD_DIM)
    k_nope, v = kv[..., :QK_NOPE_DIM], kv[..., QK_NOPE_DIM:]
    k_rope = _rope(k_rope, cos, sin)
    scale = (QK_NOPE_DIM + QK_ROPE_DIM) ** -0.5
    nb = S // Q_BLOCK
    qn_blocks = q_nope.reshape(B, nb, Q_BLOCK, MLA_HEADS, QK_NOPE_DIM).swapaxes(0, 1)
    qr_blocks = q_rope.reshape(B, nb, Q_BLOCK, MLA_HEADS, QK_ROPE_DIM).swapaxes(0, 1)

    def attend(blk):
        qn, qr = blk
        s = (jnp.einsum('bqhd,bkhd->bhqk', qn, k_nope, preferred_element_type=jnp.float32)
             + jnp.einsum('bqhr,bkr->bhqk', qr, k_rope, preferred_element_type=jnp.float32))
        p = jax.nn.softmax(s * scale, axis=-1).astype(v.dtype)
        return jnp.einsum('bhqk,bkhd->bqhd', p, v)

    o = lax.map(attend, (qn_blocks, qr_blocks))
    o = o.swapaxes(0, 1).reshape(B, S, MLA_DIM)
    return o @ w_o_att


def _orient(t):
    return jnp.concatenate([t[:1], jnp.flip(t[1:], axis=2)], axis=0)


def _rwkv7_step(state, inp):
    r_t, w_t, k_t, v_t, kk_t, a_t = inp
    s_kk = jnp.einsum('dbhvk,dbhk->dbhv', state, kk_t)
    state = (state * w_t[..., None, :]
             - s_kk[..., None] * (kk_t * a_t)[..., None, :]
             + v_t[..., None] * k_t[..., None, :])
    return state, jnp.einsum('dbhvk,dbhk->dbhv', state, r_t)


def _rwkv7_branch(p, mu, w0, w_decay_up, a0, w_iclr_up, w_gate_up, k_k, k_a, r_k, gn_g, gn_b, w_o_rwkv):
    f32 = jnp.float32
    B, S, _ = p.shape
    H, N = RWKV_HEADS, RWKV_HEAD_DIM
    p_prev, p_next = _shift_centered(p)
    p = p + mu[0] * (p_prev - p) + mu[1] * (p_next - p)
    r, k, v, wd, ad, gd = jnp.split(p.astype(f32), RW_OFFSETS, axis=-1)
    wd = wd.reshape(B, S, N_DIR, DECAY_LORA)
    ad = ad.reshape(B, S, N_DIR, ICLR_LORA)
    w_raw = w0[:, None, None, :] + jnp.einsum('bsdl,dlc->dbsc', jnp.tanh(wd), w_decay_up.astype(f32))
    decay = jnp.exp(-jnp.exp(-jax.nn.softplus(-w_raw) - 0.5))
    a = jax.nn.sigmoid(a0[:, None, None, :] + jnp.einsum('bsdl,dlc->dbsc', ad, w_iclr_up.astype(f32)))
    g = jax.nn.sigmoid(gd) @ w_gate_up.astype(f32)
    kk = (k * k_k).reshape(B, S, H, N)
    kk = kk / jnp.maximum(jnp.linalg.norm(kk, axis=-1, keepdims=True), 1e-12)
    k_dir = k[None] * (1.0 + (a - 1.0) * k_a)
    rh, vh = r.reshape(B, S, H, N), v.reshape(B, S, H, N)
    heads = lambda t: t.reshape(N_DIR, B, S, H, N)
    both = lambda t: jnp.stack([t, t], axis=0)
    xs = tuple(jnp.moveaxis(_orient(t), 2, 0) for t in
               (both(rh), heads(decay), heads(k_dir), both(vh), both(kk), heads(a)))
    state0 = jnp.zeros((N_DIR, B, H, N, N), f32)
    _, o = lax.scan(_rwkv7_step, state0, xs)
    o = _orient(jnp.moveaxis(o, 0, 2))
    o = o[0] + o[1]
    mean = jnp.mean(o, axis=-1, keepdims=True)
    var = jnp.mean(jnp.square(o - mean), axis=-1, keepdims=True)
    o = ((o - mean) * lax.rsqrt(var + RWKV_GN_EPS)).reshape(B, S, RWKV_DIM) * gn_g + gn_b
    bonus = jnp.einsum('bshn,dbshn,dhn->bsh', rh, heads(k_dir), r_k.astype(f32))[..., None] * vh
    o = (o + bonus.reshape(B, S, RWKV_DIM)) * g
    return o.astype(p.dtype) @ w_o_rwkv


def _conv_ffn(h, w_up, conv_w, conv_b, w_down):
    a, b = jnp.split(h @ w_up, 2, axis=-1)
    a_prev, a_next = _shift_centered(a)
    a = a_prev * conv_w[0] + a * conv_w[1] + a_next * conv_w[2] + conv_b
    return (jax.nn.silu(a) * b) @ w_down


def _layer(x, c, cos, sin, l, P):
    mod = jax.nn.silu(c) @ P['ada_w'][l] + P['ada_b'][l]
    sh1, sc1, gt1, sh2, sc2, gt2 = jnp.split(mod[:, None, :], N_MOD, axis=-1)
    h = _rmsnorm(x, P['norm_mix_g'][l]) * (1.0 + sc1) + sh1
    proj = h @ P['w_in'][l]
    q_down, kv_down, k_rope, rw, gates = jnp.split(proj, IN_OFFSETS, axis=-1)
    att = _mla_branch(q_down, kv_down, k_rope, cos, sin, P['q_norm_g'][l], P['w_uq'][l],
                      P['kv_norm_g'][l], P['w_ukv'][l], P['w_o_att'][l])
    rwk = _rwkv7_branch(rw, P['rwkv_mu'][l], P['rwkv_w0'][l], P['rwkv_w_decay_up'][l], P['rwkv_a0'][l],
                        P['rwkv_w_iclr_up'][l], P['rwkv_w_gate_up'][l], P['rwkv_k_k'][l], P['rwkv_k_a'][l],
                        P['rwkv_r_k'][l], P['rwkv_gn_g'][l], P['rwkv_gn_b'][l], P['w_o_rwkv'][l])
    g_att, g_rwk = jnp.split(jax.nn.sigmoid(gates), N_BRANCH, axis=-1)
    mixed = (g_att * att + g_rwk * rwk) @ P['w_out'][l]
    x = x + gt1 * mixed
    h = _rmsnorm(x, P['norm_ffn_g'][l]) * (1.0 + sc2) + sh2
    x = x + gt2 * _conv_ffn(h, P['w_ffn_up'][l], P['conv_w'][l], P['conv_b'][l], P['w_ffn_down'][l])
    return x


def _trunk(x, c, P):
    cos, sin = _rope_tables(x.shape[1], x.dtype)
    for l in range(DEPTH):
        x = _layer(x, c, cos, sin, l, P)
    return _rmsnorm(x, P['final_norm_g'])


def setup_inputs(seed: int = 0) -> dict:
    key = jax.random.key(seed)
    ks = jax.random.split(key, 32)
    nrm = lambda k, shape, s: jax.random.normal(k, shape, jnp.float32) * s
    gain = lambda k, shape: 1.0 + 0.02 * jax.random.normal(k, shape, jnp.float32)
    L = DEPTH
    conv_w = nrm(ks[27], (L, CONV_WIDTH, D_FF), 0.3).at[:, 1].add(1.0)
    return {
        'x_prompt': nrm(ks[0], (BATCH, SEQ, D_MODEL), 1.0),
        'x_sample': nrm(ks[1], (DEC_BATCH, DEC_SEQ, D_MODEL), 1.0),
        'c_prompt': nrm(ks[2], (BATCH, D_MODEL), 1.0),
        'c_sample': nrm(ks[3], (DEC_BATCH, D_MODEL), 1.0),
        'ada_w': nrm(ks[4], (L, D_MODEL, N_MOD * D_MODEL), 0.5 * D_MODEL ** -0.5),
        'ada_b': nrm(ks[5], (L, N_MOD * D_MODEL), 0.02),
        'norm_mix_g': gain(ks[6], (L, D_MODEL)),
        'w_in': nrm(ks[7], (L, D_MODEL, D_IN), D_MODEL ** -0.5),
        'q_norm_g': gain(ks[8], (L, Q_LORA_RANK)),
        'w_uq': nrm(ks[9], (L, Q_LORA_RANK, MLA_HEADS * (QK_NOPE_DIM + QK_ROPE_DIM)), Q_LORA_RANK ** -0.5),
        'kv_norm_g': gain(ks[10], (L, KV_LORA_RANK)),
        'w_ukv': nrm(ks[11], (L, KV_LORA_RANK, MLA_HEADS * (QK_NOPE_DIM + V_HEAD_DIM)), KV_LORA_RANK ** -0.5),
        'w_o_att': nrm(ks[12], (L, MLA_DIM, D_MODEL), MLA_DIM ** -0.5),
        'rwkv_mu': jax.random.uniform(ks[13], (L, 2, RWKV_IN), jnp.float32, 0.0, 0.5),
        'rwkv_w0': jax.random.uniform(ks[14], (L, N_DIR, RWKV_DIM), jnp.float32, -6.0, -1.0),
        'rwkv_w_decay_up': nrm(ks[15], (L, N_DIR, DECAY_LORA, RWKV_DIM), 0.1 * DECAY_LORA ** -0.5),
        'rwkv_a0': nrm(ks[16], (L, N_DIR, RWKV_DIM), 0.5),
        'rwkv_w_iclr_up': nrm(ks[17], (L, N_DIR, ICLR_LORA, RWKV_DIM), ICLR_LORA ** -0.5),
        'rwkv_w_gate_up': nrm(ks[18], (L, GATE_LORA, RWKV_DIM), GATE_LORA ** -0.5),
        'rwkv_k_k': 0.85 + nrm(ks[19], (L, RWKV_DIM), 0.05),
        'rwkv_k_a': gain(ks[20], (L, RWKV_DIM)),
        'rwkv_r_k': nrm(ks[21], (L, N_DIR, RWKV_HEADS, RWKV_HEAD_DIM), 0.1),
        'rwkv_gn_g': gain(ks[22], (L, RWKV_DIM)),
        'rwkv_gn_b': nrm(ks[23], (L, RWKV_DIM), 0.02),
        'w_o_rwkv': nrm(ks[24], (L, RWKV_DIM, D_MODEL), RWKV_DIM ** -0.5),
        'w_out': nrm(ks[25], (L, D_MODEL, D_MODEL), D_MODEL ** -0.5),
        'norm_ffn_g': gain(ks[26], (L, D_MODEL)),
        'w_ffn_up': nrm(ks[28], (L, D_MODEL, 2 * D_FF), D_MODEL ** -0.5),
        'conv_w': conv_w,
        'conv_b': nrm(ks[29], (L, D_FF), 0.02),
        'w_ffn_down': nrm(ks[30], (L, D_FF, D_MODEL), D_FF ** -0.5),
        'final_norm_g': gain(ks[31], (D_MODEL,)),
    }


def reference(x_prompt, x_sample, c_prompt, c_sample, ada_w, ada_b, norm_mix_g, w_in, q_norm_g, w_uq,
              kv_norm_g, w_ukv, w_o_att, rwkv_mu, rwkv_w0, rwkv_w_decay_up, rwkv_a0, rwkv_w_iclr_up,
              rwkv_w_gate_up, rwkv_k_k, rwkv_k_a, rwkv_r_k, rwkv_gn_g, rwkv_gn_b, w_o_rwkv, w_out,
              norm_ffn_g, w_ffn_up, conv_w, conv_b, w_ffn_down, final_norm_g):
    P = dict(ada_w=ada_w, ada_b=ada_b, norm_mix_g=norm_mix_g, w_in=w_in, q_norm_g=q_norm_g, w_uq=w_uq,
             kv_norm_g=kv_norm_g, w_ukv=w_ukv, w_o_att=w_o_att, rwkv_mu=rwkv_mu, rwkv_w0=rwkv_w0,
             rwkv_w_decay_up=rwkv_w_decay_up, rwkv_a0=rwkv_a0, rwkv_w_iclr_up=rwkv_w_iclr_up,
             rwkv_w_gate_up=rwkv_w_gate_up, rwkv_k_k=rwkv_k_k, rwkv_k_a=rwkv_k_a, rwkv_r_k=rwkv_r_k,
             rwkv_gn_g=rwkv_gn_g, rwkv_gn_b=rwkv_gn_b, w_o_rwkv=w_o_rwkv, w_out=w_out,
             norm_ffn_g=norm_ffn_g, w_ffn_up=w_ffn_up, conv_w=conv_w, conv_b=conv_b,
             w_ffn_down=w_ffn_down, final_norm_g=final_norm_g)
    y_prompt = _trunk(x_prompt, c_prompt, P)
    y_sample = _trunk(x_sample, c_sample, P)
    return (y_prompt, y_sample)
```

```cpp
#include <hip/hip_runtime.h>
#include <cstdio>
#include <cstdint>

#ifndef MK_MODE
#define MK_MODE 1
#endif

#ifndef ONLY
#define ONLY -1
#endif
#ifndef PROBE_MASK
#define PROBE_MASK 0
#endif
#define REPEAT(k) _Pragma("unroll") for (int rep_ = 0; rep_ < (((PROBE_MASK >> (k)) & 1) ? 2 : 1); ++rep_)
#define EN(k) (ONLY < 0 || ONLY == (k))
#define LAS __attribute__((address_space(3)))
#define GAS __attribute__((address_space(1)))
typedef unsigned short bf16;
typedef short bf16x8 __attribute__((ext_vector_type(8)));
typedef short s16x4 __attribute__((ext_vector_type(4)));
typedef float f32x4 __attribute__((ext_vector_type(4)));
typedef float f32x2 __attribute__((ext_vector_type(2)));
typedef float f32x16 __attribute__((ext_vector_type(16)));
typedef unsigned u32x4 __attribute__((ext_vector_type(4)));
typedef unsigned u32x2 __attribute__((ext_vector_type(2)));
typedef GAS unsigned gu32;

constexpr int DM = 2048, NSEQ = 12, SEQ = 4096, MALL = NSEQ * SEQ;
constexpr int NLAYER = 2;
constexpr int GROWS = 16384, NGRP = MALL / GROWS;
constexpr int DIN = 8416, W_MLA = 832, W_RW = 3520, W_GATE = 4096, NPROJ = W_MLA + W_RW + W_GATE;
constexpr int RWIN = 3488;
constexpr int DFF = 5632;
constexpr int NMOD = 6 * DM;
constexpr int QW = 1536, KFW = 1536, VW = 1024;
constexpr int LORA_K = 512, LORA_N = 5120, LORA_KB = 256;
constexpr int NWAVES = 8;

constexpr size_t MiB = 1u << 20;
constexpr size_t WS_CTL = 0, CTL_ZERO_BYTES = 3 * MiB;
constexpr size_t WS_MOD = 1 * MiB;
constexpr size_t WS_ROPE = 3 * MiB;
constexpr size_t WS_RSTD = 4 * MiB;
constexpr size_t WS_BONUS = 5 * MiB;
constexpr size_t WS_W = 8 * MiB;
constexpr size_t WO_IN = 0, WO_UQ = WO_IN + (size_t)NPROJ * DM * 2, WO_UKV = WO_UQ + (size_t)QW * 512 * 2, WO_OATT = WO_UKV + (size_t)2048 * 256 * 2,
                 WO_ORWKV = WO_OATT + (size_t)DM * 1024 * 2, WO_OUT = WO_ORWKV + (size_t)DM * 1024 * 2, WO_UP = WO_OUT + (size_t)DM * DM * 2,
                 WO_DOWN = WO_UP + (size_t)2 * DFF * DM * 2, WO_LORA = WO_DOWN + (size_t)DM * DFF * 2, WO_END = WO_LORA + (size_t)LORA_N * LORA_K * 2;
static_assert(WO_END <= 124 * MiB, "weights");
constexpr size_t WS_A = 132 * MiB;
constexpr size_t A_H = WS_A;
constexpr size_t A_PMLA = WS_A + 64 * MiB;
constexpr size_t A_PGATE = A_PMLA + 32 * MiB;
constexpr size_t A_PRW = A_PGATE + 128 * MiB;
constexpr size_t A_RKVKK = A_PRW + 112 * MiB;
constexpr size_t A_OF = A_RKVKK;
constexpr size_t A_OB = A_RKVKK + 32 * MiB;
constexpr size_t A_RWKVO = A_RKVKK + 64 * MiB;
constexpr size_t A_ALORA = A_RKVKK + 96 * MiB;
constexpr size_t A_MERGED = A_RKVKK;
constexpr size_t A_LORAOUT = A_RKVKK + 128 * MiB;
constexpr size_t A_Q = A_LORAOUT + 160 * MiB;
constexpr size_t A_KF = A_Q + 48 * MiB;
constexpr size_t A_V = A_KF + 48 * MiB;
constexpr size_t A_ATTO = A_V + 32 * MiB;
constexpr size_t A_TM_END = A_ATTO + 32 * MiB;
constexpr size_t A_MID = WS_A + 64 * MiB;
constexpr size_t A_EA = A_MID;
constexpr size_t A_EB = A_MID + 16 * MiB;
constexpr size_t A_ACT = A_MID + 352 * MiB;
constexpr size_t A_H2 = A_ACT + 176 * MiB;
constexpr size_t A_FF_END = A_H2 + 64 * MiB;
constexpr size_t WS_NEED = (A_TM_END > A_FF_END ? A_TM_END : A_FF_END);
static_assert(WS_NEED <= 1000 * MiB, "workspace map");

constexpr int CW_BAR = 4096;

constexpr int RING_BYTES = 131072, LDSCTL_OFF = RING_BYTES, MISC_OFF = LDSCTL_OFF + 320, LDS_BYTES = 147456;

#define LDS_WAIT() asm volatile("s_waitcnt lgkmcnt(0)" ::: "memory")
#define VM_WAIT() asm volatile("s_waitcnt vmcnt(0)" ::: "memory")
typedef __bf16 bf16x2_t __attribute__((ext_vector_type(2)));
__device__ __forceinline__ unsigned cvt_pk_bf16(float lo, float hi) { const f32x2 v = {lo, hi}; const bf16x2_t b = __builtin_convertvector(v, bf16x2_t); return __builtin_bit_cast(unsigned, b); }
__device__ __forceinline__ float bf_lo(unsigned w) { return __uint_as_float(w << 16); }
__device__ __forceinline__ float bf_hi(unsigned w) { return __uint_as_float(w & 0xffff0000u); }
__device__ __forceinline__ void unpack8(const u32x4 w, float (&f)[8]) { f[0] = bf_lo(w.x); f[1] = bf_hi(w.x); f[2] = bf_lo(w.y); f[3] = bf_hi(w.y); f[4] = bf_lo(w.z); f[5] = bf_hi(w.z); f[6] = bf_lo(w.w); f[7] = bf_hi(w.w); }
__device__ __forceinline__ void load8(const bf16* p, float (&f)[8]) { unpack8(*(const u32x4*)p, f); }
__device__ __forceinline__ u32x4 pack8(const float (&f)[8]) { u32x4 w; w.x = cvt_pk_bf16(f[0], f[1]); w.y = cvt_pk_bf16(f[2], f[3]); w.z = cvt_pk_bf16(f[4], f[5]); w.w = cvt_pk_bf16(f[6], f[7]); return w; }
__device__ __forceinline__ void store8(bf16* p, const float (&f)[8]) { *(u32x4*)p = pack8(f); }
__device__ __forceinline__ float sigmoidf_(float x) { return __builtin_amdgcn_rcpf(1.f + __expf(-x)); }
__device__ __forceinline__ float sigmoid_div(float x) { return 1.f / (1.f + __expf(-x)); }
__device__ __forceinline__ float wave_sum(float v) {
#pragma unroll
    for (int o = 1; o < 64; o <<= 1) v += __shfl_xor(v, o);
    return v;
}
__device__ __forceinline__ float reduce8(float x) {
    x += __builtin_bit_cast(float, __builtin_amdgcn_update_dpp(0, __builtin_bit_cast(int, x), 0xB1, 0xF, 0xF, true));
    x += __builtin_bit_cast(float, __builtin_amdgcn_update_dpp(0, __builtin_bit_cast(int, x), 0x4E, 0xF, 0xF, true));
    x += __builtin_bit_cast(float, __builtin_amdgcn_update_dpp(0, __builtin_bit_cast(int, x), 0x141, 0xF, 0xF, true));
    return x;
}

namespace pg8 {
constexpr int BM = 256, BK = 64, HALF = 128, HTB = HALF * BK * 2, STAGE_BYTES = 8 * HTB, NXCD = 8, WGM = 4;
__host__ __device__ __forceinline__ int lds_byte(int r, int c) { const int st = (r >> 4) * 2 + (c >> 5), rr = r & 15, cc = c & 31, ob = rr * 64 + cc * 2; return st * 1024 + (ob ^ (((ob >> 9) & 1) << 5)); }
__host__ __device__ __forceinline__ void stage_rc(int b, int& R, int& C) { const int st = b / 1024, sb = b % 1024, swz = sb ^ (((sb >> 9) & 1) << 5); R = (st >> 1) * 16 + swz / 64; C = (st & 1) * 32 + (swz % 64) / 2; }
__host__ __device__ __forceinline__ int perm32(int rho) { const int n = rho >> 4, i = rho & 15; return 8 * (i >> 2) + 4 * n + (i & 3); }
struct Unit { int pm, pn; };
struct Gemm { const bf16* A; const bf16* Bt; int M, N, K, lda, ldb; };
struct StaticOrder {
    int nM, nN, nwg, G, c;
    __host__ __device__ void init(int M, int N, int G_, int c_) { nM = M / BM; nN = N / BM; nwg = nM * nN; G = G_; c = c_; }
    __host__ __device__ bool next(int i, Unit& u) const {
        const long L = (long)i * G + c; if (L >= nwg) return false;
        int wgid = (int)L; { const int q = nwg / NXCD, r = nwg % NXCD, xcd = wgid % NXCD, off = wgid / NXCD; wgid = (xcd < r ? xcd * (q + 1) : r * (q + 1) + (xcd - r) * q) + off; }
        const int nig = WGM * nN, gid = wgid / nig, fm = gid * WGM, gsz = (nM - fm) < WGM ? (nM - fm) : WGM;
        u.pm = fm + ((wgid % nig) % gsz); u.pn = (wgid % nig) / gsz; return true;
    }
    __device__ __forceinline__ void a_ready(const Unit&) const {}
    __device__ __forceinline__ void done(const Unit&) const {}
};
template <int N0, int N1, int N2> struct SkewOrder {
    int nM, nN, nwg, G, c;
    __host__ __device__ void init(int M, int N, int G_, int c_) { nM = M / BM; nN = N / BM; nwg = nM * nN; G = G_; c = c_; }
    __host__ __device__ bool next(int i, Unit& u) const {
        long L;
        if (G == 256 && nwg == 128 * N0 + 64 * N1 + 64 * N2) {
            if (c < 128) { if (i >= N0) return false; L = i * 128 + c; }
            else if (c < 192) { if (i >= N1) return false; L = N0 * 128 + i * 64 + (c - 128); }
            else { if (i >= N2) return false; L = N0 * 128 + N1 * 64 + i * 64 + (c - 192); }
        } else { L = (long)i * G + c; if (L >= nwg) return false; }
        int wgid = (int)L; { const int q = nwg / NXCD, r = nwg % NXCD, xcd = wgid % NXCD, off = wgid / NXCD; wgid = (xcd < r ? xcd * (q + 1) : r * (q + 1) + (xcd - r) * q) + off; }
        const int nig = WGM * nN, gid = wgid / nig, fm = gid * WGM, gsz = (nM - fm) < WGM ? (nM - fm) : WGM;
        u.pm = fm + ((wgid % nig) % gsz); u.pn = (wgid % nig) / gsz; return true;
    }
    __device__ __forceinline__ void a_ready(const Unit&) const {}
    __device__ __forceinline__ void done(const Unit&) const {}
};
template <class F> struct EpiG {
    static constexpr bool PERM = true, AFTER_DRAIN = false;
    F f;
    __device__ __forceinline__ void operator()(const f32x4 (&acc)[2][2][4][2], const Unit& u, int wr, int wc, int fr, int fq) const {
        const int row0 = u.pm * BM + wr * 64 + fr, col0 = u.pn * BM + wc * 32 + 8 * fq;
#pragma unroll
        for (int ai = 0; ai < 2; ++ai)
#pragma unroll
            for (int m = 0; m < 4; ++m) {
                const int row = row0 + ai * HALF + m * 16;
#pragma unroll
                for (int bj = 0; bj < 2; ++bj) {
                    float v[8]; const f32x4 a0 = acc[ai][bj][m][0], a1 = acc[ai][bj][m][1];
                    v[0] = a0[0]; v[1] = a0[1]; v[2] = a0[2]; v[3] = a0[3]; v[4] = a1[0]; v[5] = a1[1]; v[6] = a1[2]; v[7] = a1[3];
                    f(row, col0 + bj * HALF, v);
                }
                asm volatile("" ::: "memory");
            }
    }
};

template <class Epi, class Sched, bool ALIGN_EPI = false, bool SP2 = false, bool PERMA = false>
__device__ __forceinline__ void gemm_phase(LAS unsigned char* lds, const Gemm g, const Sched& S, const Epi& E) {
    const int tid = threadIdx.x, wid = __builtin_amdgcn_readfirstlane(tid >> 6), lane = tid & 63, wr = wid >> 2, wc = wid & 3, fr = lane & 15, fq = lane >> 4;
    const int K = g.K, nt = K / BK;
    unsigned voffA[2], voffB[2];
#pragma unroll
    for (int i = 0; i < 2; ++i) { int R, C; stage_rc(tid * 16 + i * 8192, R, C); const int Rb = Epi::PERM ? ((R & ~31) + perm32(R & 31)) : R;
        const int Ra = PERMA ? ((R & 64) | ((R & 15) << 2) | ((R >> 4) & 3)) : R;
        voffA[i] = (unsigned)(Ra * g.lda + C) * 2u; voffB[i] = (unsigned)(Rb * g.ldb + C) * 2u; }
    const size_t kstep = (size_t)(BK * 2);
    const size_t hstepA = (size_t)HALF * g.lda * 2, hstepB = (size_t)HALF * g.ldb * 2;
    const size_t tstepA = 2 * hstepA, tstepB = 2 * hstepB;
    const unsigned ldsw = (unsigned)wid * 1024u;
    const int aoff = lds_byte(wr * 64 + fr, fq * 8), boff = lds_byte(wc * 32 + fr, fq * 8);
#define PG8_SA(b, h) (((b) * 2 + (h)) * HTB)
#define PG8_SB(b, h) ((4 + (b) * 2 + (h)) * HTB)
#define PG8_STAGE(bufoff, gbase, voff) do { _Pragma("unroll") for (int _i = 0; _i < 2; ++_i) \
        __builtin_amdgcn_global_load_lds((const unsigned*)((const char*)(gbase) + (voff)[_i]), (LAS unsigned*)(lds + (bufoff) + ldsw + _i * 8192), 16, 0, 0); } while (0)
#define PG8_LDA(dst, b, h) do { _Pragma("unroll") for (int m = 0; m < 4; ++m) _Pragma("unroll") for (int k = 0; k < 2; ++k) dst[m][k] = *(const LAS bf16x8*)(lds + PG8_SA(b, h) + aoff + m * 2048 + k * 1024); } while (0)
#define PG8_LDB(dst, b, h) do { _Pragma("unroll") for (int n = 0; n < 2; ++n) _Pragma("unroll") for (int k = 0; k < 2; ++k) dst[n][k] = *(const LAS bf16x8*)(lds + PG8_SB(b, h) + boff + n * 2048 + k * 1024); } while (0)
#define PG8_MMA(ai, bj, At, Bt) do { __builtin_amdgcn_s_setprio(1); _Pragma("unroll") for (int m = 0; m < 4; ++m) _Pragma("unroll") for (int n = 0; n < 2; ++n) _Pragma("unroll") for (int k = 0; k < 2; ++k) \
        acc[ai][bj][m][n] = __builtin_amdgcn_mfma_f32_16x16x32_bf16(Bt[n][k], At[m][k], acc[ai][bj][m][n], 0, 0, 0); __builtin_amdgcn_s_setprio(0); } while (0)
#define PG8_WAIT_V(n) asm volatile("s_waitcnt vmcnt(" #n ")" ::: "memory")
#define PG8_WAIT_L(n) asm volatile("s_waitcnt lgkmcnt(" #n ")" ::: "memory")
#define PG8_BAR __builtin_amdgcn_s_barrier()
#define PG8_SCHED __builtin_amdgcn_sched_barrier(0)
    Unit cur, nxt; int ui = 0;
    if (!S.next(0, cur)) return;
    f32x4 acc[2][2][4][2];
#pragma unroll
    for (int a = 0; a < 2; ++a)
#pragma unroll
        for (int b = 0; b < 2; ++b)
#pragma unroll
            for (int m = 0; m < 4; ++m)
#pragma unroll
                for (int n = 0; n < 2; ++n) acc[a][b][m][n] = (f32x4){0.f, 0.f, 0.f, 0.f};
    bf16x8 At[4][2], B0[2][2], B1[2][2];
    const char* cA = (const char*)g.A + (size_t)cur.pm * tstepA; const char* cB = (const char*)g.Bt + (size_t)cur.pn * tstepB;
    S.a_ready(cur);
    if constexpr (SP2) {
        PG8_STAGE(PG8_SB(0, 0), cB, voffB); PG8_STAGE(PG8_SB(0, 1), cB + hstepB, voffB); PG8_STAGE(PG8_SA(0, 0), cA, voffA); PG8_STAGE(PG8_SA(0, 1), cA + hstepA, voffA);
        if (wr == 1) PG8_BAR;
        PG8_WAIT_V(2); PG8_BAR;
        PG8_STAGE(PG8_SB(1, 0), cB + kstep, voffB); PG8_STAGE(PG8_SA(1, 0), cA + kstep, voffA); PG8_STAGE(PG8_SB(1, 1), cB + hstepB + kstep, voffB);
        PG8_WAIT_V(6); PG8_BAR;
    } else {
        PG8_STAGE(PG8_SB(0, 0), cB, voffB); PG8_STAGE(PG8_SA(0, 0), cA, voffA); PG8_STAGE(PG8_SB(0, 1), cB + hstepB, voffB); PG8_STAGE(PG8_SA(0, 1), cA + hstepA, voffA);
        if (wr == 1) PG8_BAR;
        PG8_WAIT_V(4); PG8_BAR;
        PG8_STAGE(PG8_SB(1, 0), cB + kstep, voffB); PG8_STAGE(PG8_SA(1, 0), cA + kstep, voffA); PG8_STAGE(PG8_SB(1, 1), cB + hstepB + kstep, voffB);
        PG8_WAIT_V(6); PG8_BAR;
    }
    for (;;) {
        const bool has_next = S.next(ui + 1, nxt);
        const char* nA = has_next ? (const char*)g.A + (size_t)nxt.pm * tstepA : cA; const char* nB = has_next ? (const char*)g.Bt + (size_t)nxt.pn * tstepB : cB;
#pragma unroll 1
        for (int t = 0; t < nt; t += 2) {
            const bool last = (t == nt - 2);
            const char* a1 = cA + (size_t)(t + 1) * kstep;
            const char* a2 = last ? nA : cA + (size_t)(t + 2) * kstep; const char* b2 = last ? nB : cB + (size_t)(t + 2) * kstep;
            const char* a3 = a2 + kstep; const char* b3 = b2 + kstep;
            if (last && has_next) S.a_ready(nxt);
            if constexpr (SP2) {
            PG8_LDB(B0, 0, 0); PG8_LDB(B1, 0, 1); PG8_SCHED; PG8_LDA(At, 0, 0); PG8_STAGE(PG8_SA(1, 1), a1 + hstepA, voffA);
            PG8_WAIT_V(8); PG8_WAIT_L(0); PG8_BAR; PG8_MMA(0, 0, At, B0); PG8_MMA(0, 1, At, B1); PG8_BAR; PG8_SCHED;
            PG8_LDA(At, 0, 1); PG8_STAGE(PG8_SB(0, 0), b2, voffB); PG8_STAGE(PG8_SB(0, 1), b2 + hstepB, voffB); PG8_STAGE(PG8_SA(0, 0), a2, voffA);
            PG8_WAIT_V(8); PG8_WAIT_L(0); PG8_BAR; PG8_MMA(1, 0, At, B0); PG8_MMA(1, 1, At, B1); PG8_BAR; PG8_SCHED;
            PG8_LDB(B0, 1, 0); PG8_LDB(B1, 1, 1); PG8_SCHED; PG8_LDA(At, 1, 0); PG8_STAGE(PG8_SA(0, 1), a2 + hstepA, voffA);
            PG8_WAIT_V(8); PG8_WAIT_L(0); PG8_BAR; PG8_MMA(0, 0, At, B0); PG8_MMA(0, 1, At, B1); PG8_BAR; PG8_SCHED;
            PG8_LDA(At, 1, 1); PG8_STAGE(PG8_SB(1, 0), b3, voffB); PG8_STAGE(PG8_SB(1, 1), b3 + hstepB, voffB); PG8_STAGE(PG8_SA(1, 0), a3, voffA);
            PG8_WAIT_V(8); PG8_WAIT_L(0); PG8_BAR; PG8_MMA(1, 0, At, B0); PG8_MMA(1, 1, At, B1); PG8_BAR; PG8_SCHED;
            } else {
            PG8_LDB(B0, 0, 0); PG8_SCHED; PG8_LDA(At, 0, 0); PG8_STAGE(PG8_SA(1, 1), a1 + hstepA, voffA);
            PG8_WAIT_L(8); PG8_BAR; PG8_WAIT_L(0); PG8_MMA(0, 0, At, B0); PG8_BAR; PG8_SCHED;
            PG8_LDB(B1, 0, 1); PG8_STAGE(PG8_SB(0, 0), b2, voffB);
            PG8_BAR; PG8_WAIT_L(0); PG8_MMA(0, 1, At, B1); PG8_BAR;
            PG8_LDA(At, 0, 1); PG8_STAGE(PG8_SA(0, 0), a2, voffA);
            PG8_BAR; PG8_WAIT_L(0); PG8_MMA(1, 0, At, B0); PG8_BAR; PG8_SCHED;
            PG8_STAGE(PG8_SB(0, 1), b2 + hstepB, voffB);
            PG8_WAIT_V(6); PG8_BAR; PG8_MMA(1, 1, At, B1); PG8_BAR;
            PG8_LDB(B0, 1, 0); PG8_SCHED; PG8_LDA(At, 1, 0); PG8_STAGE(PG8_SA(0, 1), a2 + hstepA, voffA);
            PG8_WAIT_L(8); PG8_BAR; PG8_WAIT_L(0); PG8_MMA(0, 0, At, B0); PG8_BAR; PG8_SCHED;
            PG8_LDB(B1, 1, 1); PG8_STAGE(PG8_SB(1, 0), b3, voffB);
            PG8_BAR; PG8_WAIT_L(0); PG8_MMA(0, 1, At, B1); PG8_BAR;
            PG8_LDA(At, 1, 1); PG8_STAGE(PG8_SA(1, 0), a3, voffA);
            PG8_BAR; PG8_WAIT_L(0); PG8_MMA(1, 0, At, B0); PG8_BAR; PG8_SCHED;
            PG8_STAGE(PG8_SB(1, 1), b3 + hstepB, voffB);
            PG8_WAIT_V(6); PG8_BAR; PG8_MMA(1, 1, At, B1); PG8_BAR;
            }
        }
        if constexpr (ALIGN_EPI) { if (wr == 0) PG8_BAR; }
        E(acc, cur, wr, wc, fr, fq); S.done(cur);
        if (!has_next) break;
#pragma unroll
        for (int a = 0; a < 2; ++a)
#pragma unroll
            for (int b = 0; b < 2; ++b)
#pragma unroll
                for (int m = 0; m < 4; ++m)
#pragma unroll
                    for (int n = 0; n < 2; ++n) acc[a][b][m][n] = (f32x4){0.f, 0.f, 0.f, 0.f};
        cur = nxt; cA = nA; cB = nB; ++ui;
        if constexpr (ALIGN_EPI) { if (wr == 1) PG8_BAR; }
    }
    PG8_WAIT_V(0);
    if constexpr (!ALIGN_EPI) { if (wr == 0) PG8_BAR; }
    PG8_BAR;
#undef PG8_SA
#undef PG8_SB
#undef PG8_STAGE
#undef PG8_LDA
#undef PG8_LDB
#undef PG8_MMA
#undef PG8_WAIT_V
#undef PG8_WAIT_L
#undef PG8_BAR
#undef PG8_SCHED
}
}
#define PG8_SP2 true
#define PG8_ALIGN true

struct FProj {
    bf16* mla; bf16* rw; bf16* gate;
    __device__ __forceinline__ void operator()(int row, int col, const float (&v)[8]) const {
        bf16* p;
        if (col < W_MLA) p = mla + (size_t)row * W_MLA + col;
        else if (col < W_MLA + W_RW) p = rw + (size_t)row * W_RW + (col - W_MLA);
        else p = gate + (size_t)row * W_GATE + (col - W_MLA - W_RW);
        store8(p, v);
    }
};
struct FStore {
    bf16* O; int ldc;
    __device__ __forceinline__ void operator()(int row, int col, const float (&v)[8]) const { store8(O + (size_t)row * ldc + col, v); }
};
struct FQ {
    bf16* Q; const float* rstd; const float* rc; const float* rs;
    __device__ __forceinline__ void operator()(int row, int col, const float (&v)[8]) const {
        const float s = rstd[row]; float o[8];
        const int c = col % 192;
        if (c >= 128) {
            const int j0 = ((c - 128) >> 3) * 4, pos = row & (SEQ - 1);
            const f32x4 cs = *(const f32x4*)(rc + pos * 32 + j0), sn = *(const f32x4*)(rs + pos * 32 + j0);
#pragma unroll
            for (int i = 0; i < 4; ++i) { const float x1 = v[i] * s, x2 = v[4 + i] * s; o[i] = x1 * cs[i] - x2 * sn[i]; o[4 + i] = x2 * cs[i] + x1 * sn[i]; }
        } else {
#pragma unroll
            for (int i = 0; i < 8; ++i) o[i] = v[i] * s;
        }
        store8(Q + (size_t)row * QW + col, o);
    }
};
struct FKV {
    bf16* KF; bf16* V; const float* rstd;
    __device__ __forceinline__ void operator()(int row, int col, const float (&v)[8]) const {
        const float s = rstd[row]; float o[8];
#pragma unroll
        for (int i = 0; i < 8; ++i) o[i] = v[i] * s;
        const int hh = col >> 8, w = col & 255;
        bf16* p = (w < 128) ? KF + (size_t)row * KFW + hh * 192 + w : V + (size_t)row * VW + hh * 128 + (w - 128);
        store8(p, o);
    }
};
struct FLora {
    bf16* O; const float* w0; const float* a0; int col0;
    __device__ __forceinline__ void operator()(int row, int colr, const float (&v)[8]) const {
        float o[8]; const int col = colr + col0;
        if (col < 4096) {
            const float* b = (col < 2048) ? w0 + col : a0 + (col - 2048);
            const f32x4 b0 = *(const f32x4*)b, b1 = *(const f32x4*)(b + 4);
#pragma unroll
            for (int i = 0; i < 4; ++i) { o[i] = sigmoidf_(v[i] + b0[i]); o[4 + i] = sigmoidf_(v[4 + i] + b1[i]); }
        } else {
#pragma unroll
            for (int i = 0; i < 8; ++i) o[i] = v[i];
        }
        store8(O + (size_t)row * LORA_N + col, o);
    }
};
struct FMergeA {
    bf16* MG; const bf16* gate;
    __device__ __forceinline__ void operator()(int row, int col, const float (&v)[8]) const {
        float gt[8], o[8]; load8(gate + (size_t)row * W_GATE + col, gt);
#pragma unroll
        for (int i = 0; i < 8; ++i) o[i] = sigmoidf_(gt[i]) * v[i];
        store8(MG + (size_t)row * DM + col, o);
    }
};
struct FMergeB {
    bf16* MG; const bf16* gate;
    __device__ __forceinline__ void operator()(int row, int col, const float (&v)[8]) const {
        float gt[8], o[8], m[8]; load8(gate + (size_t)row * W_GATE + DM + col, gt); load8(MG + (size_t)row * DM + col, m);
#pragma unroll
        for (int i = 0; i < 8; ++i) o[i] = m[i] + sigmoidf_(gt[i]) * v[i];
        store8(MG + (size_t)row * DM + col, o);
    }
};
struct FResid {
    const float* xin; float* out; const float* gt;
    __device__ __forceinline__ void operator()(int row, int col, const float (&v)[8]) const {
        const float* gp = gt + (size_t)(row >> 12) * NMOD + col;
        const f32x4 g0 = *(const f32x4*)gp, g1 = *(const f32x4*)(gp + 4);
        const float* xp = xin + (size_t)row * DM + col;
        const f32x4 x0 = *(const f32x4*)xp, x1 = *(const f32x4*)(xp + 4);
        f32x4 o0, o1;
#pragma unroll
        for (int i = 0; i < 4; ++i) { o0[i] = x0[i] + g0[i] * v[i]; o1[i] = x1[i] + g1[i] * v[4 + i]; }
        float* op = out + (size_t)row * DM + col;
        *(f32x4*)op = o0; *(f32x4*)(op + 4) = o1;
    }
};

__device__ __forceinline__ float dpp_shr1(float x) { return __builtin_bit_cast(float, __builtin_amdgcn_update_dpp(0, __builtin_bit_cast(int, x), 0x111, 0xF, 0xF, true)); }
__device__ __forceinline__ float dpp_shl1(float x) { return __builtin_bit_cast(float, __builtin_amdgcn_update_dpp(0, __builtin_bit_cast(int, x), 0x101, 0xF, 0xF, true)); }
struct EpiAct {
    static constexpr bool PERM = true, AFTER_DRAIN = false;
    bf16* ACT; bf16* EA; bf16* EB; const float* cw; const float* cb;
    __device__ __forceinline__ void operator()(const f32x4 (&acc)[2][2][4][2], const pg8::Unit& u, int wr, int wc, int fr, int fq) const {
        const int j0 = u.pn * 128 + wc * 32 + 8 * fq;
        float w0[8], w1[8], w2[8], bb[8];
#pragma unroll
        for (int h = 0; h < 2; ++h) { const f32x4 x0 = *(const f32x4*)(cw + j0 + 4 * h), x1 = *(const f32x4*)(cw + DFF + j0 + 4 * h), x2 = *(const f32x4*)(cw + 2 * DFF + j0 + 4 * h), x3 = *(const f32x4*)(cb + j0 + 4 * h);
#pragma unroll
            for (int i = 0; i < 4; ++i) { w0[4 * h + i] = x0[i]; w1[4 * h + i] = x1[i]; w2[4 * h + i] = x2[i]; bb[4 * h + i] = x3[i]; } }
#pragma unroll
        for (int ai = 0; ai < 2; ++ai) {
            float av[4][8], bv[4][8];
#pragma unroll
            for (int m = 0; m < 4; ++m)
#pragma unroll
                for (int i = 0; i < 4; ++i) { av[m][i] = acc[ai][0][m][0][i]; av[m][4 + i] = acc[ai][0][m][1][i]; bv[m][i] = acc[ai][1][m][0][i]; bv[m][4 + i] = acc[ai][1][m][1][i]; }
            float ap[8], an[8];
#pragma unroll
            for (int i = 0; i < 8; ++i) { ap[i] = dpp_shr1(av[3][i]); an[i] = dpp_shl1(av[0][i]); }
            const int blk = ai * 2 + wr; const size_t tok0 = (size_t)u.pm * 256 + blk * 64 + 4 * fr;
#pragma unroll
            for (int m = 0; m < 4; ++m) {
                float o[8];
#pragma unroll
                for (int i = 0; i < 8; ++i) { const float xm = (m == 0) ? ap[i] : av[m == 0 ? 0 : m - 1][i], xp = (m == 3) ? an[i] : av[m == 3 ? 3 : m + 1][i];
                    const float c = w0[i] * xm + w1[i] * av[m][i] + w2[i] * xp + bb[i]; o[i] = c * sigmoidf_(c) * bv[m][i]; }
                store8(ACT + (tok0 + m) * DFF + j0, o);
            }
            const size_t eb = ((size_t)u.pm * 4 + blk);
            if (fr == 0) { store8(EA + (eb * 4 + 0) * DFF + j0, av[0]); store8(EA + (eb * 4 + 1) * DFF + j0, av[1]); store8(EB + (eb * 2 + 0) * DFF + j0, bv[0]); }
            if (fr == 15) { store8(EA + (eb * 4 + 2) * DFF + j0, av[2]); store8(EA + (eb * 4 + 3) * DFF + j0, av[3]); store8(EB + (eb * 2 + 1) * DFF + j0, bv[3]); }
            asm volatile("" ::: "memory");
        }
    }
};

namespace att {
constexpr int DQK = 192, DV = 128, NW = 8, QBLK = 32, KVBLK = 64;
constexpr float SCALE = 0.07216878364870322f;
constexpr float THR = 8.f;
constexpr int LDQ = QW, LDK = KFW, LDV = VW, LDO = 1024;
constexpr int SHM_V = KVBLK * DV * 2, SHM_K = KVBLK * DQK * 2, SHM_ATTN = 2 * SHM_V + 2 * SHM_K + NW * 64 * 4;
#define KSWZ(row, colB) ((row) * 384 + ((colB) ^ (((row) & 7) << 4)))
#define SBAR() __builtin_amdgcn_sched_barrier(0)
__device__ __forceinline__ int crow(int r, int hi) { return (r & 3) + 8 * (r >> 2) + 4 * hi; }
__device__ __forceinline__ void partialSM(f32x16& p0, f32x16& p1, float& m_reg, float& mn, float& alpha) {
    constexpr float C = SCALE * 1.4426950408889634f;
    float pmax = p0[0];
#pragma unroll
    for (int r = 1; r < 16; ++r) pmax = fmaxf(pmax, p0[r]);
#pragma unroll
    for (int r = 0; r < 16; ++r) pmax = fmaxf(pmax, p1[r]);
    { auto rr = __builtin_amdgcn_permlane32_swap(__float_as_uint(pmax), __float_as_uint(pmax), false, false);
      pmax = fmaxf(__uint_as_float(rr[0]), __uint_as_float(rr[1])); }
    if (__builtin_expect(__all(pmax - m_reg <= THR / SCALE), 1)) { mn = m_reg; alpha = 1.f; }
    else { mn = fmaxf(m_reg, pmax); alpha = __builtin_amdgcn_exp2f((m_reg - mn) * C); m_reg = mn; }
    const float mnC = -mn * C;
#pragma unroll
    for (int r = 0; r < 16; ++r) p0[r] = fmaf(p0[r], C, mnC);
#pragma unroll
    for (int r = 0; r < 16; ++r) p1[r] = fmaf(p1[r], C, mnC);
#pragma unroll
    for (int r = 0; r < 16; ++r) p0[r] = __builtin_amdgcn_exp2f(p0[r]);
}
__device__ __forceinline__ void finishSM(f32x16& p0, f32x16& p1, float alpha, float& l_reg, bf16x8& pa0, bf16x8& pa1, bf16x8& pa2, bf16x8& pa3) {
#pragma unroll
    for (int r = 0; r < 16; ++r) p1[r] = __builtin_amdgcn_exp2f(p1[r]);
    float ps = 0;
#pragma unroll
    for (int r = 0; r < 16; ++r) ps += p0[r];
#pragma unroll
    for (int r = 0; r < 16; ++r) ps += p1[r];
    { auto rr = __builtin_amdgcn_permlane32_swap(__float_as_uint(ps), __float_as_uint(ps), false, false);
      ps = __uint_as_float(rr[0]) + __uint_as_float(rr[1]); }
    l_reg = l_reg * alpha + ps;
#define PK4(P, BASE, OUT) do { unsigned a0 = cvt_pk_bf16(P[BASE + 0], P[BASE + 1]), a1 = cvt_pk_bf16(P[BASE + 2], P[BASE + 3]);   \
    unsigned b0 = cvt_pk_bf16(P[BASE + 4], P[BASE + 5]), b1 = cvt_pk_bf16(P[BASE + 6], P[BASE + 7]);                              \
    auto r0 = __builtin_amdgcn_permlane32_swap(a0, b0, false, false); auto r1 = __builtin_amdgcn_permlane32_swap(a1, b1, false, false); \
    u32x4 w = {r0[0], r1[0], r0[1], r1[1]}; OUT = __builtin_bit_cast(bf16x8, w); } while (0)
    PK4(p0, 0, pa0); PK4(p0, 8, pa1); PK4(p1, 0, pa2); PK4(p1, 8, pa3);
#undef PK4
}
__device__ __forceinline__ void qkt(f32x16& p0, f32x16& p1, const LAS char* Ks, const bf16x8* qr, int r32, int hi) {
    p0 = f32x16{}; p1 = f32x16{};
#pragma unroll
    for (int d0 = 0; d0 < 12; ++d0) { const int cb = (d0 * 16 + hi * 8) * 2;
        const bf16x8 b0 = *(const LAS bf16x8*)(Ks + KSWZ(r32, cb));
        const bf16x8 b1 = *(const LAS bf16x8*)(Ks + KSWZ(32 + r32, cb));
        p0 = __builtin_amdgcn_mfma_f32_32x32x16_bf16(b0, qr[d0], p0, 0, 0, 0);
        p1 = __builtin_amdgcn_mfma_f32_32x32x16_bf16(b1, qr[d0], p1, 0, 0, 0); }
}
__device__ __forceinline__ int v_st(int k, int c) { const int kk = (k & ~0xC) | ((k & 4) << 1) | ((k & 8) >> 1); return ((kk >> 3) * 4 + (c >> 5)) * 512 + ((kk & 7) * 32 + (c & 31)) * 2; }
__device__ __forceinline__ int v_rd_base(int lane) { return ((lane & 3) << 3) | (((lane >> 2) & 3) << 6) | (((lane >> 4) & 1) << 5) | (((lane >> 5) & 1) << 8); }
constexpr int v_rd_off(int d0, int ks, int half) { return d0 * 512 + ks * 4096 + half * 2048; }
template <int OFF> __device__ __forceinline__ s16x4 tr_read(int vb) {
    s16x4 r; asm volatile("ds_read_b64_tr_b16 %0, %1 offset:%2" : "=&v"(r) : "v"(vb), "i"(OFF) : "memory"); return r;
}
template <int D0> __device__ __forceinline__ void pv_one(f32x16& od, int vb, bf16x8 pa0, bf16x8 pa1, bf16x8 pa2, bf16x8 pa3) {
    const s16x4 l0 = tr_read<v_rd_off(D0, 0, 0)>(vb), h0 = tr_read<v_rd_off(D0, 0, 1)>(vb), l1 = tr_read<v_rd_off(D0, 1, 0)>(vb), h1 = tr_read<v_rd_off(D0, 1, 1)>(vb);
    const s16x4 l2 = tr_read<v_rd_off(D0, 2, 0)>(vb), h2 = tr_read<v_rd_off(D0, 2, 1)>(vb), l3 = tr_read<v_rd_off(D0, 3, 0)>(vb), h3 = tr_read<v_rd_off(D0, 3, 1)>(vb);
    asm volatile("s_waitcnt lgkmcnt(0)" ::: "memory"); SBAR();
#define PK(L, H) (bf16x8){L[0], L[1], L[2], L[3], H[0], H[1], H[2], H[3]}
    od = __builtin_amdgcn_mfma_f32_32x32x16_bf16(pa0, PK(l0, h0), od, 0, 0, 0);
    od = __builtin_amdgcn_mfma_f32_32x32x16_bf16(pa1, PK(l1, h1), od, 0, 0, 0);
    od = __builtin_amdgcn_mfma_f32_32x32x16_bf16(pa2, PK(l2, h2), od, 0, 0, 0);
    od = __builtin_amdgcn_mfma_f32_32x32x16_bf16(pa3, PK(l3, h3), od, 0, 0, 0);
#undef PK
}
__device__ __forceinline__ void pv_d0(f32x16* o, int vb, bf16x8 pa0, bf16x8 pa1, bf16x8 pa2, bf16x8 pa3) {
    pv_one<0>(o[0], vb, pa0, pa1, pa2, pa3); pv_one<1>(o[1], vb, pa0, pa1, pa2, pa3); pv_one<2>(o[2], vb, pa0, pa1, pa2, pa3); pv_one<3>(o[3], vb, pa0, pa1, pa2, pa3);
}
__device__ __forceinline__ void attn_unit(const bf16* __restrict__ Qb, const bf16* __restrict__ Kh, const bf16* __restrict__ Vh, bf16* __restrict__ Ob, int seq, LAS char* lds) {
    const int tid = threadIdx.x, wid = tid >> 6, lane = tid & 63, r32 = lane & 31, hi = lane >> 5;
    LAS char* V_lds = lds; LAS char* K_lds = lds + 2 * SHM_V;
    LAS float* ws = (LAS float*)(lds + 2 * SHM_V + 2 * SHM_K) + wid * 64; LAS float* li_l = ws; LAS float* al_l = ws + 32;
    float m_reg = -1e30f, l_reg = 0; f32x16 o[4] = {}; bf16x8 qr[12];
    const bf16* Qw = Qb + (long)(wid * QBLK + r32) * LDQ + hi * 8;
#pragma unroll
    for (int d0 = 0; d0 < 12; ++d0) qr[d0] = *(const bf16x8*)(Qw + d0 * 16);
    const int sr = tid >> 4, sc = (tid & 15) * 8, vst0 = v_st(sr, sc), vst1 = v_st(32 + sr, sc);
    const int krow0 = tid >> 3, kch0 = tid & 7;
    const int vb0 = (int)(unsigned)(uintptr_t)V_lds + v_rd_base(lane);
    bf16x8 vs0, vs1, ks0, ks1, ks2;
#define SLOAD(k0) do { vs0 = *(const bf16x8*)(&Vh[(long)((k0) + sr) * LDV + sc]); vs1 = *(const bf16x8*)(&Vh[(long)((k0) + 32 + sr) * LDV + sc]); \
    { const bf16* kp_ = &Kh[(long)((k0) + krow0) * LDK + kch0 * 8]; ks0 = *(const bf16x8*)kp_; ks1 = *(const bf16x8*)(kp_ + 64); ks2 = *(const bf16x8*)(kp_ + 128); } } while (0)
#define SWRITE(b) do { *(LAS bf16x8*)(V_lds + (b) * SHM_V + vst0) = vs0; *(LAS bf16x8*)(V_lds + (b) * SHM_V + vst1) = vs1; \
    *(LAS bf16x8*)(K_lds + (b) * SHM_K + KSWZ(krow0, kch0 * 16)) = ks0; *(LAS bf16x8*)(K_lds + (b) * SHM_K + KSWZ(krow0, (kch0 + 8) * 16)) = ks1; \
    *(LAS bf16x8*)(K_lds + (b) * SHM_K + KSWZ(krow0, (kch0 + 16) * 16)) = ks2; } while (0)
#define RESC(a) do { if (__any((a) < 1.f)) { if (hi == 0) al_l[r32] = (a); asm volatile("s_waitcnt lgkmcnt(0)" ::: "memory"); \
    _Pragma("unroll") for (int d = 0; d < 4; ++d) _Pragma("unroll") for (int r = 0; r < 16; ++r) o[d][r] *= al_l[crow(r, hi)]; } } while (0)
    f32x16 p0, p1; float mn, al; bf16x8 pa0, pa1, pa2, pa3; const int NT = seq / KVBLK;
    SLOAD(0); VM_WAIT(); SWRITE(0); __syncthreads();
    for (int j = 0; j < NT; ++j) {
        const int b = j & 1;
        if (j + 1 < NT) SLOAD((j + 1) * KVBLK);
        SBAR(); qkt(p0, p1, K_lds + b * SHM_K, qr, r32, hi);
        partialSM(p0, p1, m_reg, mn, al);
        finishSM(p0, p1, al, l_reg, pa0, pa1, pa2, pa3); SBAR();
        RESC(al);
        pv_d0(o, vb0 + b * SHM_V, pa0, pa1, pa2, pa3);
        if (j + 1 < NT) { VM_WAIT(); SWRITE(b ^ 1); }
        __syncthreads();
    }
    if (hi == 0) li_l[r32] = l_reg; asm volatile("s_waitcnt lgkmcnt(0)" ::: "memory");
    float rli[16];
#pragma unroll
    for (int r = 0; r < 16; ++r) rli[r] = __builtin_amdgcn_rcpf(li_l[crow(r, hi)]);
    LAS char* ost = lds + wid * (QBLK * 272);
#pragma unroll
    for (int r = 0; r < 16; ++r) { const int orow = crow(r, hi);
#pragma unroll
        for (int d0 = 0; d0 < 4; ++d0) *(LAS bf16*)(ost + orow * 272 + (d0 * 32 + r32) * 2) = (bf16)(cvt_pk_bf16(o[d0][r] * rli[r], 0.f) & 0xffffu); }
    asm volatile("s_waitcnt lgkmcnt(0)" ::: "memory");
    bf16* Ow = Ob + (long)(wid * QBLK) * LDO;
#pragma unroll
    for (int i = 0; i < 8; ++i) { const int id = lane + 64 * i, orow = id >> 4, ch = id & 15;
        *(u32x4*)(Ow + (long)orow * LDO + ch * 8) = *(const LAS u32x4*)(ost + orow * 272 + ch * 16); }
    __syncthreads();
#undef SLOAD
#undef SWRITE
#undef RESC
}
}

#define XB_TMO      128
#define XB_XCNT(j)  (256  + 64 * (j))
#define XB_XSUB(j)  (1280 + 64 * (j))
#define XB_XGEN(j)  (2304 + 64 * (j))
#define XB_TOP      3328
#define XB_TOPGEN   3392
#define XCD_BAR_WORDS 3456
#define XB_SPIN_CAP (1u << 22)
__device__ __forceinline__ unsigned xb_ld(unsigned* p)              { return __hip_atomic_load(p, __ATOMIC_RELAXED, __HIP_MEMORY_SCOPE_AGENT); }
__device__ __forceinline__ unsigned xb_add(unsigned* p, unsigned v) { return __hip_atomic_fetch_add(p, v, __ATOMIC_RELAXED, __HIP_MEMORY_SCOPE_AGENT); }
__device__ __forceinline__ unsigned xb_xcc_id() { return (unsigned)__builtin_amdgcn_s_getreg((3 << 11) | 20) & 0xFu; }
#define XB_SPIN(cond, bar) do { unsigned _sp = 0; while (cond) { __builtin_amdgcn_s_sleep(1); \
    if ((++_sp & 255u) == 0u) { if (xb_ld(&(bar)[XB_TMO])) break; if (_sp > XB_SPIN_CAP) { atomicAdd(&(bar)[XB_TMO], 1u); break; } } } } while (0)
struct XcdBarrier { unsigned* bar; unsigned x; volatile LAS unsigned* st; };
__device__ __forceinline__ XcdBarrier xcd_barrier_post(unsigned* bar, volatile LAS unsigned* st) {
    XcdBarrier b; b.bar = bar; b.x = xb_xcc_id(); b.st = st;
    if (threadIdx.x == 0) (void)xb_add(&bar[XB_XCNT(b.x)], 1u);
    return b;
}
__device__ __forceinline__ void xcd_barrier_complete(unsigned* bar, unsigned x, unsigned& nloc, unsigned& nx) {
    const unsigned G = gridDim.x * gridDim.y * gridDim.z;
    unsigned sum, cnt, mine, sp = 0u;
    for (;;) {
        sum = 0u; cnt = 0u; mine = 0u;
#pragma unroll
        for (unsigned j = 0; j < 16; ++j) { const unsigned c = xb_ld(&bar[XB_XCNT(j)]); sum += c; cnt += (c > 0u) ? 1u : 0u; mine = (j == x) ? c : mine; }
        if (sum == G) break;
        __builtin_amdgcn_s_sleep(1);
        if ((++sp & 255u) == 0u) { if (xb_ld(&bar[XB_TMO])) break; if (sp > XB_SPIN_CAP) { atomicAdd(&bar[XB_TMO], 1u); break; } }
    }
    nloc = mine > 0u ? mine : 1u; nx = cnt > 0u ? cnt : 1u;
}
__device__ __forceinline__ void xcd_barrier(const XcdBarrier& b) {
    asm volatile("s_waitcnt vmcnt(0)" ::: "memory");
    __syncthreads();
    if (threadIdx.x == 0) {
        unsigned* bar = b.bar;
        __builtin_amdgcn_s_waitcnt(0);
        unsigned nloc = b.st[0], nx = b.st[1];
        if (nloc == 0u) { xcd_barrier_complete(bar, b.x, nloc, nx); b.st[0] = nloc; b.st[1] = nx; }
        const unsigned old = xb_add(&bar[XB_XSUB(b.x)], 1u);
        const unsigned gen = old / nloc;
        if (old + 1u == (gen + 1u) * nloc) {
            __builtin_amdgcn_fence(__ATOMIC_RELEASE, "agent");
            asm volatile("s_waitcnt vmcnt(0)" ::: "memory");
            const unsigned og = xb_add(&bar[XB_TOP], 1u);
            const unsigned tg = og / nx;
            if (og + 1u == (tg + 1u) * nx) xb_add(&bar[XB_TOPGEN], 1u);
            else XB_SPIN(xb_ld(&bar[XB_TOPGEN]) == tg, bar);
            __builtin_amdgcn_fence(__ATOMIC_ACQUIRE, "agent");
            xb_add(&bar[XB_XGEN(b.x)], 1u);
            asm volatile("s_waitcnt vmcnt(0)" ::: "memory");
        } else {
            XB_SPIN(xb_ld(&bar[XB_XGEN(b.x)]) == gen, bar);
            __builtin_amdgcn_fence(__ATOMIC_ACQUIRE, "agent");
            asm volatile("s_waitcnt vmcnt(0)" ::: "memory");
        }
    }
    __syncthreads();
}

struct Args {
    const float* in[32];
    float* out; unsigned char* ws;
    int lo, hi, pad0, pad1;
};
enum { I_XP = 0, I_XS, I_CP, I_CS, I_ADAW, I_ADAB, I_NMIXG, I_WIN, I_QNG, I_WUQ, I_KVNG, I_WUKV, I_WOATT, I_MU, I_W0, I_WDEC, I_A0, I_WICLR, I_WGATE,
       I_KK, I_KA, I_RK, I_GNG, I_GNB, I_WORWKV, I_WOUT, I_NFFNG, I_WUP, I_CONVW, I_CONVB, I_WDOWN, I_FNG };

constexpr int ARGTAB_OFF = MISC_OFF + 256;
struct Ctx { LAS unsigned char* lds; int tid, lane, wave, gw, ngw; };
struct PT {
    LAS unsigned char* lds; int toff;
    __device__ __forceinline__ explicit PT(const Ctx& C) { lds = C.lds; int t = ARGTAB_OFF; asm volatile("" : "+s"(t)); toff = t; }
    __device__ __forceinline__ unsigned long long raw(int i) const { const LAS unsigned* p = (const LAS unsigned*)(lds + toff) + 2 * i;
        const unsigned lo = __builtin_amdgcn_readfirstlane(p[0]), hi = __builtin_amdgcn_readfirstlane(p[1]); return ((unsigned long long)hi << 32) | lo; }
    __device__ __forceinline__ const float* in(int i) const { return (const float*)raw(i); }
    __device__ __forceinline__ float* out() const { return (float*)raw(32); }
    __device__ __forceinline__ unsigned char* ws() const { return (unsigned char*)raw(33); }
};

__device__ __forceinline__ void phase_mod(const Ctx& C) {
    const PT a(C);
    float* mod = (float*)(a.ws() + WS_MOD);
    LAS float* sil = (LAS float*)C.lds;
    for (int u = blockIdx.x; u < 192; u += gridDim.x) {
        const int cu = u % 96, kh = u / 96, l = cu / 48, n0 = (cu % 48) * 256;
        for (int i = C.tid; i < 1024 * 12; i += 512) { const int kk = i / 12, s = i % 12;
            const float c = (s < 8) ? a.in(I_CP)[s * DM + kh * 1024 + kk] : a.in(I_CS)[(s - 8) * DM + kh * 1024 + kk];
            sil[i] = c / (1.f + __expf(-c)); }
        __syncthreads();
        f32x4 acc[12];
#pragma unroll
        for (int s = 0; s < 12; ++s) acc[s] = (f32x4){0.f, 0.f, 0.f, 0.f};
        const int kb = C.wave * 128;
        const float* wp = a.in(I_ADAW) + ((size_t)l * DM + kh * 1024 + kb) * NMOD + n0 + C.lane * 4;
        for (int kk = 0; kk < 128; kk += 4) {
            f32x4 wv[4];
#pragma unroll
            for (int i = 0; i < 4; ++i) wv[i] = *(const f32x4*)(wp + (size_t)(kk + i) * NMOD);
#pragma unroll
            for (int i = 0; i < 4; ++i) {
                const LAS f32x4* sp = (const LAS f32x4*)(sil + (kb + kk + i) * 12);
                const f32x4 s0 = sp[0], s1 = sp[1], s2 = sp[2];
                acc[0] += wv[i] * s0[0]; acc[1] += wv[i] * s0[1]; acc[2] += wv[i] * s0[2]; acc[3] += wv[i] * s0[3];
                acc[4] += wv[i] * s1[0]; acc[5] += wv[i] * s1[1]; acc[6] += wv[i] * s1[2]; acc[7] += wv[i] * s1[3];
                acc[8] += wv[i] * s2[0]; acc[9] += wv[i] * s2[1]; acc[10] += wv[i] * s2[2]; acc[11] += wv[i] * s2[3];
            }
        }
        __syncthreads();
        LAS f32x4* part = (LAS f32x4*)C.lds;
#pragma unroll
        for (int s = 0; s < 12; ++s) part[(C.wave * 12 + s) * 64 + C.lane] = acc[s];
        __syncthreads();
        for (int i = C.tid; i < 12 * 64; i += 512) {
            f32x4 t = part[i];
#pragma unroll
            for (int w = 1; w < 8; ++w) t += part[w * 12 * 64 + i];
            const int s_ = i >> 6, ln = i & 63;
            if (kh == 0) t += *(const f32x4*)(a.in(I_ADAB) + (size_t)l * NMOD + n0 + ln * 4);
            float* mp = mod + ((size_t)l * 12 + s_) * NMOD + n0 + ln * 4;
#pragma unroll
            for (int j = 0; j < 4; ++j) __hip_atomic_fetch_add(mp + j, t[j], __ATOMIC_RELAXED, __HIP_MEMORY_SCOPE_AGENT);
        }
        __syncthreads();
    }
    float* rc = (float*)(a.ws() + WS_ROPE); float* rs = rc + SEQ * 32;
    for (int i = blockIdx.x * 512 + C.tid; i < SEQ * 32; i += gridDim.x * 512) {
        const int pos = i >> 5, j = i & 31;
        const double inv = 1.0 / pow(10000.0, (double)j / 32.0), ang = (double)pos * inv;
        rc[i] = (float)cos(ang); rs[i] = (float)sin(ang);
    }
}

constexpr f32x4 ZERO4 = {0.f, 0.f, 0.f, 0.f};
template <class Get> __device__ __forceinline__ void tr_tile(const Get& get, bf16* WT, int ldt, int n0, int k0, LAS float* T, int tid) {
    const int n4 = (tid & 63) * 4, kq = tid >> 6;
    f32x4 v[8];
#pragma unroll
    for (int i = 0; i < 8; ++i) v[i] = get.get4(n0 + n4, k0 + kq + 8 * i);
#pragma unroll
    for (int i = 0; i < 8; ++i) *(LAS f32x4*)(T + (kq + 8 * i) * 260 + n4) = v[i];
    __syncthreads();
    const int n = tid >> 1, kh = (tid & 1) * 32;
#pragma unroll
    for (int j = 0; j < 4; ++j) { const LAS float* t = T + (kh + 8 * j) * 260 + n;
        u32x4 o; o.x = cvt_pk_bf16(t[0], t[260]); o.y = cvt_pk_bf16(t[2 * 260], t[3 * 260]); o.z = cvt_pk_bf16(t[4 * 260], t[5 * 260]); o.w = cvt_pk_bf16(t[6 * 260], t[7 * 260]);
        *(u32x4*)(WT + (size_t)(n0 + n) * ldt + k0 + kh + 8 * j) = o; }
    __syncthreads();
}
struct GetPlain { const float* W; int ldw; __device__ __forceinline__ f32x4 get4(int n, int k) const { return *(const f32x4*)(W + (size_t)k * ldw + n); } };
struct GetWin { const float* W; __device__ __forceinline__ f32x4 get4(int n, int k) const {
    int s;
    if (n < 832) s = n; else if (n < W_MLA) s = -1; else if (n < W_MLA + RWIN) s = 832 + (n - W_MLA); else if (n < W_MLA + W_RW) s = -1; else s = 4320 + (n - W_MLA - W_RW);
    return s < 0 ? ZERO4 : *(const f32x4*)(W + (size_t)k * DIN + s); } };
struct GetUq { const float* W; const float* g; __device__ __forceinline__ f32x4 get4(int n, int k) const {
    const int hh = n / 192, c = n % 192; int s;
    if (c < 128) s = hh * 192 + c; else { const int p = c - 128, grp = p >> 3, w = p & 7; s = hh * 192 + 128 + (w >> 2) * 32 + grp * 4; }
    return *(const f32x4*)(W + (size_t)k * QW + s) * g[k]; } };
struct GetUp { const float* W; __device__ __forceinline__ f32x4 get4(int n, int k) const {
    const int t = n >> 8, w = n & 255; const int sc = (w < 128) ? t * 128 + w : DFF + t * 128 + (w - 128); return *(const f32x4*)(W + (size_t)k * (2 * DFF) + sc); } };
struct GetUkv { const float* W; const float* g; __device__ __forceinline__ f32x4 get4(int n, int k) const { return *(const f32x4*)(W + (size_t)k * 2048 + n) * g[k]; } };
struct GetLora { const float* wdec; const float* wiclr; const float* wgate;
    __device__ __forceinline__ f32x4 get4(int n, int k) const {
        if (n < 2048) { const int d = n >> 10, c = n & 1023, kk = k - d * 64; return (kk >= 0 && kk < 64) ? *(const f32x4*)(wdec + ((size_t)d * 64 + kk) * 1024 + c) : ZERO4; }
        if (n < 4096) { const int d = (n - 2048) >> 10, c = n & 1023, kk = k - 128 - d * 64; return (kk >= 0 && kk < 64) ? *(const f32x4*)(wiclr + ((size_t)d * 64 + kk) * 1024 + c) : ZERO4; }
        const int c = n - 4096; return (k < 160) ? *(const f32x4*)(wgate + (size_t)k * 1024 + c) : ZERO4; } };

__device__ __forceinline__ void phase_convert(const Ctx& C, int l) {
    const PT a(C);
    LAS float* T = (LAS float*)C.lds;
    bf16* wb = (bf16*)(a.ws() + WS_W);
    constexpr int I0 = (NPROJ / 256) * (DM / 64), I1 = (QW / 256) * (512 / 64), I2 = (2048 / 256) * (256 / 64), I3 = (DM / 256) * (1024 / 64), I4 = I3,
                  I5 = (DM / 256) * (DM / 64), I6 = (2 * DFF / 256) * (DM / 64), I7 = (DM / 256) * (DFF / 64), I8 = (LORA_N / 256) * (LORA_KB / 64);
    constexpr int NIT = I0 + I1 + I2 + I3 + I4 + I5 + I6 + I7 + I8;
    for (int it = blockIdx.x; it < NIT; it += gridDim.x) {
        int r = it;
#define ITEM(CNT, GET, OFF, KD) if (r < (CNT)) { const int nblk_k = (KD) / 64; const int nb = r / nblk_k, kb = r % nblk_k; tr_tile(GET, (bf16*)((char*)wb + (OFF)), (KD), nb * 256, kb * 64, T, C.tid); continue; } r -= (CNT);
        ITEM(I0, (GetWin{a.in(I_WIN) + (size_t)l * DM * DIN}), WO_IN, DM)
        ITEM(I1, (GetUq{a.in(I_WUQ) + (size_t)l * 512 * QW, a.in(I_QNG) + l * 512}), WO_UQ, 512)
        ITEM(I2, (GetUkv{a.in(I_WUKV) + (size_t)l * 256 * 2048, a.in(I_KVNG) + l * 256}), WO_UKV, 256)
        ITEM(I3, (GetPlain{a.in(I_WOATT) + (size_t)l * 1024 * DM, DM}), WO_OATT, 1024)
        ITEM(I4, (GetPlain{a.in(I_WORWKV) + (size_t)l * 1024 * DM, DM}), WO_ORWKV, 1024)
        ITEM(I5, (GetPlain{a.in(I_WOUT) + (size_t)l * DM * DM, DM}), WO_OUT, DM)
        ITEM(I6, (GetUp{a.in(I_WUP) + (size_t)l * DM * 2 * DFF}), WO_UP, DM)
        ITEM(I7, (GetPlain{a.in(I_WDOWN) + (size_t)l * DFF * DM, DM}), WO_DOWN, DFF)
        ITEM(I8, (GetLora{a.in(I_WDEC) + (size_t)l * 2 * 64 * 1024, a.in(I_WICLR) + (size_t)l * 2 * 64 * 1024, a.in(I_WGATE) + (size_t)l * 160 * 1024}), WO_LORA, LORA_KB)
#undef ITEM
    }
}

__device__ __forceinline__ void phase_modnorm(const Ctx& C, int gw, int ngw, const float* xsrc, bf16* H, const float* g, const float* modb, int ksh, int ksc) {
    const int per = GROWS / ngw, r0 = gw * per;
    const float* mb = modb + (size_t)(r0 >> 12) * NMOD;
    f32x4 gm[8], sh[8];
#pragma unroll
    for (int j = 0; j < 8; ++j) { const int c = 256 * j + 4 * C.lane; const f32x4 gg = *(const f32x4*)(g + c), sc = *(const f32x4*)(mb + ksc * DM + c); sh[j] = *(const f32x4*)(mb + ksh * DM + c);
#pragma unroll
        for (int i = 0; i < 4; ++i) gm[j][i] = gg[i] * (1.f + sc[i]); }
#pragma unroll 2
    for (int row = r0; row < r0 + per; ++row) {
        const float* xr = xsrc + (size_t)row * DM;
        f32x4 v[8]; float ss = 0.f;
#pragma unroll
        for (int j = 0; j < 8; ++j) { v[j] = *(const f32x4*)(xr + 256 * j + 4 * C.lane); ss += (v[j][0] * v[j][0] + v[j][1] * v[j][1]) + (v[j][2] * v[j][2] + v[j][3] * v[j][3]); }
        const float rstd = rsqrtf(wave_sum(ss) * (1.f / DM) + 1e-6f);
#pragma unroll
        for (int j = 0; j < 8; ++j) { const int c = 256 * j + 4 * C.lane;
            f32x4 y;
#pragma unroll
            for (int i = 0; i < 4; ++i) y[i] = v[j][i] * rstd * gm[j][i] + sh[j][i];
            u32x2 w; w.x = cvt_pk_bf16(y[0], y[1]); w.y = cvt_pk_bf16(y[2], y[3]);
            *(u32x2*)(H + (size_t)row * DM + c) = w; }
    }
}
__device__ __forceinline__ void phase_final(const Ctx& C, int gw, int ngw, int row_lo, int row_hi, float* out, const float* g) {
    f32x4 gv[8];
#pragma unroll
    for (int j = 0; j < 8; ++j) gv[j] = *(const f32x4*)(g + 256 * j + 4 * C.lane);
#pragma unroll 2
    for (int row = row_lo + gw; row < row_hi; row += ngw) {
        float* xr = out + (size_t)row * DM;
        f32x4 v[8]; float ss = 0.f;
#pragma unroll
        for (int j = 0; j < 8; ++j) { v[j] = *(const f32x4*)(xr + 256 * j + 4 * C.lane); ss += (v[j][0] * v[j][0] + v[j][1] * v[j][1]) + (v[j][2] * v[j][2] + v[j][3] * v[j][3]); }
        const float rstd = rsqrtf(wave_sum(ss) * (1.f / DM) + 1e-6f);
#pragma unroll
        for (int j = 0; j < 8; ++j) { const int c = 256 * j + 4 * C.lane;
            f32x4 y;
#pragma unroll
            for (int i = 0; i < 4; ++i) y[i] = v[j][i] * rstd * gv[j][i];
            *(f32x4*)(xr + c) = y; }
    }
}
__device__ __forceinline__ void phase_prep(const Ctx& C, int l) {
    const PT a(C);
    const bf16* PRW = (const bf16*)(a.ws() + A_PRW); const bf16* PMLA = (const bf16*)(a.ws() + A_PMLA);
    bf16* AL = (bf16*)(a.ws() + A_ALORA); bf16* KF = (bf16*)(a.ws() + A_KF);
    float* rstd_q = (float*)(a.ws() + WS_RSTD); float* rstd_kv = rstd_q + GROWS;
    const float* rc = (const float*)(a.ws() + WS_ROPE); const float* rs = rc + SEQ * 32;
    const float* mu0 = a.in(I_MU) + (size_t)l * 2 * RWIN; const float* mu1 = mu0 + RWIN;
    const int lane = C.lane;
    constexpr int RB = 8, NU = GROWS / RB;
    for (int u = C.gw; u < NU; u += C.ngw) {
        const int r0 = u * RB, t0 = r0 & (SEQ - 1), c0 = (384 + lane) * 8;
        const bool act = lane < 52;
        float m0[8], m1[8];
#pragma unroll
        for (int i = 0; i < 8; ++i) { m0[i] = 0.f; m1[i] = 0.f; }
        if (act) {
#pragma unroll
            for (int h = 0; h < 2; ++h) { const f32x4 x0 = *(const f32x4*)(mu0 + c0 + 4 * h), x1 = *(const f32x4*)(mu1 + c0 + 4 * h);
#pragma unroll
                for (int i = 0; i < 4; ++i) { m0[4 * h + i] = x0[i]; m1[4 * h + i] = x1[i]; } }
        }
        const bf16* xr = PRW + (size_t)r0 * W_RW + c0;
        u32x4 pv = (u32x4){0u, 0u, 0u, 0u}, cv = *(const u32x4*)xr;
        if (t0 > 0) pv = *(const u32x4*)(xr - W_RW);
#pragma unroll
        for (int r = 0; r < RB; ++r) {
            const int row = r0 + r;
            const bool hn = t0 + r + 1 < SEQ;
            u32x4 nv = *(const u32x4*)(xr + (size_t)(hn ? r + 1 : r) * W_RW);
            if (!hn) nv = (u32x4){0u, 0u, 0u, 0u};
            float xp[8], x[8], xn[8], p[8], o[8];
            unpack8(pv, xp); unpack8(cv, x); unpack8(nv, xn);
#pragma unroll
            for (int i = 0; i < 8; ++i) p[i] = x[i] + m0[i] * (xp[i] - x[i]) + m1[i] * (xn[i] - x[i]);
            if (lane < 16) {
#pragma unroll
                for (int i = 0; i < 8; ++i) o[i] = tanhf(p[i]);
                store8(AL + (size_t)row * LORA_K + lane * 8, o);
            } else if (lane < 32) { store8(AL + (size_t)row * LORA_K + 128 + (lane - 16) * 8, p); }
            else if (lane < 52) {
#pragma unroll
                for (int i = 0; i < 8; ++i) o[i] = sigmoidf_(p[i]);
                store8(AL + (size_t)row * LORA_K + 256 + (lane - 32) * 8, o);
            } else {
#pragma unroll
                for (int i = 0; i < 8; ++i) o[i] = 0.f;
                store8(AL + (size_t)row * LORA_K + 416 + (lane - 52) * 8, o);
            }
            pv = cv; cv = nv;
        }
    }
    for (int row = C.gw; row < GROWS; row += C.ngw) {
        const int t = row & (SEQ - 1);
        const bf16* mr = PMLA + (size_t)row * W_MLA;
        { float q[8]; load8(mr + lane * 8, q); float ss = 0.f;
#pragma unroll
          for (int i = 0; i < 8; ++i) ss += q[i] * q[i];
          ss = wave_sum(ss); if (lane == 0) rstd_q[row] = rsqrtf(ss * (1.f / 512.f) + 1e-6f); }
        { float q[8]; float ss = 0.f;
          if (lane < 32) { load8(mr + 512 + lane * 8, q);
#pragma unroll
            for (int i = 0; i < 8; ++i) ss += q[i] * q[i]; }
          ss = wave_sum(ss); if (lane == 0) rstd_kv[row] = rsqrtf(ss * (1.f / 256.f) + 1e-6f); }
        if (lane < 8) {
            const u32x2 w1 = *(const u32x2*)(mr + 768 + 4 * lane), w2 = *(const u32x2*)(mr + 800 + 4 * lane);
            const float x1[4] = {bf_lo(w1.x), bf_hi(w1.x), bf_lo(w1.y), bf_hi(w1.y)}, x2[4] = {bf_lo(w2.x), bf_hi(w2.x), bf_lo(w2.y), bf_hi(w2.y)};
            const f32x4 cs = *(const f32x4*)(rc + t * 32 + 4 * lane), sn = *(const f32x4*)(rs + t * 32 + 4 * lane);
            float o[8];
#pragma unroll
            for (int i = 0; i < 4; ++i) { o[i] = x1[i] * cs[i] - x2[i] * sn[i]; o[4 + i] = x2[i] * cs[i] + x1[i] * sn[i]; }
            const u32x4 pk = pack8(o);
#pragma unroll
            for (int hh = 0; hh < 8; ++hh) *(u32x4*)(KF + (size_t)row * KFW + hh * 192 + 128 + 8 * lane) = pk;
        }
    }
}
__device__ __forceinline__ void phase_rwkv_post(const Ctx& C, int l) {
    const PT a(C);
    const bf16* OF = (const bf16*)(a.ws() + A_OF); const bf16* OB = (const bf16*)(a.ws() + A_OB); const bf16* PRW = (const bf16*)(a.ws() + A_PRW);
    const float* mu0 = a.in(I_MU) + (size_t)l * 2 * RWIN + 2048; const float* mu1 = mu0 + RWIN;
    const bf16* LO = (const bf16*)(a.ws() + A_LORAOUT); bf16* RO = (bf16*)(a.ws() + A_RWKVO);
    const float* bonus = (const float*)(a.ws() + WS_BONUS);
    const float* gng = a.in(I_GNG) + l * 1024; const float* gnb = a.in(I_GNB) + l * 1024;
    const int lane = C.lane;
    for (int row = C.gw; row < GROWS; row += C.ngw) {
        const int t = row & (SEQ - 1);
#pragma unroll
        for (int it = 0; it < 2; ++it) {
            const int c0 = (it * 64 + lane) * 8, hh = c0 >> 6;
            float of[8], ob[8], o[8], vv[8], gg[8];
            load8(OF + (size_t)row * 1024 + c0, of); load8(OB + (size_t)row * 1024 + c0, ob);
            { const bf16* vr = PRW + (size_t)row * W_RW + 2048 + c0; float x[8], xp[8], xn[8]; load8(vr, x); load8(t > 0 ? vr - W_RW : vr, xp); load8(t < SEQ - 1 ? vr + W_RW : vr, xn);
              const f32x4 ma = *(const f32x4*)(mu0 + c0), mb = *(const f32x4*)(mu0 + c0 + 4), na = *(const f32x4*)(mu1 + c0), nb = *(const f32x4*)(mu1 + c0 + 4);
              const float zp = t > 0 ? 1.f : 0.f, zn = t < SEQ - 1 ? 1.f : 0.f;
#pragma unroll
              for (int i = 0; i < 4; ++i) { vv[i] = x[i] + ma[i] * (xp[i] * zp - x[i]) + na[i] * (xn[i] * zn - x[i]); vv[4 + i] = x[4 + i] + mb[i] * (xp[4 + i] * zp - x[4 + i]) + nb[i] * (xn[4 + i] * zn - x[4 + i]); } }
            load8(LO + (size_t)row * LORA_N + 4096 + c0, gg);
            float s = 0.f;
#pragma unroll
            for (int i = 0; i < 8; ++i) { o[i] = of[i] + ob[i]; s += o[i]; }
            const float mean = reduce8(s) * (1.f / 64.f);
            float q = 0.f;
#pragma unroll
            for (int i = 0; i < 8; ++i) { o[i] -= mean; q += o[i] * o[i]; }
            const float rstd = rsqrtf(reduce8(q) * (1.f / 64.f) + 64e-5f);
            const float bn = bonus[(size_t)row * 16 + hh] + bonus[(size_t)(GROWS + row) * 16 + hh];
            const f32x4 g0 = *(const f32x4*)(gng + c0), g1 = *(const f32x4*)(gng + c0 + 4), b0 = *(const f32x4*)(gnb + c0), b1 = *(const f32x4*)(gnb + c0 + 4);
            float y[8];
#pragma unroll
            for (int i = 0; i < 4; ++i) { y[i] = (o[i] * rstd * g0[i] + b0[i] + bn * vv[i]) * gg[i]; y[4 + i] = (o[4 + i] * rstd * g1[i] + b1[i] + bn * vv[4 + i]) * gg[4 + i]; }
            store8(RO + (size_t)row * 1024 + c0, y);
        }
    }
}
__device__ __forceinline__ void phase_act_fix(const Ctx& C, int l) {
    const PT a(C);
    const bf16* EA = (const bf16*)(a.ws() + A_EA); const bf16* EB = (const bf16*)(a.ws() + A_EB); bf16* ACT = (bf16*)(a.ws() + A_ACT);
    const float* cw = a.in(I_CONVW) + (size_t)l * 3 * DFF; const float* cb = a.in(I_CONVB) + (size_t)l * DFF;
    constexpr int NT = GROWS / 256, NR = NT * 8;
    for (int u = C.gw; u < NR; u += C.ngw) {
        const int tile = u >> 3, blk = (u >> 1) & 3, e = u & 1;
        const size_t eb = (size_t)tile * 4 + blk, tok = (size_t)tile * 256 + blk * 64 + (e ? 63 : 0);
        const bf16* ac = EA + (eb * 4 + (e ? 3 : 0)) * DFF; const bf16* bc = EB + (eb * 2 + e) * DFF;
        const bf16* apv; const bf16* anx; float zp = 1.f, zn = 1.f;
        if (e == 0) { anx = EA + (eb * 4 + 1) * DFF;
            if (blk > 0) apv = EA + ((eb - 1) * 4 + 3) * DFF; else if ((tile & 15) != 0) apv = EA + ((eb - 1) * 4 + 3) * DFF; else { apv = ac; zp = 0.f; } }
        else { apv = EA + (eb * 4 + 2) * DFF;
            if (blk < 3) anx = EA + ((eb + 1) * 4 + 0) * DFF; else if ((tile & 15) != 15) anx = EA + ((eb + 1) * 4 + 0) * DFF; else { anx = ac; zn = 0.f; } }
#pragma unroll 1
        for (int it = 0; it < 11; ++it) {
            const int c0 = (it * 64 + C.lane) * 8;
            float x[8], xp[8], xn[8], b[8], o[8];
            load8(ac + c0, x); load8(apv + c0, xp); load8(anx + c0, xn); load8(bc + c0, b);
#pragma unroll
            for (int h = 0; h < 2; ++h) {
                const f32x4 w0 = *(const f32x4*)(cw + c0 + 4 * h), w1 = *(const f32x4*)(cw + DFF + c0 + 4 * h), w2 = *(const f32x4*)(cw + 2 * DFF + c0 + 4 * h), bb = *(const f32x4*)(cb + c0 + 4 * h);
#pragma unroll
                for (int i = 0; i < 4; ++i) { const int j = 4 * h + i; const float cc = xp[j] * zp * w0[i] + x[j] * w1[i] + xn[j] * zn * w2[i] + bb[i]; o[j] = cc * sigmoidf_(cc) * b[j]; }
            }
            store8(ACT + tok * DFF + c0, o);
        }
    }
}

constexpr int SCAN_T = 32, SCAN_STEP_F = 384, SCAN_BUF_F = SCAN_T * SCAN_STEP_F;
static_assert((2 * SCAN_BUF_F + 2 * SCAN_T * 64) * 4 + 2 * 2 * SCAN_T * 64 * 2 <= RING_BYTES, "scan LDS");
__device__ __forceinline__ void scan_chain(const Ctx& C, int l, int ch) {
    const PT a(C);
    const bf16* PRW = (const bf16*)(a.ws() + A_PRW); const bf16* AL = (const bf16*)(a.ws() + A_ALORA);
    float* bonus = (float*)(a.ws() + WS_BONUS);
    LAS float* buf = (LAS float*)C.lds;
    LAS float* obuf = buf + 2 * SCAN_BUF_F;
    LAS bf16* xs = (LAS bf16*)(obuf + 2 * SCAN_T * 64);
    const int tid = C.tid, lane = C.lane;
    const int d = ch & 1, hh = (ch >> 1) & 15, sq = ch >> 5;
    bf16* OD = (bf16*)(a.ws() + (d ? A_OB : A_OF));
    const bool loader = tid >= 256;
    const int lid = tid - 256, lj = lid >> 3, lg = lid & 7, chn = hh * 64 + lg * 8;
    float ka[8], rk[8], kkw[8], m0r[8], m1r[8], m0k[8], m1k[8], m0v[8], m1v[8];
    u32x4 g_r, g_rp, g_rn, g_k, g_kp, g_kn, g_v, g_vp, g_vn;
    const int mtx = (C.wave >> 1) & 1, nb = C.wave & 1, r32 = lane & 31, hi = lane >> 5;
    bf16x8 Bf[4]; float lbias = 0.f;
    if (loader) {
        const float* Wm = (mtx ? a.in(I_WICLR) : a.in(I_WDEC)) + (size_t)(l * 2 + d) * 64 * 1024 + hh * 64 + nb * 32 + r32;
#pragma unroll
        for (int ks = 0; ks < 4; ++ks) { float t_[8];
#pragma unroll
            for (int j = 0; j < 8; ++j) t_[j] = Wm[(size_t)(ks * 16 + hi * 8 + j) * 1024];
            Bf[ks] = __builtin_bit_cast(bf16x8, pack8(t_)); }
        lbias = (mtx ? a.in(I_A0) : a.in(I_W0))[l * 2048 + d * 1024 + hh * 64 + nb * 32 + r32];
    }
    if (loader) {
        const float* mu0 = a.in(I_MU) + (size_t)l * 2 * RWIN; const float* mu1 = mu0 + RWIN;
#define LD8F(dst, p) do { const f32x4 x0_ = *(const f32x4*)(p), x1_ = *(const f32x4*)((p) + 4); _Pragma("unroll") for (int i = 0; i < 4; ++i) { dst[i] = x0_[i]; dst[4 + i] = x1_[i]; } } while (0)
        LD8F(ka, a.in(I_KA) + l * 1024 + chn); LD8F(rk, a.in(I_RK) + ((size_t)(l * 2 + d) * 16 + hh) * 64 + lg * 8); LD8F(kkw, a.in(I_KK) + l * 1024 + chn);
        LD8F(m0r, mu0 + chn); LD8F(m1r, mu1 + chn); LD8F(m0k, mu0 + 1024 + chn); LD8F(m1k, mu1 + 1024 + chn); LD8F(m0v, mu0 + 2048 + chn); LD8F(m1v, mu1 + 2048 + chn);
#undef LD8F
    }
#define SC_TOK(step) (d ? (SEQ - 1 - (step)) : (step))
#define SC_ISSUE(cn) do { const int tok_ = SC_TOK((cn) * SCAN_T + lj), row_ = sq * SEQ + tok_; const bf16* rp_ = PRW + (size_t)row_ * W_RW + chn; \
        const int op_ = tok_ > 0 ? -W_RW : 0, on_ = tok_ < SEQ - 1 ? W_RW : 0; \
        g_r = *(const u32x4*)rp_; g_rp = *(const u32x4*)(rp_ + op_); g_rn = *(const u32x4*)(rp_ + on_); g_k = *(const u32x4*)(rp_ + 1024); g_kp = *(const u32x4*)(rp_ + 1024 + op_); g_kn = *(const u32x4*)(rp_ + 1024 + on_); \
        g_v = *(const u32x4*)(rp_ + 2048); g_vp = *(const u32x4*)(rp_ + 2048 + op_); g_vn = *(const u32x4*)(rp_ + 2048 + on_); } while (0)
#define ST8(p, x) do { *(LAS f32x4*)(p) = (f32x4){x[0], x[1], x[2], x[3]}; *(LAS f32x4*)((p) + 4) = (f32x4){x[4], x[5], x[6], x[7]}; } while (0)
#define SC_MIX(dst, gc, gp, gn, m0, m1) do { float x_[8], xp_[8], xn_[8]; unpack8(gc, x_); unpack8(gp, xp_); unpack8(gn, xn_); \
        _Pragma("unroll") for (int i = 0; i < 8; ++i) dst[i] = x_[i] + m0[i] * (xp_[i] * zp_ - x_[i]) + m1[i] * (xn_[i] * zn_ - x_[i]); } while (0)
#define SC_WRITE(cn) do { float r_[8], k_[8], v_[8], kk_[8], w_[8], a_[8]; unpack8(*(const LAS u32x4*)(xs + (((cn) & 1) * 2 + 0) * 2048 + lj * 64 + lg * 8), w_); unpack8(*(const LAS u32x4*)(xs + (((cn) & 1) * 2 + 1) * 2048 + lj * 64 + lg * 8), a_); \
        { const int tok_ = SC_TOK((cn) * SCAN_T + lj); const float zp_ = tok_ > 0 ? 1.f : 0.f, zn_ = tok_ < SEQ - 1 ? 1.f : 0.f; \
          SC_MIX(r_, g_r, g_rp, g_rn, m0r, m1r); SC_MIX(k_, g_k, g_kp, g_kn, m0k, m1k); SC_MIX(v_, g_v, g_vp, g_vn, m0v, m1v); \
          float ss_ = 0.f; _Pragma("unroll") for (int i = 0; i < 8; ++i) { kk_[i] = k_[i] * kkw[i]; ss_ += kk_[i] * kk_[i]; } \
          ss_ = reduce8(ss_); const float inv_ = 1.f / fmaxf(sqrtf(ss_), 1e-12f); _Pragma("unroll") for (int i = 0; i < 8; ++i) kk_[i] *= inv_; } \
        LAS float* bp_ = buf + ((cn) & 1) * SCAN_BUF_F + lj * SCAN_STEP_F + lg * 8; float bs_ = 0.f; \
        float G_[8], kt_[8], at_[8], bt_[8], rt_[8]; \
        _Pragma("unroll") for (int i = 0; i < 8; ++i) { G_[i] = __builtin_amdgcn_exp2f(-0.8750387749f * w_[i]); const float kd_ = k_[i] * (1.f + (a_[i] - 1.f) * ka[i]); bs_ += r_[i] * kd_ * rk[i]; bt_[i] = kd_; at_[i] = kk_[i] * a_[i]; } \
        _Pragma("unroll") for (int off_ = 8; off_ < 64; off_ <<= 1) { _Pragma("unroll") for (int i = 0; i < 8; ++i) { const float y_ = __shfl_up(G_[i], off_); if (lane >= off_) G_[i] *= y_; } } \
        _Pragma("unroll") for (int i = 0; i < 8; ++i) { float gp_ = __shfl_up(G_[i], 8); if (lane < 8) gp_ = 1.f; const float rg_ = 1.f / G_[i]; kt_[i] = kk_[i] * gp_; at_[i] *= rg_; bt_[i] *= rg_; rt_[i] = r_[i] * G_[i]; } \
        ST8(bp_, G_); ST8(bp_ + 64, kt_); ST8(bp_ + 128, at_); ST8(bp_ + 192, bt_); ST8(bp_ + 256, rt_); ST8(bp_ + 320, v_); \
        bs_ = reduce8(bs_); if (lg == 0) { const int row_ = sq * SEQ + SC_TOK((cn) * SCAN_T + lj); bonus[((size_t)d * GROWS + row_) * 16 + hh] = bs_; } } while (0)
#define SC_LORA(cn) do { const bf16* ap_ = AL + (size_t)(sq * SEQ + SC_TOK((cn) * SCAN_T + r32)) * LORA_K + mtx * 128 + d * 64 + hi * 8; f32x16 acc_ = {}; \
        _Pragma("unroll") for (int ks = 0; ks < 4; ++ks) acc_ = __builtin_amdgcn_mfma_f32_32x32x16_bf16(*(const bf16x8*)(ap_ + ks * 16), Bf[ks], acc_, 0, 0, 0); \
        LAS bf16* xp_ = xs + (((cn) & 1) * 2 + mtx) * 2048 + nb * 32 + r32; \
        _Pragma("unroll") for (int r = 0; r < 16; ++r) xp_[att::crow(r, hi) * 64] = (bf16)(cvt_pk_bf16(sigmoidf_(acc_[r] + lbias), 0.f) & 0xffffu); } while (0)
#define SC_OUT(cn) do { const LAS float* op_ = obuf + ((cn) & 1) * (SCAN_T * 64) + lj * 64 + lg * 8; const f32x4 o0_ = *(const LAS f32x4*)op_, o1_ = *(const LAS f32x4*)(op_ + 4); \
        const int row_ = sq * SEQ + SC_TOK((cn) * SCAN_T + lj); u32x4 w_; w_.x = cvt_pk_bf16(o0_[0], o0_[1]); w_.y = cvt_pk_bf16(o0_[2], o0_[3]); w_.z = cvt_pk_bf16(o1_[0], o1_[1]); w_.w = cvt_pk_bf16(o1_[2], o1_[3]); \
        *(u32x4*)(OD + (size_t)row_ * 1024 + hh * 64 + lg * 8) = w_; } while (0)
    constexpr int NCH = SEQ / SCAN_T;
    const int rloc = (C.wave & 3) * 8 + (lane >> 3), cg = lane & 7;
    f32x2 s01 = {0.f, 0.f}, s23 = {0.f, 0.f}, s45 = {0.f, 0.f}, s67 = {0.f, 0.f};
    f32x2 t01 = {0.f, 0.f}, t23 = {0.f, 0.f}, t45 = {0.f, 0.f}, t67 = {0.f, 0.f};
    if (loader) SC_LORA(0);
    __syncthreads();
    if (loader) { SC_ISSUE(0); SC_WRITE(0); SC_LORA(1); }
    __syncthreads();
#pragma unroll 1
    for (int cn = 0; cn < NCH; ++cn) {
        if (loader) {
            if (cn + 1 < NCH) SC_ISSUE(cn + 1);
            if (cn + 2 < NCH) SC_LORA(cn + 2);
            if (cn > 0) SC_OUT(cn - 1);
            if (cn + 1 < NCH) SC_WRITE(cn + 1);
        } else {
            const unsigned ba = (unsigned)(uintptr_t)(buf + (cn & 1) * SCAN_BUF_F + cg * 8);
            const unsigned va = (unsigned)(uintptr_t)(buf + (cn & 1) * SCAN_BUF_F + 320 + rloc);
            LAS float* op = obuf + (cn & 1) * (SCAN_T * 64) + rloc;
#define DSR128(dst, addr, off) asm volatile("ds_read_b128 %0, %1 offset:%2" : "=v"(dst) : "v"(addr), "n"(off))
#define DSR32(dst, addr, off) asm volatile("ds_read_b32 %0, %1 offset:%2" : "=v"(dst) : "v"(addr), "n"(off))
#define SC_LDE(j) do { DSR128(Ek0, ba, (j) * 1536 + 256); DSR128(Ek1, ba, (j) * 1536 + 272); DSR128(Ed0, ba, (j) * 1536 + 768); DSR128(Ed1, ba, (j) * 1536 + 784); DSR32(Evv, va, (j) * 1536); DSR32(Evu, va, (j) * 1536 + 128); } while (0)
#define SC_LDL(j) do { DSR128(La0, ba, (j) * 1536 + 512); DSR128(La1, ba, (j) * 1536 + 528); DSR128(Lr0, ba, (j) * 1536 + 1024); DSR128(Lr1, ba, (j) * 1536 + 1040); \
        if ((((j) & 7) == 7)) { DSR128(Lg0, ba, (j) * 1536); DSR128(Lg1, ba, (j) * 1536 + 16); } } while (0)
#define LO2(v) __builtin_shufflevector(v, v, 0, 1)
#define HI2(v) __builtin_shufflevector(v, v, 2, 3)
#define SC_STEP(j) do { \
        if ((((j) & 7) == 7)) asm volatile("s_waitcnt lgkmcnt(6)" : "+v"(Ek0), "+v"(Ek1), "+v"(Ed0), "+v"(Ed1), "+v"(Evv), "+v"(Evu)); \
        else asm volatile("s_waitcnt lgkmcnt(4)" : "+v"(Ek0), "+v"(Ek1), "+v"(Ed0), "+v"(Ed1), "+v"(Evv), "+v"(Evu)); \
        if ((j) > 0) { const float q_ = reduce8(cqs_); const float qv_ = reduce8(cqt_); op[((j) - 1) * 64] = q_; op[((j) - 1) * 64 + 32] = qv_; }     \
        f32x2 pp_ = s01 * LO2(Ek0); f32x2 pu_ = t01 * LO2(Ek0); pp_ = s23 * HI2(Ek0) + pp_; pu_ = t23 * HI2(Ek0) + pu_; pp_ = s45 * LO2(Ek1) + pp_; pu_ = t45 * LO2(Ek1) + pu_; pp_ = s67 * HI2(Ek1) + pp_; pu_ = t67 * HI2(Ek1) + pu_; \
        float p_ = reduce8(pp_[0] + pp_[1]); float pq_ = reduce8(pu_[0] + pu_[1]); const f32x2 v2_ = {Evv, Evv}, u2_ = {Evu, Evu}; \
        s01 = v2_ * LO2(Ed0) + s01; s23 = v2_ * HI2(Ed0) + s23; s45 = v2_ * LO2(Ed1) + s45; s67 = v2_ * HI2(Ed1) + s67; \
        t01 = u2_ * LO2(Ed0) + t01; t23 = u2_ * HI2(Ed0) + t23; t45 = u2_ * LO2(Ed1) + t45; t67 = u2_ * HI2(Ed1) + t67; \
        asm volatile("" : "+v"(s01), "+v"(s23), "+v"(s45), "+v"(s67), "+v"(t01), "+v"(t23), "+v"(t45), "+v"(t67), "+v"(p_), "+v"(pq_));     \
        SC_LDE((j) + 1); \
        if ((((j) & 7) == 7)) asm volatile("s_waitcnt lgkmcnt(6)" : "+v"(La0), "+v"(La1), "+v"(Lr0), "+v"(Lr1), "+v"(Lg0), "+v"(Lg1)); \
        else asm volatile("s_waitcnt lgkmcnt(6)" : "+v"(La0), "+v"(La1), "+v"(Lr0), "+v"(Lr1)); \
        { const f32x2 p2_ = {p_, p_}, q2_ = {pq_, pq_}; \
        s01 = s01 - p2_ * LO2(La0); s23 = s23 - p2_ * HI2(La0); s45 = s45 - p2_ * LO2(La1); s67 = s67 - p2_ * HI2(La1); \
        t01 = t01 - q2_ * LO2(La0); t23 = t23 - q2_ * HI2(La0); t45 = t45 - q2_ * LO2(La1); t67 = t67 - q2_ * HI2(La1); } \
        f32x2 qq_ = s01 * LO2(Lr0); f32x2 qu_ = t01 * LO2(Lr0); qq_ = s23 * HI2(Lr0) + qq_; qu_ = t23 * HI2(Lr0) + qu_; qq_ = s45 * LO2(Lr1) + qq_; qu_ = t45 * LO2(Lr1) + qu_; qq_ = s67 * HI2(Lr1) + qq_; qu_ = t67 * HI2(Lr1) + qu_; \
        if ((((j) & 7) == 7)) { s01 *= LO2(Lg0); s23 *= HI2(Lg0); s45 *= LO2(Lg1); s67 *= HI2(Lg1); t01 *= LO2(Lg0); t23 *= HI2(Lg0); t45 *= LO2(Lg1); t67 *= HI2(Lg1); }     \
        asm volatile("" : "+v"(qq_), "+v"(qu_), "+v"(s01), "+v"(s23), "+v"(s45), "+v"(s67), "+v"(t01), "+v"(t23), "+v"(t45), "+v"(t67));     \
        SC_LDL((j) + 1); \
        cqs_ = qq_[0] + qq_[1]; cqt_ = qu_[0] + qu_[1]; } while (0)
            f32x4 Ek0, Ek1, Ed0, Ed1, La0, La1, Lr0, Lr1, Lg0, Lg1; float Evv, Evu; float cqs_ = 0.f, cqt_ = 0.f;
            SC_LDE(0); SC_LDL(0);
#pragma unroll
            for (int j = 0; j < SCAN_T; ++j) SC_STEP(j);
            { const float q_ = reduce8(cqs_); const float qv_ = reduce8(cqt_); op[(SCAN_T - 1) * 64] = q_; op[(SCAN_T - 1) * 64 + 32] = qv_; }
            asm volatile("s_waitcnt lgkmcnt(0)" : "+v"(Ek0), "+v"(Ek1), "+v"(Ed0), "+v"(Ed1), "+v"(Evv), "+v"(Evu), "+v"(La0), "+v"(La1), "+v"(Lr0), "+v"(Lr1), "+v"(Lg0), "+v"(Lg1));
#undef DSR128
#undef DSR32
#undef SC_LDE
#undef SC_LDL
#undef SC_STEP
#undef LO2
#undef HI2
        }
        __syncthreads();
    }
    if (loader) SC_OUT(NCH - 1);
    __syncthreads();
#undef SC_TOK
#undef SC_ISSUE
#undef SC_LORA
#undef SC_MIX
#undef SC_WRITE
#undef SC_OUT
#undef ST8
}

constexpr int NT_STEPS = 12;
constexpr int N_STEPS = 1 + NLAYER * (1 + NGRP * NT_STEPS) + 1;
#ifndef NL_BUILD
#define NL_BUILD NLAYER
#endif
#ifndef NG_BUILD
#define NG_BUILD NGRP
#endif

#define IN_STEP(k) (lo <= (sbase + (k)) && (sbase + (k)) < hi)
#define END_STEP(k) do { if (sbase + (k) + 1 < hi) { const PT pb_(C); XcdBarrier bar_; bar_.bar = (unsigned*)(pb_.ws() + WS_CTL) + CW_BAR; bar_.x = xb_xcc_id(); bar_.st = (volatile LAS unsigned*)(C.lds + MISC_OFF) + 8; xcd_barrier(bar_); } } while (0)
#define STEP_PTRS const PT a(C); unsigned char* const ws = a.ws(); (void)ws; \
    const float* const mod = (const float*)(ws + WS_MOD); bf16* const wb = (bf16*)(ws + WS_W); (void)wb; \
    const float* const xsrc = (L == 0) ? ((GI < 2) ? a.in(I_XP) + grow0 * DM : a.in(I_XS) + (grow0 - 32768) * DM) : a.out() + grow0 * DM; (void)xsrc; \
    float* const xout = a.out() + grow0 * DM; (void)xout; \
    const float* const modb = mod + ((size_t)L * 12 + GI * 4) * NMOD; (void)modb;

template <int L, int GI>
__device__ __forceinline__ void group_program(const Ctx& C, const int lo, const int hi) {
    constexpr int sbase = 1 + L * (1 + NGRP * NT_STEPS) + 1 + GI * NT_STEPS;
    constexpr size_t grow0 = (size_t)GI * GROWS;
    const int gdim = gridDim.x, bidx = blockIdx.x;
    if (EN(2) && IN_STEP(0)) { if constexpr (L == 0 && GI == 0) { REPEAT(2) { STEP_PTRS; phase_modnorm(C, C.gw, C.ngw, xsrc, (bf16*)(ws + A_H), a.in(I_NMIXG) + L * DM, modb, 0, 1); } END_STEP(0); } }
    if (EN(3) && IN_STEP(1)) { REPEAT(3) { STEP_PTRS;
        pg8::Gemm gm{(const bf16*)(ws + A_H), (const bf16*)((char*)wb + WO_IN), GROWS, NPROJ - 256, DM, DM, DM}; pg8::StaticOrder S; S.init(GROWS, NPROJ - 256, gdim, bidx);
        pg8::EpiG<FProj> E{FProj{(bf16*)(ws + A_PMLA), (bf16*)(ws + A_PRW), (bf16*)(ws + A_PGATE)}};
        pg8::gemm_phase<pg8::EpiG<FProj>, pg8::StaticOrder, PG8_ALIGN, PG8_SP2>(C.lds, gm, S, E); }
        END_STEP(1); }
    if (EN(4) && IN_STEP(2)) { REPEAT(4) { phase_prep(C, L); } END_STEP(2); }
    if (EN(5) && IN_STEP(3)) { REPEAT(5) {
        { STEP_PTRS; pg8::Gemm gm{(const bf16*)(ws + A_ALORA) + 256, (const bf16*)((char*)wb + WO_LORA) + (size_t)4096 * LORA_KB, GROWS, 1024, LORA_KB, LORA_K, LORA_KB}; pg8::StaticOrder S; S.init(GROWS, 1024, gdim, bidx);
          pg8::EpiG<FLora> E{FLora{(bf16*)(ws + A_LORAOUT), a.in(I_W0) + L * 2048, a.in(I_A0) + L * 2048, 4096}};
          pg8::gemm_phase<pg8::EpiG<FLora>, pg8::StaticOrder, PG8_ALIGN, PG8_SP2>(C.lds, gm, S, E); }
        { STEP_PTRS; pg8::Gemm gm{(const bf16*)(ws + A_PMLA), (const bf16*)((char*)wb + WO_UQ), GROWS, QW, 512, W_MLA, 512}; pg8::SkewOrder<2, 0, 2> S; S.init(GROWS, QW, gdim, bidx);
          pg8::EpiG<FQ> E{FQ{(bf16*)(ws + A_Q), (const float*)(ws + WS_RSTD), (const float*)(ws + WS_ROPE), (const float*)(ws + WS_ROPE) + SEQ * 32}};
          pg8::gemm_phase<pg8::EpiG<FQ>, pg8::SkewOrder<2, 0, 2>, PG8_ALIGN, PG8_SP2>(C.lds, gm, S, E); }
        { STEP_PTRS; pg8::Gemm gm{(const bf16*)(ws + A_PMLA) + 512, (const bf16*)((char*)wb + WO_UKV), GROWS, 2048, 256, W_MLA, 256}; pg8::SkewOrder<3, 0, 2> S; S.init(GROWS, 2048, gdim, bidx);
          pg8::EpiG<FKV> E{FKV{(bf16*)(ws + A_KF), (bf16*)(ws + A_V), (const float*)(ws + WS_RSTD) + GROWS}};
          pg8::gemm_phase<pg8::EpiG<FKV>, pg8::SkewOrder<3, 0, 2>, PG8_ALIGN, PG8_SP2>(C.lds, gm, S, E); }
        { STEP_PTRS; pg8::Gemm gm{(const bf16*)(ws + A_H), (const bf16*)((char*)wb + WO_IN) + (size_t)(NPROJ - 256) * DM, GROWS, 256, DM, DM, DM}; pg8::SkewOrder<0, 1, 0> S; S.init(GROWS, 256, gdim, bidx);
          pg8::EpiG<FStore> E{FStore{(bf16*)(ws + A_PGATE) + (W_GATE - 256), W_GATE}};
          pg8::gemm_phase<pg8::EpiG<FStore>, pg8::SkewOrder<0, 1, 0>, PG8_ALIGN, PG8_SP2>(C.lds, gm, S, E); } }
        END_STEP(3); }
    if (EN(6) && IN_STEP(4)) { { STEP_PTRS;
        const bool split = (gdim == 256);
        const int xcd = bidx & 7, bi = (bidx >> 3) & 15;
        for (int rp_ = 0; rp_ < (((PROBE_MASK >> 6) & 1) ? 2 : 1); ++rp_)
        for (int pr = bidx; pr < 128; pr += gdim) scan_chain(C, L, pr);
        const int r0 = 0, nr = split ? (bidx < 128 ? 0 : 4) : (512 - bidx + gdim - 1) / gdim;
        for (int k = 0; k < nr * (((PROBE_MASK >> 7) & 1) ? 2 : 1); ++k) {
            const int kk = k % (nr > 0 ? nr : 1);
            int pi, qb;
            if (split) { pi = xcd + 8 * (r0 + kk); qb = bi; } else { const int u = bidx + kk * gdim; pi = u >> 4; qb = u & 15; }
            const int hh = pi & 7, sq = pi >> 3;
            const bf16* Qb = (const bf16*)(ws + A_Q) + ((size_t)sq * SEQ + qb * 256) * QW + hh * 192;
            const bf16* Kh = (const bf16*)(ws + A_KF) + (size_t)sq * SEQ * KFW + hh * 192;
            const bf16* Vh = (const bf16*)(ws + A_V) + (size_t)sq * SEQ * VW + hh * 128;
            bf16* Ob = (bf16*)(ws + A_ATTO) + ((size_t)sq * SEQ + qb * 256) * 1024 + hh * 128;
            att::attn_unit(Qb, Kh, Vh, Ob, SEQ, (LAS char*)C.lds);
        }
        constexpr int NL_ = (GI == NGRP - 1) ? L + 1 : L, NG_ = (GI == NGRP - 1) ? 0 : GI + 1;
        if constexpr (NL_ < NLAYER) {
            constexpr size_t ngrow0 = (size_t)NG_ * GROWS;
            const float* nx = (NL_ == 0) ? ((NG_ < 2) ? a.in(I_XP) + ngrow0 * DM : a.in(I_XS) + (ngrow0 - 32768) * DM) : a.out() + ngrow0 * DM;
            const float* nmodb = mod + ((size_t)NL_ * 12 + NG_ * 4) * NMOD;
            if (split) { if (bidx >= 128) phase_modnorm(C, (bidx - 128) * NWAVES + C.wave, 128 * NWAVES, nx, (bf16*)(ws + A_H), a.in(I_NMIXG) + NL_ * DM, nmodb, 0, 1); }
            else phase_modnorm(C, C.gw, C.ngw, nx, (bf16*)(ws + A_H), a.in(I_NMIXG) + NL_ * DM, nmodb, 0, 1);
        }
        if constexpr (L == NLAYER - 1 && GI >= 1) {
            if (split) { if (bidx >= 128) phase_final(C, (bidx - 128) * NWAVES + C.wave, 128 * NWAVES, (GI - 1) * GROWS, GI * GROWS, a.out(), a.in(I_FNG)); }
            else phase_final(C, C.gw, C.ngw, (GI - 1) * GROWS, GI * GROWS, a.out(), a.in(I_FNG));
        } }
        END_STEP(4); }
    if (EN(7) && IN_STEP(5)) { REPEAT(15) { phase_rwkv_post(C, L); } END_STEP(5); }
    if (EN(8) && IN_STEP(6)) { REPEAT(8) {
        { STEP_PTRS; pg8::Gemm gm{(const bf16*)(ws + A_ATTO), (const bf16*)((char*)wb + WO_OATT), GROWS, DM, 1024, 1024, 1024}; pg8::StaticOrder S; S.init(GROWS, DM, gdim, bidx);
          pg8::EpiG<FMergeA> E{FMergeA{(bf16*)(ws + A_MERGED), (const bf16*)(ws + A_PGATE)}};
          pg8::gemm_phase<pg8::EpiG<FMergeA>, pg8::StaticOrder, PG8_ALIGN, PG8_SP2>(C.lds, gm, S, E); }
        VM_WAIT(); __syncthreads();
        { STEP_PTRS; pg8::Gemm gm{(const bf16*)(ws + A_RWKVO), (const bf16*)((char*)wb + WO_ORWKV), GROWS, DM, 1024, 1024, 1024}; pg8::StaticOrder S; S.init(GROWS, DM, gdim, bidx);
          pg8::EpiG<FMergeB> E{FMergeB{(bf16*)(ws + A_MERGED), (const bf16*)(ws + A_PGATE)}};
          pg8::gemm_phase<pg8::EpiG<FMergeB>, pg8::StaticOrder, PG8_ALIGN, PG8_SP2>(C.lds, gm, S, E); }
          VM_WAIT(); __syncthreads(); }
        END_STEP(6); }
    if (EN(9) && IN_STEP(7)) { _Pragma("unroll") for (int rep_ = 0; rep_ < ((((PROBE_MASK >> 9) & 1) && L == 0) ? 2 : 1); ++rep_) { STEP_PTRS;
        pg8::Gemm gm{(const bf16*)(ws + A_MERGED), (const bf16*)((char*)wb + WO_OUT), GROWS, DM, DM, DM, DM}; pg8::StaticOrder S; S.init(GROWS, DM, gdim, bidx);
        pg8::EpiG<FResid> E{FResid{xsrc, xout, modb + 2 * DM}};
        pg8::gemm_phase<pg8::EpiG<FResid>, pg8::StaticOrder, false, PG8_SP2>(C.lds, gm, S, E); }
        END_STEP(7); }
    if (EN(10) && IN_STEP(8)) { REPEAT(10) { STEP_PTRS; phase_modnorm(C, C.gw, C.ngw, xout, (bf16*)(ws + A_H2), a.in(I_NFFNG) + L * DM, modb, 3, 4); } END_STEP(8); }
    if (EN(11) && IN_STEP(9)) { { STEP_PTRS;
        pg8::Gemm gm{(const bf16*)(ws + A_H2), (const bf16*)((char*)wb + WO_UP), GROWS, 2 * DFF, DM, DM, DM}; pg8::StaticOrder S; S.init(GROWS, 2 * DFF, gdim, bidx);
        EpiAct E{(bf16*)(ws + A_ACT), (bf16*)(ws + A_EA), (bf16*)(ws + A_EB), a.in(I_CONVW) + (size_t)L * 3 * DFF, a.in(I_CONVB) + (size_t)L * DFF};
        pg8::gemm_phase<EpiAct, pg8::StaticOrder, PG8_ALIGN, PG8_SP2, true>(C.lds, gm, S, E); }
        END_STEP(9); }
    if (EN(12) && IN_STEP(10)) { phase_act_fix(C, L); END_STEP(10); }
    if (EN(13) && IN_STEP(11)) { { STEP_PTRS;
        pg8::Gemm gm{(const bf16*)(ws + A_ACT), (const bf16*)((char*)wb + WO_DOWN), GROWS, DM, DFF, DFF, DFF}; pg8::StaticOrder S; S.init(GROWS, DM, gdim, bidx);
        pg8::EpiG<FResid> E{FResid{xout, xout, modb + 5 * DM}};
        pg8::gemm_phase<pg8::EpiG<FResid>, pg8::StaticOrder, false, PG8_SP2>(C.lds, gm, S, E); }
        if constexpr (GI == NGRP - 1) END_STEP(11);
    }
}
template <int L>
__device__ __forceinline__ void layer_program(const Ctx& C, const int lo, const int hi) {
    constexpr int sbase = 1 + L * (1 + NGRP * NT_STEPS);
    if (EN(1) && IN_STEP(0)) { if constexpr (L > 0) { phase_convert(C, L); END_STEP(0); } }
    group_program<L, 0>(C, lo, hi);
    if constexpr (NG_BUILD > 1) group_program<L, 1>(C, lo, hi);
    if constexpr (NG_BUILD > 2) group_program<L, 2>(C, lo, hi);
}

__global__ void __launch_bounds__(NWAVES * 64, 2) mk_fwd(Args a) {
    extern __shared__ __attribute__((aligned(16))) unsigned char lds_raw[];
    Ctx C;
    C.lds = (LAS unsigned char*)lds_raw;
    C.tid = threadIdx.x; C.lane = C.tid & 63; C.wave = __builtin_amdgcn_readfirstlane(C.tid >> 6);
    C.gw = blockIdx.x * NWAVES + C.wave; C.ngw = gridDim.x * NWAVES;
    for (int u = C.tid; u < (LDS_BYTES - LDSCTL_OFF) / 4; u += NWAVES * 64) ((LAS unsigned*)(C.lds + LDSCTL_OFF))[u] = 0u;
    __syncthreads();
    if (C.tid == 0) {
        LAS unsigned long long* t = (LAS unsigned long long*)(C.lds + ARGTAB_OFF);
#pragma unroll
        for (int i = 0; i < 32; ++i) t[i] = (unsigned long long)a.in[i];
        t[32] = (unsigned long long)a.out; t[33] = (unsigned long long)a.ws;
    }
    __syncthreads();
    const int lo = a.lo, hi = a.hi;
    if (hi - lo > 1) (void)xcd_barrier_post((unsigned*)(a.ws + WS_CTL) + CW_BAR, (volatile LAS unsigned*)(C.lds + MISC_OFF) + 8);
    { constexpr int sbase = 0; if (EN(0) && IN_STEP(0)) { phase_mod(C); __syncthreads(); phase_convert(C, 0); END_STEP(0); } }
    layer_program<0>(C, lo, hi);
    if constexpr (NL_BUILD > 1) layer_program<1>(C, lo, hi);
    { constexpr int sbase = N_STEPS - 1; if (EN(14) && IN_STEP(0)) { const PT p(C); phase_final(C, C.gw, C.ngw, (NGRP - 1) * GROWS, MALL, p.out(), p.in(I_FNG)); } }
}
#undef IN_STEP
#undef END_STEP

extern "C" void kernel_launch(void* const* d_in, const int* in_sizes, int n_in, void* d_out, int out_size, void* d_ws, size_t ws_size, hipStream_t stream) {
    static int grid = 0;
    if (grid == 0) {
        if (n_in != 32 || out_size != MALL * DM || ws_size < WS_NEED) { fprintf(stderr, "kernel_launch: unexpected shapes: n_in %d out %d ws %zu (need %zu)\n", n_in, out_size, ws_size, (size_t)WS_NEED); grid = -1; return; }
        int dev = 0, cus = 0, per_cu = 0;
        if (hipGetDevice(&dev) != hipSuccess || hipDeviceGetAttribute(&cus, hipDeviceAttributeMultiprocessorCount, dev) != hipSuccess) { grid = -1; return; }
        if (hipFuncSetAttribute((const void*)mk_fwd, hipFuncAttributeMaxDynamicSharedMemorySize, LDS_BYTES) != hipSuccess) { fprintf(stderr, "kernel_launch: hipFuncSetAttribute failed\n"); grid = -1; return; }
        if (hipOccupancyMaxActiveBlocksPerMultiprocessor(&per_cu, (const void*)mk_fwd, NWAVES * 64, LDS_BYTES) != hipSuccess || per_cu < 1) fprintf(stderr, "kernel_launch: occupancy query reports %d\n", per_cu);
        (void)hipGetLastError();
        grid = cus;
    }
    if (grid < 0) return;
    if (hipMemsetAsync((char*)d_ws + WS_CTL, 0, CTL_ZERO_BYTES, stream) != hipSuccess) return;
    Args a{};
    for (int i = 0; i < 32; ++i) a.in[i] = (const float*)d_in[i];
    a.out = (float*)d_out; a.ws = (unsigned char*)d_ws;
#if MK_MODE == 1
    a.lo = 0; a.hi = N_STEPS;
    hipLaunchKernelGGL(mk_fwd, dim3(grid), dim3(NWAVES * 64), LDS_BYTES, stream, a);
#else
    for (int s = 0; s < N_STEPS; ++s) { a.lo = s; a.hi = s + 1; hipLaunchKernelGGL(mk_fwd, dim3(grid), dim3(NWAVES * 64), LDS_BYTES, stream, a); }
#endif
}
```

```cpp
#include <hip/hip_runtime.h>
#include <cstdio>
#include <cstdint>

#ifndef MK_MODE
#define MK_MODE 1
#endif

#ifndef ONLY
#define ONLY -1
#endif
#ifndef PROBE_MASK
#define PROBE_MASK 0
#endif
#define REPEAT(k) _Pragma("unroll") for (int rep_ = 0; rep_ < (((PROBE_MASK >> (k)) & 1) ? 2 : 1); ++rep_)
#define EN(k) (ONLY < 0 || ONLY == (k))
#define LAS __attribute__((address_space(3)))
#define GAS __attribute__((address_space(1)))
typedef unsigned short bf16;
typedef short bf16x8 __attribute__((ext_vector_type(8)));
typedef short s16x4 __attribute__((ext_vector_type(4)));
typedef float f32x4 __attribute__((ext_vector_type(4)));
typedef float f32x2 __attribute__((ext_vector_type(2)));
typedef float f32x16 __attribute__((ext_vector_type(16)));
typedef unsigned u32x4 __attribute__((ext_vector_type(4)));
typedef unsigned u32x2 __attribute__((ext_vector_type(2)));
typedef GAS unsigned gu32;

constexpr int DM = 2048, NSEQ = 12, SEQ = 4096, MALL = NSEQ * SEQ;
constexpr int NLAYER = 2;
constexpr int GROWS = 16384, NGRP = MALL / GROWS;
constexpr int DIN = 8416, W_MLA = 832, W_RW = 3520, W_GATE = 4096, NPROJ = W_MLA + W_RW + W_GATE;
constexpr int RWIN = 3488;
constexpr int DFF = 5632;
constexpr int NMOD = 6 * DM;
constexpr int QW = 1536, KFW = 1536, VW = 1024;
constexpr int LORA_K = 512, LORA_N = 5120, LORA_KB = 256;
constexpr int NWAVES = 8;

constexpr size_t MiB = 1u << 20;
constexpr size_t WS_CTL = 0, CTL_ZERO_BYTES = 3 * MiB;
constexpr size_t WS_MOD = 1 * MiB;
constexpr size_t WS_ROPE = 3 * MiB;
constexpr size_t WS_RSTD = 4 * MiB;
constexpr size_t WS_BONUS = 5 * MiB;
constexpr size_t WS_W = 8 * MiB;
constexpr size_t WO_IN = 0, WO_UQ = WO_IN + (size_t)NPROJ * DM * 2, WO_UKV = WO_UQ + (size_t)QW * 512 * 2, WO_OATT = WO_UKV + (size_t)2048 * 256 * 2,
                 WO_ORWKV = WO_OATT + (size_t)DM * 1024 * 2, WO_OUT = WO_ORWKV + (size_t)DM * 1024 * 2, WO_UP = WO_OUT + (size_t)DM * DM * 2,
                 WO_DOWN = WO_UP + (size_t)2 * DFF * DM * 2, WO_LORA = WO_DOWN + (size_t)DM * DFF * 2, WO_END = WO_LORA + (size_t)LORA_N * LORA_K * 2;
static_assert(WO_END <= 124 * MiB, "weights");
constexpr size_t WS_A = 132 * MiB;
constexpr size_t A_H = WS_A;
constexpr size_t A_PMLA = WS_A + 64 * MiB;
constexpr size_t A_PGATE = A_PMLA + 32 * MiB;
constexpr size_t A_PRW = A_PGATE + 128 * MiB;
constexpr size_t A_RKVKK = A_PRW + 112 * MiB;
constexpr size_t A_OF = A_RKVKK;
constexpr size_t A_OB = A_RKVKK + 32 * MiB;
constexpr size_t A_RWKVO = A_RKVKK + 64 * MiB;
constexpr size_t A_ALORA = A_RKVKK + 96 * MiB;
constexpr size_t A_MERGED = A_RKVKK;
constexpr size_t A_LORAOUT = A_RKVKK + 128 * MiB;
constexpr size_t A_Q = A_LORAOUT + 160 * MiB;
constexpr size_t A_KF = A_Q + 48 * MiB;
constexpr size_t A_V = A_KF + 48 * MiB;
constexpr size_t A_ATTO = A_V + 32 * MiB;
constexpr size_t A_TM_END = A_ATTO + 32 * MiB;
constexpr size_t A_MID = WS_A + 64 * MiB;
constexpr size_t A_EA = A_MID;
constexpr size_t A_EB = A_MID + 16 * MiB;
constexpr size_t A_ACT = A_MID + 352 * MiB;
constexpr size_t A_H2 = A_ACT + 176 * MiB;
constexpr size_t A_FF_END = A_H2 + 64 * MiB;
constexpr size_t WS_NEED = (A_TM_END > A_FF_END ? A_TM_END : A_FF_END);
static_assert(WS_NEED <= 1000 * MiB, "workspace map");

constexpr int CW_BAR = 4096;

constexpr int RING_BYTES = 131072, LDSCTL_OFF = RING_BYTES, MISC_OFF = LDSCTL_OFF + 320, LDS_BYTES = 147456;

#define LDS_WAIT() asm volatile("s_waitcnt lgkmcnt(0)" ::: "memory")
#define VM_WAIT() asm volatile("s_waitcnt vmcnt(0)" ::: "memory")
typedef __bf16 bf16x2_t __attribute__((ext_vector_type(2)));
__device__ __forceinline__ unsigned cvt_pk_bf16(float lo, float hi) { const f32x2 v = {lo, hi}; const bf16x2_t b = __builtin_convertvector(v, bf16x2_t); return __builtin_bit_cast(unsigned, b); }
__device__ __forceinline__ float bf_lo(unsigned w) { return __uint_as_float(w << 16); }
__device__ __forceinline__ float bf_hi(unsigned w) { return __uint_as_float(w & 0xffff0000u); }
__device__ __forceinline__ void unpack8(const u32x4 w, float (&f)[8]) { f[0] = bf_lo(w.x); f[1] = bf_hi(w.x); f[2] = bf_lo(w.y); f[3] = bf_hi(w.y); f[4] = bf_lo(w.z); f[5] = bf_hi(w.z); f[6] = bf_lo(w.w); f[7] = bf_hi(w.w); }
__device__ __forceinline__ void load8(const bf16* p, float (&f)[8]) { unpack8(*(const u32x4*)p, f); }
__device__ __forceinline__ u32x4 pack8(const float (&f)[8]) { u32x4 w; w.x = cvt_pk_bf16(f[0], f[1]); w.y = cvt_pk_bf16(f[2], f[3]); w.z = cvt_pk_bf16(f[4], f[5]); w.w = cvt_pk_bf16(f[6], f[7]); return w; }
__device__ __forceinline__ void store8(bf16* p, const float (&f)[8]) { *(u32x4*)p = pack8(f); }
__device__ __forceinline__ float sigmoidf_(float x) { return __builtin_amdgcn_rcpf(1.f + __expf(-x)); }
__device__ __forceinline__ float sigmoid_div(float x) { return 1.f / (1.f + __expf(-x)); }
__device__ __forceinline__ float wave_sum(float v) {
#pragma unroll
    for (int o = 1; o < 64; o <<= 1) v += __shfl_xor(v, o);
    return v;
}
__device__ __forceinline__ float reduce8(float x) {
    x += __builtin_bit_cast(float, __builtin_amdgcn_update_dpp(0, __builtin_bit_cast(int, x), 0xB1, 0xF, 0xF, true));
    x += __builtin_bit_cast(float, __builtin_amdgcn_update_dpp(0, __builtin_bit_cast(int, x), 0x4E, 0xF, 0xF, true));
    x += __builtin_bit_cast(float, __builtin_amdgcn_update_dpp(0, __builtin_bit_cast(int, x), 0x141, 0xF, 0xF, true));
    return x;
}

namespace pg8 {
constexpr int BM = 256, BK = 64, HALF = 128, HTB = HALF * BK * 2, STAGE_BYTES = 8 * HTB, NXCD = 8, WGM = 4;
__host__ __device__ __forceinline__ int lds_byte(int r, int c) { const int st = (r >> 4) * 2 + (c >> 5), rr = r & 15, cc = c & 31, ob = rr * 64 + cc * 2; return st * 1024 + (ob ^ (((ob >> 9) & 1) << 5)); }
__host__ __device__ __forceinline__ void stage_rc(int b, int& R, int& C) { const int st = b / 1024, sb = b % 1024, swz = sb ^ (((sb >> 9) & 1) << 5); R = (st >> 1) * 16 + swz / 64; C = (st & 1) * 32 + (swz % 64) / 2; }
__host__ __device__ __forceinline__ int perm32(int rho) { const int n = rho >> 4, i = rho & 15; return 8 * (i >> 2) + 4 * n + (i & 3); }
struct Unit { int pm, pn; };
struct Gemm { const bf16* A; const bf16* Bt; int M, N, K, lda, ldb; };
struct StaticOrder {
    int nM, nN, nwg, G, c;
    __host__ __device__ void init(int M, int N, int G_, int c_) { nM = M / BM; nN = N / BM; nwg = nM * nN; G = G_; c = c_; }
    __host__ __device__ bool next(int i, Unit& u) const {
        const long L = (long)i * G + c; if (L >= nwg) return false;
        int wgid = (int)L; { const int q = nwg / NXCD, r = nwg % NXCD, xcd = wgid % NXCD, off = wgid / NXCD; wgid = (xcd < r ? xcd * (q + 1) : r * (q + 1) + (xcd - r) * q) + off; }
        const int nig = WGM * nN, gid = wgid / nig, fm = gid * WGM, gsz = (nM - fm) < WGM ? (nM - fm) : WGM;
        u.pm = fm + ((wgid % nig) % gsz); u.pn = (wgid % nig) / gsz; return true;
    }
    __device__ __forceinline__ void a_ready(const Unit&) const {}
    __device__ __forceinline__ void done(const Unit&) const {}
};
template <int N0, int N1, int N2> struct SkewOrder {
    int nM, nN, nwg, G, c;
    __host__ __device__ void init(int M, int N, int G_, int c_) { nM = M / BM; nN = N / BM; nwg = nM * nN; G = G_; c = c_; }
    __host__ __device__ bool next(int i, Unit& u) const {
        long L;
        if (G == 256 && nwg == 128 * N0 + 64 * N1 + 64 * N2) {
            if (c < 128) { if (i >= N0) return false; L = i * 128 + c; }
            else if (c < 192) { if (i >= N1) return false; L = N0 * 128 + i * 64 + (c - 128); }
            else { if (i >= N2) return false; L = N0 * 128 + N1 * 64 + i * 64 + (c - 192); }
        } else { L = (long)i * G + c; if (L >= nwg) return false; }
        int wgid = (int)L; { const int q = nwg / NXCD, r = nwg % NXCD, xcd = wgid % NXCD, off = wgid / NXCD; wgid = (xcd < r ? xcd * (q + 1) : r * (q + 1) + (xcd - r) * q) + off; }
        const int nig = WGM * nN, gid = wgid / nig, fm = gid * WGM, gsz = (nM - fm) < WGM ? (nM - fm) : WGM;
        u.pm = fm + ((wgid % nig) % gsz); u.pn = (wgid % nig) / gsz; return true;
    }
    __device__ __forceinline__ void a_ready(const Unit&) const {}
    __device__ __forceinline__ void done(const Unit&) const {}
};
template <class F> struct EpiG {
    static constexpr bool PERM = true, AFTER_DRAIN = false;
    F f;
    __device__ __forceinline__ void operator()(const f32x4 (&acc)[2][2][4][2], const Unit& u, int wr, int wc, int fr, int fq) const {
        const int row0 = u.pm * BM + wr * 64 + fr, col0 = u.pn * BM + wc * 32 + 8 * fq;
#pragma unroll
        for (int ai = 0; ai < 2; ++ai)
#pragma unroll
            for (int m = 0; m < 4; ++m) {
                const int row = row0 + ai * HALF + m * 16;
#pragma unroll
                for (int bj = 0; bj < 2; ++bj) {
                    float v[8]; const f32x4 a0 = acc[ai][bj][m][0], a1 = acc[ai][bj][m][1];
                    v[0] = a0[0]; v[1] = a0[1]; v[2] = a0[2]; v[3] = a0[3]; v[4] = a1[0]; v[5] = a1[1]; v[6] = a1[2]; v[7] = a1[3];
                    f(row, col0 + bj * HALF, v);
                }
                asm volatile("" ::: "memory");
            }
    }
};

template <class Epi, class Sched, bool ALIGN_EPI = false, bool SP2 = false, bool PERMA = false>
__device__ __forceinline__ void gemm_phase(LAS unsigned char* lds, const Gemm g, const Sched& S, const Epi& E) {
    const int tid = threadIdx.x, wid = __builtin_amdgcn_readfirstlane(tid >> 6), lane = tid & 63, wr = wid >> 2, wc = wid & 3, fr = lane & 15, fq = lane >> 4;
    const int K = g.K, nt = K / BK;
    unsigned voffA[2], voffB[2];
#pragma unroll
    for (int i = 0; i < 2; ++i) { int R, C; stage_rc(tid * 16 + i * 8192, R, C); const int Rb = Epi::PERM ? ((R & ~31) + perm32(R & 31)) : R;
        const int Ra = PERMA ? ((R & 64) | ((R & 15) << 2) | ((R >> 4) & 3)) : R;
        voffA[i] = (unsigned)(Ra * g.lda + C) * 2u; voffB[i] = (unsigned)(Rb * g.ldb + C) * 2u; }
    const size_t kstep = (size_t)(BK * 2);
    const size_t hstepA = (size_t)HALF * g.lda * 2, hstepB = (size_t)HALF * g.ldb * 2;
    const size_t tstepA = 2 * hstepA, tstepB = 2 * hstepB;
    const unsigned ldsw = (unsigned)wid * 1024u;
    const int aoff = lds_byte(wr * 64 + fr, fq * 8), boff = lds_byte(wc * 32 + fr, fq * 8);
#define PG8_SA(b, h) (((b) * 2 + (h)) * HTB)
#define PG8_SB(b, h) ((4 + (b) * 2 + (h)) * HTB)
#define PG8_STAGE(bufoff, gbase, voff) do { _Pragma("unroll") for (int _i = 0; _i < 2; ++_i) \
        __builtin_amdgcn_global_load_lds((const unsigned*)((const char*)(gbase) + (voff)[_i]), (LAS unsigned*)(lds + (bufoff) + ldsw + _i * 8192), 16, 0, 0); } while (0)
#define PG8_LDA(dst, b, h) do { _Pragma("unroll") for (int m = 0; m < 4; ++m) _Pragma("unroll") for (int k = 0; k < 2; ++k) dst[m][k] = *(const LAS bf16x8*)(lds + PG8_SA(b, h) + aoff + m * 2048 + k * 1024); } while (0)
#define PG8_LDB(dst, b, h) do { _Pragma("unroll") for (int n = 0; n < 2; ++n) _Pragma("unroll") for (int k = 0; k < 2; ++k) dst[n][k] = *(const LAS bf16x8*)(lds + PG8_SB(b, h) + boff + n * 2048 + k * 1024); } while (0)
#define PG8_MMA(ai, bj, At, Bt) do { __builtin_amdgcn_s_setprio(1); _Pragma("unroll") for (int m = 0; m < 4; ++m) _Pragma("unroll") for (int n = 0; n < 2; ++n) _Pragma("unroll") for (int k = 0; k < 2; ++k) \
        acc[ai][bj][m][n] = __builtin_amdgcn_mfma_f32_16x16x32_bf16(Bt[n][k], At[m][k], acc[ai][bj][m][n], 0, 0, 0); __builtin_amdgcn_s_setprio(0); } while (0)
#define PG8_WAIT_V(n) asm volatile("s_waitcnt vmcnt(" #n ")" ::: "memory")
#define PG8_WAIT_L(n) asm volatile("s_waitcnt lgkmcnt(" #n ")" ::: "memory")
#define PG8_BAR __builtin_amdgcn_s_barrier()
#define PG8_SCHED __builtin_amdgcn_sched_barrier(0)
    Unit cur, nxt; int ui = 0;
    if (!S.next(0, cur)) return;
    f32x4 acc[2][2][4][2];
#pragma unroll
    for (int a = 0; a < 2; ++a)
#pragma unroll
        for (int b = 0; b < 2; ++b)
#pragma unroll
            for (int m = 0; m < 4; ++m)
#pragma unroll
                for (int n = 0; n < 2; ++n) acc[a][b][m][n] = (f32x4){0.f, 0.f, 0.f, 0.f};
    bf16x8 At[4][2], B0[2][2], B1[2][2];
    const char* cA = (const char*)g.A + (size_t)cur.pm * tstepA; const char* cB = (const char*)g.Bt + (size_t)cur.pn * tstepB;
    S.a_ready(cur);
    if constexpr (SP2) {
        PG8_STAGE(PG8_SB(0, 0), cB, voffB); PG8_STAGE(PG8_SB(0, 1), cB + hstepB, voffB); PG8_STAGE(PG8_SA(0, 0), cA, voffA); PG8_STAGE(PG8_SA(0, 1), cA + hstepA, voffA);
        if (wr == 1) PG8_BAR;
        PG8_WAIT_V(2); PG8_BAR;
        PG8_STAGE(PG8_SB(1, 0), cB + kstep, voffB); PG8_STAGE(PG8_SA(1, 0), cA + kstep, voffA); PG8_STAGE(PG8_SB(1, 1), cB + hstepB + kstep, voffB);
        PG8_WAIT_V(6); PG8_BAR;
    } else {
        PG8_STAGE(PG8_SB(0, 0), cB, voffB); PG8_STAGE(PG8_SA(0, 0), cA, voffA); PG8_STAGE(PG8_SB(0, 1), cB + hstepB, voffB); PG8_STAGE(PG8_SA(0, 1), cA + hstepA, voffA);
        if (wr == 1) PG8_BAR;
        PG8_WAIT_V(4); PG8_BAR;
        PG8_STAGE(PG8_SB(1, 0), cB + kstep, voffB); PG8_STAGE(PG8_SA(1, 0), cA + kstep, voffA); PG8_STAGE(PG8_SB(1, 1), cB + hstepB + kstep, voffB);
        PG8_WAIT_V(6); PG8_BAR;
    }
    for (;;) {
        const bool has_next = S.next(ui + 1, nxt);
        const char* nA = has_next ? (const char*)g.A + (size_t)nxt.pm * tstepA : cA; const char* nB = has_next ? (const char*)g.Bt + (size_t)nxt.pn * tstepB : cB;
#pragma unroll 1
        for (int t = 0; t < nt; t += 2) {
            const bool last = (t == nt - 2);
            const char* a1 = cA + (size_t)(t + 1) * kstep;
            const char* a2 = last ? nA : cA + (size_t)(t + 2) * kstep; const char* b2 = last ? nB : cB + (size_t)(t + 2) * kstep;
            const char* a3 = a2 + kstep; const char* b3 = b2 + kstep;
            if (last && has_next) S.a_ready(nxt);
            if constexpr (SP2) {
            PG8_LDB(B0, 0, 0); PG8_LDB(B1, 0, 1); PG8_SCHED; PG8_LDA(At, 0, 0); PG8_STAGE(PG8_SA(1, 1), a1 + hstepA, voffA);
            PG8_WAIT_V(8); PG8_WAIT_L(0); PG8_BAR; PG8_MMA(0, 0, At, B0); PG8_MMA(0, 1, At, B1); PG8_BAR; PG8_SCHED;
            PG8_LDA(At, 0, 1); PG8_STAGE(PG8_SB(0, 0), b2, voffB); PG8_STAGE(PG8_SB(0, 1), b2 + hstepB, voffB); PG8_STAGE(PG8_SA(0, 0), a2, voffA);
            PG8_WAIT_V(8); PG8_WAIT_L(0); PG8_BAR; PG8_MMA(1, 0, At, B0); PG8_MMA(1, 1, At, B1); PG8_BAR; PG8_SCHED;
            PG8_LDB(B0, 1, 0); PG8_LDB(B1, 1, 1); PG8_SCHED; PG8_LDA(At, 1, 0); PG8_STAGE(PG8_SA(0, 1), a2 + hstepA, voffA);
            PG8_WAIT_V(8); PG8_WAIT_L(0); PG8_BAR; PG8_MMA(0, 0, At, B0); PG8_MMA(0, 1, At, B1); PG8_BAR; PG8_SCHED;
            PG8_LDA(At, 1, 1); PG8_STAGE(PG8_SB(1, 0), b3, voffB); PG8_STAGE(PG8_SB(1, 1), b3 + hstepB, voffB); PG8_STAGE(PG8_SA(1, 0), a3, voffA);
            PG8_WAIT_V(8); PG8_WAIT_L(0); PG8_BAR; PG8_MMA(1, 0, At, B0); PG8_MMA(1, 1, At, B1); PG8_BAR; PG8_SCHED;
            } else {
            PG8_LDB(B0, 0, 0); PG8_SCHED; PG8_LDA(At, 0, 0); PG8_STAGE(PG8_SA(1, 1), a1 + hstepA, voffA);
            PG8_WAIT_L(8); PG8_BAR; PG8_WAIT_L(0); PG8_MMA(0, 0, At, B0); PG8_BAR; PG8_SCHED;
            PG8_LDB(B1, 0, 1); PG8_STAGE(PG8_SB(0, 0), b2, voffB);
            PG8_BAR; PG8_WAIT_L(0); PG8_MMA(0, 1, At, B1); PG8_BAR;
            PG8_LDA(At, 0, 1); PG8_STAGE(PG8_SA(0, 0), a2, voffA);
            PG8_BAR; PG8_WAIT_L(0); PG8_MMA(1, 0, At, B0); PG8_BAR; PG8_SCHED;
            PG8_STAGE(PG8_SB(0, 1), b2 + hstepB, voffB);
            PG8_WAIT_V(6); PG8_BAR; PG8_MMA(1, 1, At, B1); PG8_BAR;
            PG8_LDB(B0, 1, 0); PG8_SCHED; PG8_LDA(At, 1, 0); PG8_STAGE(PG8_SA(0, 1), a2 + hstepA, voffA);
            PG8_WAIT_L(8); PG8_BAR; PG8_WAIT_L(0); PG8_MMA(0, 0, At, B0); PG8_BAR; PG8_SCHED;
            PG8_LDB(B1, 1, 1); PG8_STAGE(PG8_SB(1, 0), b3, voffB);
            PG8_BAR; PG8_WAIT_L(0); PG8_MMA(0, 1, At, B1); PG8_BAR;
            PG8_LDA(At, 1, 1); PG8_STAGE(PG8_SA(1, 0), a3, voffA);
            PG8_BAR; PG8_WAIT_L(0); PG8_MMA(1, 0, At, B0); PG8_BAR; PG8_SCHED;
            PG8_STAGE(PG8_SB(1, 1), b3 + hstepB, voffB);
            PG8_WAIT_V(6); PG8_BAR; PG8_MMA(1, 1, At, B1); PG8_BAR;
            }
        }
        if constexpr (ALIGN_EPI) { if (wr == 0) PG8_BAR; }
        E(acc, cur, wr, wc, fr, fq); S.done(cur);
        if (!has_next) break;
#pragma unroll
        for (int a = 0; a < 2; ++a)
#pragma unroll
            for (int b = 0; b < 2; ++b)
#pragma unroll
                for (int m = 0; m < 4; ++m)
#pragma unroll
                    for (int n = 0; n < 2; ++n) acc[a][b][m][n] = (f32x4){0.f, 0.f, 0.f, 0.f};
        cur = nxt; cA = nA; cB = nB; ++ui;
        if constexpr (ALIGN_EPI) { if (wr == 1) PG8_BAR; }
    }
    PG8_WAIT_V(0);
    if constexpr (!ALIGN_EPI) { if (wr == 0) PG8_BAR; }
    PG8_BAR;
#undef PG8_SA
#undef PG8_SB
#undef PG8_STAGE
#undef PG8_LDA
#undef PG8_LDB
#undef PG8_MMA
#undef PG8_WAIT_V
#undef PG8_WAIT_L
#undef PG8_BAR
#undef PG8_SCHED
}
}
#define PG8_SP2 true
#define PG8_ALIGN true

struct FProj {
    bf16* mla; bf16* rw; bf16* gate;
    __device__ __forceinline__ void operator()(int row, int col, const float (&v)[8]) const {
        bf16* p;
        if (col < W_MLA) p = mla + (size_t)row * W_MLA + col;
        else if (col < W_MLA + W_RW) p = rw + (size_t)row * W_RW + (col - W_MLA);
        else p = gate + (size_t)row * W_GATE + (col - W_MLA - W_RW);
        store8(p, v);
    }
};
struct FStore {
    bf16* O; int ldc;
    __device__ __forceinline__ void operator()(int row, int col, const float (&v)[8]) const { store8(O + (size_t)row * ldc + col, v); }
};
struct FQ {
    bf16* Q; const float* rstd; const float* rc; const float* rs;
    __device__ __forceinline__ void operator()(int row, int col, const float (&v)[8]) const {
        const float s = rstd[row]; float o[8];
        const int c = col % 192;
        if (c >= 128) {
            const int j0 = ((c - 128) >> 3) * 4, pos = row & (SEQ - 1);
            const f32x4 cs = *(const f32x4*)(rc + pos * 32 + j0), sn = *(const f32x4*)(rs + pos * 32 + j0);
#pragma unroll
            for (int i = 0; i < 4; ++i) { const float x1 = v[i] * s, x2 = v[4 + i] * s; o[i] = x1 * cs[i] - x2 * sn[i]; o[4 + i] = x2 * cs[i] + x1 * sn[i]; }
        } else {
#pragma unroll
            for (int i = 0; i < 8; ++i) o[i] = v[i] * s;
        }
        store8(Q + (size_t)row * QW + col, o);
    }
};
struct FKV {
    bf16* KF; bf16* V; const float* rstd;
    __device__ __forceinline__ void operator()(int row, int col, const float (&v)[8]) const {
        const float s = rstd[row]; float o[8];
#pragma unroll
        for (int i = 0; i < 8; ++i) o[i] = v[i] * s;
        const int hh = col >> 8, w = col & 255;
        bf16* p = (w < 128) ? KF + (size_t)row * KFW + hh * 192 + w : V + (size_t)row * VW + hh * 128 + (w - 128);
        store8(p, o);
    }
};
struct FLora {
    bf16* O; const float* w0; const float* a0; int col0;
    __device__ __forceinline__ void operator()(int row, int colr, const float (&v)[8]) const {
        float o[8]; const int col = colr + col0;
        if (col < 4096) {
            const float* b = (col < 2048) ? w0 + col : a0 + (col - 2048);
            const f32x4 b0 = *(const f32x4*)b, b1 = *(const f32x4*)(b + 4);
#pragma unroll
            for (int i = 0; i < 4; ++i) { o[i] = sigmoidf_(v[i] + b0[i]); o[4 + i] = sigmoidf_(v[4 + i] + b1[i]); }
        } else {
#pragma unroll
            for (int i = 0; i < 8; ++i) o[i] = v[i];
        }
        store8(O + (size_t)row * LORA_N + col, o);
    }
};
struct FMergeA {
    bf16* MG; const bf16* gate;
    __device__ __forceinline__ void operator()(int row, int col, const float (&v)[8]) const {
        float gt[8], o[8]; load8(gate + (size_t)row * W_GATE + col, gt);
#pragma unroll
        for (int i = 0; i < 8; ++i) o[i] = sigmoidf_(gt[i]) * v[i];
        store8(MG + (size_t)row * DM + col, o);
    }
};
struct FMergeB {
    bf16* MG; const bf16* gate;
    __device__ __forceinline__ void operator()(int row, int col, const float (&v)[8]) const {
        float gt[8], o[8], m[8]; load8(gate + (size_t)row * W_GATE + DM + col, gt); load8(MG + (size_t)row * DM + col, m);
#pragma unroll
        for (int i = 0; i < 8; ++i) o[i] = m[i] + sigmoidf_(gt[i]) * v[i];
        store8(MG + (size_t)row * DM + col, o);
    }
};
struct FResid {
    const float* xin; float* out; const float* gt;
    __device__ __forceinline__ void operator()(int row, int col, const float (&v)[8]) const {
        const float* gp = gt + (size_t)(row >> 12) * NMOD + col;
        const f32x4 g0 = *(const f32x4*)gp, g1 = *(const f32x4*)(gp + 4);
        const float* xp = xin + (size_t)row * DM + col;
        const f32x4 x0 = *(const f32x4*)xp, x1 = *(const f32x4*)(xp + 4);
        f32x4 o0, o1;
#pragma unroll
        for (int i = 0; i < 4; ++i) { o0[i] = x0[i] + g0[i] * v[i]; o1[i] = x1[i] + g1[i] * v[4 + i]; }
        float* op = out + (size_t)row * DM + col;
        *(f32x4*)op = o0; *(f32x4*)(op + 4) = o1;
    }
};

__device__ __forceinline__ float dpp_shr1(float x) { return __builtin_bit_cast(float, __builtin_amdgcn_update_dpp(0, __builtin_bit_cast(int, x), 0x111, 0xF, 0xF, true)); }
__device__ __forceinline__ float dpp_shl1(float x) { return __builtin_bit_cast(float, __builtin_amdgcn_update_dpp(0, __builtin_bit_cast(int, x), 0x101, 0xF, 0xF, true)); }
struct EpiAct {
    static constexpr bool PERM = true, AFTER_DRAIN = false;
    bf16* ACT; bf16* EA; bf16* EB; const float* cw; const float* cb;
    __device__ __forceinline__ void operator()(const f32x4 (&acc)[2][2][4][2], const pg8::Unit& u, int wr, int wc, int fr, int fq) const {
        const int j0 = u.pn * 128 + wc * 32 + 8 * fq;
        float w0[8], w1[8], w2[8], bb[8];
#pragma unroll
        for (int h = 0; h < 2; ++h) { const f32x4 x0 = *(const f32x4*)(cw + j0 + 4 * h), x1 = *(const f32x4*)(cw + DFF + j0 + 4 * h), x2 = *(const f32x4*)(cw + 2 * DFF + j0 + 4 * h), x3 = *(const f32x4*)(cb + j0 + 4 * h);
#pragma unroll
            for (int i = 0; i < 4; ++i) { w0[4 * h + i] = x0[i]; w1[4 * h + i] = x1[i]; w2[4 * h + i] = x2[i]; bb[4 * h + i] = x3[i]; } }
#pragma unroll
        for (int ai = 0; ai < 2; ++ai) {
            float av[4][8], bv[4][8];
#pragma unroll
            for (int m = 0; m < 4; ++m)
#pragma unroll
                for (int i = 0; i < 4; ++i) { av[m][i] = acc[ai][0][m][0][i]; av[m][4 + i] = acc[ai][0][m][1][i]; bv[m][i] = acc[ai][1][m][0][i]; bv[m][4 + i] = acc[ai][1][m][1][i]; }
            float ap[8], an[8];
#pragma unroll
            for (int i = 0; i < 8; ++i) { ap[i] = dpp_shr1(av[3][i]); an[i] = dpp_shl1(av[0][i]); }
            const int blk = ai * 2 + wr; const size_t tok0 = (size_t)u.pm * 256 + blk * 64 + 4 * fr;
#pragma unroll
            for (int m = 0; m < 4; ++m) {
                float o[8];
#pragma unroll
                for (int i = 0; i < 8; ++i) { const float xm = (m == 0) ? ap[i] : av[m == 0 ? 0 : m - 1][i], xp = (m == 3) ? an[i] : av[m == 3 ? 3 : m + 1][i];
                    const float c = w0[i] * xm + w1[i] * av[m][i] + w2[i] * xp + bb[i]; o[i] = c * sigmoidf_(c) * bv[m][i]; }
                store8(ACT + (tok0 + m) * DFF + j0, o);
            }
            const size_t eb = ((size_t)u.pm * 4 + blk);
            if (fr == 0) { store8(EA + (eb * 4 + 0) * DFF + j0, av[0]); store8(EA + (eb * 4 + 1) * DFF + j0, av[1]); store8(EB + (eb * 2 + 0) * DFF + j0, bv[0]); }
            if (fr == 15) { store8(EA + (eb * 4 + 2) * DFF + j0, av[2]); store8(EA + (eb * 4 + 3) * DFF + j0, av[3]); store8(EB + (eb * 2 + 1) * DFF + j0, bv[3]); }
            asm volatile("" ::: "memory");
        }
    }
};

namespace att {
constexpr int DQK = 192, DV = 128, NW = 8, QBLK = 32, KVBLK = 64;
constexpr float SCALE = 0.07216878364870322f;
constexpr float THR = 8.f;
constexpr int LDQ = QW, LDK = KFW, LDV = VW, LDO = 1024;
constexpr int SHM_V = KVBLK * DV * 2, SHM_K = KVBLK * DQK * 2, SHM_ATTN = 2 * SHM_V + 2 * SHM_K + NW * 64 * 4;
#define KSWZ(row, colB) ((row) * 384 + ((colB) ^ (((row) & 7) << 4)))
#define SBAR() __builtin_amdgcn_sched_barrier(0)
__device__ __forceinline__ int crow(int r, int hi) { return (r & 3) + 8 * (r >> 2) + 4 * hi; }
__device__ __forceinline__ void partialSM(f32x16& p0, f32x16& p1, float& m_reg, float& mn, float& alpha) {
    constexpr float C = SCALE * 1.4426950408889634f;
    float pmax = p0[0];
#pragma unroll
    for (int r = 1; r < 16; ++r) pmax = fmaxf(pmax, p0[r]);
#pragma unroll
    for (int r = 0; r < 16; ++r) pmax = fmaxf(pmax, p1[r]);
    { auto rr = __builtin_amdgcn_permlane32_swap(__float_as_uint(pmax), __float_as_uint(pmax), false, false);
      pmax = fmaxf(__uint_as_float(rr[0]), __uint_as_float(rr[1])); }
    if (__builtin_expect(__all(pmax - m_reg <= THR / SCALE), 1)) { mn = m_reg; alpha = 1.f; }
    else { mn = fmaxf(m_reg, pmax); alpha = __builtin_amdgcn_exp2f((m_reg - mn) * C); m_reg = mn; }
    const float mnC = -mn * C;
#pragma unroll
    for (int r = 0; r < 16; ++r) p0[r] = fmaf(p0[r], C, mnC);
#pragma unroll
    for (int r = 0; r < 16; ++r) p1[r] = fmaf(p1[r], C, mnC);
#pragma unroll
    for (int r = 0; r < 16; ++r) p0[r] = __builtin_amdgcn_exp2f(p0[r]);
}
__device__ __forceinline__ void finishSM(f32x16& p0, f32x16& p1, float alpha, float& l_reg, bf16x8& pa0, bf16x8& pa1, bf16x8& pa2, bf16x8& pa3) {
#pragma unroll
    for (int r = 0; r < 16; ++r) p1[r] = __builtin_amdgcn_exp2f(p1[r]);
    float ps = 0;
#pragma unroll
    for (int r = 0; r < 16; ++r) ps += p0[r];
#pragma unroll
    for (int r = 0; r < 16; ++r) ps += p1[r];
    { auto rr = __builtin_amdgcn_permlane32_swap(__float_as_uint(ps), __float_as_uint(ps), false, false);
      ps = __uint_as_float(rr[0]) + __uint_as_float(rr[1]); }
    l_reg = l_reg * alpha + ps;
#define PK4(P, BASE, OUT) do { unsigned a0 = cvt_pk_bf16(P[BASE + 0], P[BASE + 1]), a1 = cvt_pk_bf16(P[BASE + 2], P[BASE + 3]);   \
    unsigned b0 = cvt_pk_bf16(P[BASE + 4], P[BASE + 5]), b1 = cvt_pk_bf16(P[BASE + 6], P[BASE + 7]);                              \
    auto r0 = __builtin_amdgcn_permlane32_swap(a0, b0, false, false); auto r1 = __builtin_amdgcn_permlane32_swap(a1, b1, false, false); \
    u32x4 w = {r0[0], r1[0], r0[1], r1[1]}; OUT = __builtin_bit_cast(bf16x8, w); } while (0)
    PK4(p0, 0, pa0); PK4(p0, 8, pa1); PK4(p1, 0, pa2); PK4(p1, 8, pa3);
#undef PK4
}
__device__ __forceinline__ void qkt(f32x16& p0, f32x16& p1, const LAS char* Ks, const bf16x8* qr, int r32, int hi) {
    p0 = f32x16{}; p1 = f32x16{};
#pragma unroll
    for (int d0 = 0; d0 < 12; ++d0) { const int cb = (d0 * 16 + hi * 8) * 2;
        const bf16x8 b0 = *(const LAS bf16x8*)(Ks + KSWZ(r32, cb));
        const bf16x8 b1 = *(const LAS bf16x8*)(Ks + KSWZ(32 + r32, cb));
        p0 = __builtin_amdgcn_mfma_f32_32x32x16_bf16(b0, qr[d0], p0, 0, 0, 0);
        p1 = __builtin_amdgcn_mfma_f32_32x32x16_bf16(b1, qr[d0], p1, 0, 0, 0); }
}
__device__ __forceinline__ int v_st(int k, int c) { const int kk = (k & ~0xC) | ((k & 4) << 1) | ((k & 8) >> 1); return ((kk >> 3) * 4 + (c >> 5)) * 512 + ((kk & 7) * 32 + (c & 31)) * 2; }
__device__ __forceinline__ int v_rd_base(int lane) { return ((lane & 3) << 3) | (((lane >> 2) & 3) << 6) | (((lane >> 4) & 1) << 5) | (((lane >> 5) & 1) << 8); }
constexpr int v_rd_off(int d0, int ks, int half) { return d0 * 512 + ks * 4096 + half * 2048; }
template <int OFF> __device__ __forceinline__ s16x4 tr_read(int vb) {
    s16x4 r; asm volatile("ds_read_b64_tr_b16 %0, %1 offset:%2" : "=&v"(r) : "v"(vb), "i"(OFF) : "memory"); return r;
}
template <int D0> __device__ __forceinline__ void pv_one(f32x16& od, int vb, bf16x8 pa0, bf16x8 pa1, bf16x8 pa2, bf16x8 pa3) {
    const s16x4 l0 = tr_read<v_rd_off(D0, 0, 0)>(vb), h0 = tr_read<v_rd_off(D0, 0, 1)>(vb), l1 = tr_read<v_rd_off(D0, 1, 0)>(vb), h1 = tr_read<v_rd_off(D0, 1, 1)>(vb);
    const s16x4 l2 = tr_read<v_rd_off(D0, 2, 0)>(vb), h2 = tr_read<v_rd_off(D0, 2, 1)>(vb), l3 = tr_read<v_rd_off(D0, 3, 0)>(vb), h3 = tr_read<v_rd_off(D0, 3, 1)>(vb);
    asm volatile("s_waitcnt lgkmcnt(0)" ::: "memory"); SBAR();
#define PK(L, H) (bf16x8){L[0], L[1], L[2], L[3], H[0], H[1], H[2], H[3]}
    od = __builtin_amdgcn_mfma_f32_32x32x16_bf16(pa0, PK(l0, h0), od, 0, 0, 0);
    od = __builtin_amdgcn_mfma_f32_32x32x16_bf16(pa1, PK(l1, h1), od, 0, 0, 0);
    od = __builtin_amdgcn_mfma_f32_32x32x16_bf16(pa2, PK(l2, h2), od, 0, 0, 0);
    od = __builtin_amdgcn_mfma_f32_32x32x16_bf16(pa3, PK(l3, h3), od, 0, 0, 0);
#undef PK
}
__device__ __forceinline__ void pv_d0(f32x16* o, int vb, bf16x8 pa0, bf16x8 pa1, bf16x8 pa2, bf16x8 pa3) {
    pv_one<0>(o[0], vb, pa0, pa1, pa2, pa3); pv_one<1>(o[1], vb, pa0, pa1, pa2, pa3); pv_one<2>(o[2], vb, pa0, pa1, pa2, pa3); pv_one<3>(o[3], vb, pa0, pa1, pa2, pa3);
}
__device__ __forceinline__ void attn_unit(const bf16* __restrict__ Qb, const bf16* __restrict__ Kh, const bf16* __restrict__ Vh, bf16* __restrict__ Ob, int seq, LAS char* lds) {
    const int tid = threadIdx.x, wid = tid >> 6, lane = tid & 63, r32 = lane & 31, hi = lane >> 5;
    LAS char* V_lds = lds; LAS char* K_lds = lds + 2 * SHM_V;
    LAS float* ws = (LAS float*)(lds + 2 * SHM_V + 2 * SHM_K) + wid * 64; LAS float* li_l = ws; LAS float* al_l = ws + 32;
    float m_reg = -1e30f, l_reg = 0; f32x16 o[4] = {}; bf16x8 qr[12];
    const bf16* Qw = Qb + (long)(wid * QBLK + r32) * LDQ + hi * 8;
#pragma unroll
    for (int d0 = 0; d0 < 12; ++d0) qr[d0] = *(const bf16x8*)(Qw + d0 * 16);
    const int sr = tid >> 4, sc = (tid & 15) * 8, vst0 = v_st(sr, sc), vst1 = v_st(32 + sr, sc);
    const int krow0 = tid >> 3, kch0 = tid & 7;
    const int vb0 = (int)(unsigned)(uintptr_t)V_lds + v_rd_base(lane);
    bf16x8 vs0, vs1, ks0, ks1, ks2;
#define SLOAD(k0) do { vs0 = *(const bf16x8*)(&Vh[(long)((k0) + sr) * LDV + sc]); vs1 = *(const bf16x8*)(&Vh[(long)((k0) + 32 + sr) * LDV + sc]); \
    { const bf16* kp_ = &Kh[(long)((k0) + krow0) * LDK + kch0 * 8]; ks0 = *(const bf16x8*)kp_; ks1 = *(const bf16x8*)(kp_ + 64); ks2 = *(const bf16x8*)(kp_ + 128); } } while (0)
#define SWRITE(b) do { *(LAS bf16x8*)(V_lds + (b) * SHM_V + vst0) = vs0; *(LAS bf16x8*)(V_lds + (b) * SHM_V + vst1) = vs1; \
    *(LAS bf16x8*)(K_lds + (b) * SHM_K + KSWZ(krow0, kch0 * 16)) = ks0; *(LAS bf16x8*)(K_lds + (b) * SHM_K + KSWZ(krow0, (kch0 + 8) * 16)) = ks1; \
    *(LAS bf16x8*)(K_lds + (b) * SHM_K + KSWZ(krow0, (kch0 + 16) * 16)) = ks2; } while (0)
#define RESC(a) do { if (__any((a) < 1.f)) { if (hi == 0) al_l[r32] = (a); asm volatile("s_waitcnt lgkmcnt(0)" ::: "memory"); \
    _Pragma("unroll") for (int d = 0; d < 4; ++d) _Pragma("unroll") for (int r = 0; r < 16; ++r) o[d][r] *= al_l[crow(r, hi)]; } } while (0)
    f32x16 p0, p1; float mn, al; bf16x8 pa0, pa1, pa2, pa3; const int NT = seq / KVBLK;
    SLOAD(0); VM_WAIT(); SWRITE(0); __syncthreads();
    for (int j = 0; j < NT; ++j) {
        const int b = j & 1;
        if (j + 1 < NT) SLOAD((j + 1) * KVBLK);
        SBAR(); qkt(p0, p1, K_lds + b * SHM_K, qr, r32, hi);
        partialSM(p0, p1, m_reg, mn, al);
        finishSM(p0, p1, al, l_reg, pa0, pa1, pa2, pa3); SBAR();
        RESC(al);
        pv_d0(o, vb0 + b * SHM_V, pa0, pa1, pa2, pa3);
        if (j + 1 < NT) { VM_WAIT(); SWRITE(b ^ 1); }
        __syncthreads();
    }
    if (hi == 0) li_l[r32] = l_reg; asm volatile("s_waitcnt lgkmcnt(0)" ::: "memory");
    float rli[16];
#pragma unroll
    for (int r = 0; r < 16; ++r) rli[r] = __builtin_amdgcn_rcpf(li_l[crow(r, hi)]);
    LAS char* ost = lds + wid * (QBLK * 272);
#pragma unroll
    for (int r = 0; r < 16; ++r) { const int orow = crow(r, hi);
#pragma unroll
        for (int d0 = 0; d0 < 4; ++d0) *(LAS bf16*)(ost + orow * 272 + (d0 * 32 + r32) * 2) = (bf16)(cvt_pk_bf16(o[d0][r] * rli[r], 0.f) & 0xffffu); }
    asm volatile("s_waitcnt lgkmcnt(0)" ::: "memory");
    bf16* Ow = Ob + (long)(wid * QBLK) * LDO;
#pragma unroll
    for (int i = 0; i < 8; ++i) { const int id = lane + 64 * i, orow = id >> 4, ch = id & 15;
        *(u32x4*)(Ow + (long)orow * LDO + ch * 8) = *(const LAS u32x4*)(ost + orow * 272 + ch * 16); }
    __syncthreads();
#undef SLOAD
#undef SWRITE
#undef RESC
}
}

#define XB_TMO      128
#define XB_XCNT(j)  (256  + 64 * (j))
#define XB_XSUB(j)  (1280 + 64 * (j))
#define XB_XGEN(j)  (2304 + 64 * (j))
#define XB_TOP      3328
#define XB_TOPGEN   3392
#define XCD_BAR_WORDS 3456
#define XB_SPIN_CAP (1u << 22)
__device__ __forceinline__ unsigned xb_ld(unsigned* p)              { return __hip_atomic_load(p, __ATOMIC_RELAXED, __HIP_MEMORY_SCOPE_AGENT); }
__device__ __forceinline__ unsigned xb_add(unsigned* p, unsigned v) { return __hip_atomic_fetch_add(p, v, __ATOMIC_RELAXED, __HIP_MEMORY_SCOPE_AGENT); }
__device__ __forceinline__ unsigned xb_xcc_id() { return (unsigned)__builtin_amdgcn_s_getreg((3 << 11) | 20) & 0xFu; }
#define XB_SPIN(cond, bar) do { unsigned _sp = 0; while (cond) { __builtin_amdgcn_s_sleep(1); \
    if ((++_sp & 255u) == 0u) { if (xb_ld(&(bar)[XB_TMO])) break; if (_sp > XB_SPIN_CAP) { atomicAdd(&(bar)[XB_TMO], 1u); break; } } } } while (0)
struct XcdBarrier { unsigned* bar; unsigned x; volatile LAS unsigned* st; };
__device__ __forceinline__ XcdBarrier xcd_barrier_post(unsigned* bar, volatile LAS unsigned* st) {
    XcdBarrier b; b.bar = bar; b.x = xb_xcc_id(); b.st = st;
    if (threadIdx.x == 0) (void)xb_add(&bar[XB_XCNT(b.x)], 1u);
    return b;
}
__device__ __forceinline__ void xcd_barrier_complete(unsigned* bar, unsigned x, unsigned& nloc, unsigned& nx) {
    const unsigned G = gridDim.x * gridDim.y * gridDim.z;
    unsigned sum, cnt, mine, sp = 0u;
    for (;;) {
        sum = 0u; cnt = 0u; mine = 0u;
#pragma unroll
        for (unsigned j = 0; j < 16; ++j) { const unsigned c = xb_ld(&bar[XB_XCNT(j)]); sum += c; cnt += (c > 0u) ? 1u : 0u; mine = (j == x) ? c : mine; }
        if (sum == G) break;
        __builtin_amdgcn_s_sleep(1);
        if ((++sp & 255u) == 0u) { if (xb_ld(&bar[XB_TMO])) break; if (sp > XB_SPIN_CAP) { atomicAdd(&bar[XB_TMO], 1u); break; } }
    }
    nloc = mine > 0u ? mine : 1u; nx = cnt > 0u ? cnt : 1u;
}
__device__ __forceinline__ void xcd_barrier(const XcdBarrier& b) {
    asm volatile("s_waitcnt vmcnt(0)" ::: "memory");
    __syncthreads();
    if (threadIdx.x == 0) {
        unsigned* bar = b.bar;
        __builtin_amdgcn_s_waitcnt(0);
        unsigned nloc = b.st[0], nx = b.st[1];
        if (nloc == 0u) { xcd_barrier_complete(bar, b.x, nloc, nx); b.st[0] = nloc; b.st[1] = nx; }
        const unsigned old = xb_add(&bar[XB_XSUB(b.x)], 1u);
        const unsigned gen = old / nloc;
        if (old + 1u == (gen + 1u) * nloc) {
            __builtin_amdgcn_fence(__ATOMIC_RELEASE, "agent");
            asm volatile("s_waitcnt vmcnt(0)" ::: "memory");
            const unsigned og = xb_add(&bar[XB_TOP], 1u);
            const unsigned tg = og / nx;
            if (og + 1u == (tg + 1u) * nx) xb_add(&bar[XB_TOPGEN], 1u);
            else XB_SPIN(xb_ld(&bar[XB_TOPGEN]) == tg, bar);
            __builtin_amdgcn_fence(__ATOMIC_ACQUIRE, "agent");
            xb_add(&bar[XB_XGEN(b.x)], 1u);
            asm volatile("s_waitcnt vmcnt(0)" ::: "memory");
        } else {
            XB_SPIN(xb_ld(&bar[XB_XGEN(b.x)]) == gen, bar);
            __builtin_amdgcn_fence(__ATOMIC_ACQUIRE, "agent");
            asm volatile("s_waitcnt vmcnt(0)" ::: "memory");
        }
    }
    __syncthreads();
}

struct Args {
    const float* in[32];
    float* out; unsigned char* ws;
    int lo, hi, pad0, pad1;
};
enum { I_XP = 0, I_XS, I_CP, I_CS, I_ADAW, I_ADAB, I_NMIXG, I_WIN, I_QNG, I_WUQ, I_KVNG, I_WUKV, I_WOATT, I_MU, I_W0, I_WDEC, I_A0, I_WICLR, I_WGATE,
       I_KK, I_KA, I_RK, I_GNG, I_GNB, I_WORWKV, I_WOUT, I_NFFNG, I_WUP, I_CONVW, I_CONVB, I_WDOWN, I_FNG };

constexpr int ARGTAB_OFF = MISC_OFF + 256;
struct Ctx { LAS unsigned char* lds; int tid, lane, wave, gw, ngw; };
struct PT {
    LAS unsigned char* lds; int toff;
    __device__ __forceinline__ explicit PT(const Ctx& C) { lds = C.lds; int t = ARGTAB_OFF; asm volatile("" : "+s"(t)); toff = t; }
    __device__ __forceinline__ unsigned long long raw(int i) const { const LAS unsigned* p = (const LAS unsigned*)(lds + toff) + 2 * i;
        const unsigned lo = __builtin_amdgcn_readfirstlane(p[0]), hi = __builtin_amdgcn_readfirstlane(p[1]); return ((unsigned long long)hi << 32) | lo; }
    __device__ __forceinline__ const float* in(int i) const { return (const float*)raw(i); }
    __device__ __forceinline__ float* out() const { return (float*)raw(32); }
    __device__ __forceinline__ unsigned char* ws() const { return (unsigned char*)raw(33); }
};

__device__ __forceinline__ void phase_mod(const Ctx& C) {
    const PT a(C);
    float* mod = (float*)(a.ws() + WS_MOD);
    LAS float* sil = (LAS float*)C.lds;
    for (int u = blockIdx.x; u < 192; u += gridDim.x) {
        const int cu = u % 96, kh = u / 96, l = cu / 48, n0 = (cu % 48) * 256;
        for (int i = C.tid; i < 1024 * 12; i += 512) { const int kk = i / 12, s = i % 12;
            const float c = (s < 8) ? a.in(I_CP)[s * DM + kh * 1024 + kk] : a.in(I_CS)[(s - 8) * DM + kh * 1024 + kk];
            sil[i] = c / (1.f + __expf(-c)); }
        __syncthreads();
        f32x4 acc[12];
#pragma unroll
        for (int s = 0; s < 12; ++s) acc[s] = (f32x4){0.f, 0.f, 0.f, 0.f};
        const int kb = C.wave * 128;
        const float* wp = a.in(I_ADAW) + ((size_t)l * DM + kh * 1024 + kb) * NMOD + n0 + C.lane * 4;
        for (int kk = 0; kk < 128; kk += 4) {
            f32x4 wv[4];
#pragma unroll
            for (int i = 0; i < 4; ++i) wv[i] = *(const f32x4*)(wp + (size_t)(kk + i) * NMOD);
#pragma unroll
            for (int i = 0; i < 4; ++i) {
                const LAS f32x4* sp = (const LAS f32x4*)(sil + (kb + kk + i) * 12);
                const f32x4 s0 = sp[0], s1 = sp[1], s2 = sp[2];
                acc[0] += wv[i] * s0[0]; acc[1] += wv[i] * s0[1]; acc[2] += wv[i] * s0[2]; acc[3] += wv[i] * s0[3];
                acc[4] += wv[i] * s1[0]; acc[5] += wv[i] * s1[1]; acc[6] += wv[i] * s1[2]; acc[7] += wv[i] * s1[3];
                acc[8] += wv[i] * s2[0]; acc[9] += wv[i] * s2[1]; acc[10] += wv[i] * s2[2]; acc[11] += wv[i] * s2[3];
            }
        }
        __syncthreads();
        LAS f32x4* part = (LAS f32x4*)C.lds;
#pragma unroll
        for (int s = 0; s < 12; ++s) part[(C.wave * 12 + s) * 64 + C.lane] = acc[s];
        __syncthreads();
        for (int i = C.tid; i < 12 * 64; i += 512) {
            f32x4 t = part[i];
#pragma unroll
            for (int w = 1; w < 8; ++w) t += part[w * 12 * 64 + i];
            const int s_ = i >> 6, ln = i & 63;
            if (kh == 0) t += *(const f32x4*)(a.in(I_ADAB) + (size_t)l * NMOD + n0 + ln * 4);
            float* mp = mod + ((size_t)l * 12 + s_) * NMOD + n0 + ln * 4;
#pragma unroll
            for (int j = 0; j < 4; ++j) __hip_atomic_fetch_add(mp + j, t[j], __ATOMIC_RELAXED, __HIP_MEMORY_SCOPE_AGENT);
        }
        __syncthreads();
    }
    float* rc = (float*)(a.ws() + WS_ROPE); float* rs = rc + SEQ * 32;
    for (int i = blockIdx.x * 512 + C.tid; i < SEQ * 32; i += gridDim.x * 512) {
        const int pos = i >> 5, j = i & 31;
        const double inv = 1.0 / pow(10000.0, (double)j / 32.0), ang = (double)pos * inv;
        rc[i] = (float)cos(ang); rs[i] = (float)sin(ang);
    }
}

constexpr f32x4 ZERO4 = {0.f, 0.f, 0.f, 0.f};
template <class Get> __device__ __forceinline__ void tr_tile(const Get& get, bf16* WT, int ldt, int n0, int k0, LAS float* T, int tid) {
    const int n4 = (tid & 63) * 4, kq = tid >> 6;
    f32x4 v[8];
#pragma unroll
    for (int i = 0; i < 8; ++i) v[i] = get.get4(n0 + n4, k0 + kq + 8 * i);
#pragma unroll
    for (int i = 0; i < 8; ++i) *(LAS f32x4*)(T + (kq + 8 * i) * 260 + n4) = v[i];
    __syncthreads();
    const int n = tid >> 1, kh = (tid & 1) * 32;
#pragma unroll
    for (int j = 0; j < 4; ++j) { const LAS float* t = T + (kh + 8 * j) * 260 + n;
        u32x4 o; o.x = cvt_pk_bf16(t[0], t[260]); o.y = cvt_pk_bf16(t[2 * 260], t[3 * 260]); o.z = cvt_pk_bf16(t[4 * 260], t[5 * 260]); o.w = cvt_pk_bf16(t[6 * 260], t[7 * 260]);
        *(u32x4*)(WT + (size_t)(n0 + n) * ldt + k0 + kh + 8 * j) = o; }
    __syncthreads();
}
struct GetPlain { const float* W; int ldw; __device__ __forceinline__ f32x4 get4(int n, int k) const { return *(const f32x4*)(W + (size_t)k * ldw + n); } };
struct GetWin { const float* W; __device__ __forceinline__ f32x4 get4(int n, int k) const {
    int s;
    if (n < 832) s = n; else if (n < W_MLA) s = -1; else if (n < W_MLA + RWIN) s = 832 + (n - W_MLA); else if (n < W_MLA + W_RW) s = -1; else s = 4320 + (n - W_MLA - W_RW);
    return s < 0 ? ZERO4 : *(const f32x4*)(W + (size_t)k * DIN + s); } };
struct GetUq { const float* W; const float* g; __device__ __forceinline__ f32x4 get4(int n, int k) const {
    const int hh = n / 192, c = n % 192; int s;
    if (c < 128) s = hh * 192 + c; else { const int p = c - 128, grp = p >> 3, w = p & 7; s = hh * 192 + 128 + (w >> 2) * 32 + grp * 4; }
    return *(const f32x4*)(W + (size_t)k * QW + s) * g[k]; } };
struct GetUp { const float* W; __device__ __forceinline__ f32x4 get4(int n, int k) const {
    const int t = n >> 8, w = n & 255; const int sc = (w < 128) ? t * 128 + w : DFF + t * 128 + (w - 128); return *(const f32x4*)(W + (size_t)k * (2 * DFF) + sc); } };
struct GetUkv { const float* W; const float* g; __device__ __forceinline__ f32x4 get4(int n, int k) const { return *(const f32x4*)(W + (size_t)k * 2048 + n) * g[k]; } };
struct GetLora { const float* wdec; const float* wiclr; const float* wgate;
    __device__ __forceinline__ f32x4 get4(int n, int k) const {
        if (n < 2048) { const int d = n >> 10, c = n & 1023, kk = k - d * 64; return (kk >= 0 && kk < 64) ? *(const f32x4*)(wdec + ((size_t)d * 64 + kk) * 1024 + c) : ZERO4; }
        if (n < 4096) { const int d = (n - 2048) >> 10, c = n & 1023, kk = k - 128 - d * 64; return (kk >= 0 && kk < 64) ? *(const f32x4*)(wiclr + ((size_t)d * 64 + kk) * 1024 + c) : ZERO4; }
        const int c = n - 4096; return (k < 160) ? *(const f32x4*)(wgate + (size_t)k * 1024 + c) : ZERO4; } };

__device__ __forceinline__ void phase_convert(const Ctx& C, int l) {
    const PT a(C);
    LAS float* T = (LAS float*)C.lds;
    bf16* wb = (bf16*)(a.ws() + WS_W);
    constexpr int I0 = (NPROJ / 256) * (DM / 64), I1 = (QW / 256) * (512 / 64), I2 = (2048 / 256) * (256 / 64), I3 = (DM / 256) * (1024 / 64), I4 = I3,
                  I5 = (DM / 256) * (DM / 64), I6 = (2 * DFF / 256) * (DM / 64), I7 = (DM / 256) * (DFF / 64), I8 = (LORA_N / 256) * (LORA_KB / 64);
    constexpr int NIT = I0 + I1 + I2 + I3 + I4 + I5 + I6 + I7 + I8;
    for (int it = blockIdx.x; it < NIT; it += gridDim.x) {
        int r = it;
#define ITEM(CNT, GET, OFF, KD) if (r < (CNT)) { const int nblk_k = (KD) / 64; const int nb = r / nblk_k, kb = r % nblk_k; tr_tile(GET, (bf16*)((char*)wb + (OFF)), (KD), nb * 256, kb * 64, T, C.tid); continue; } r -= (CNT);
        ITEM(I0, (GetWin{a.in(I_WIN) + (size_t)l * DM * DIN}), WO_IN, DM)
        ITEM(I1, (GetUq{a.in(I_WUQ) + (size_t)l * 512 * QW, a.in(I_QNG) + l * 512}), WO_UQ, 512)
        ITEM(I2, (GetUkv{a.in(I_WUKV) + (size_t)l * 256 * 2048, a.in(I_KVNG) + l * 256}), WO_UKV, 256)
        ITEM(I3, (GetPlain{a.in(I_WOATT) + (size_t)l * 1024 * DM, DM}), WO_OATT, 1024)
        ITEM(I4, (GetPlain{a.in(I_WORWKV) + (size_t)l * 1024 * DM, DM}), WO_ORWKV, 1024)
        ITEM(I5, (GetPlain{a.in(I_WOUT) + (size_t)l * DM * DM, DM}), WO_OUT, DM)
        ITEM(I6, (GetUp{a.in(I_WUP) + (size_t)l * DM * 2 * DFF}), WO_UP, DM)
        ITEM(I7, (GetPlain{a.in(I_WDOWN) + (size_t)l * DFF * DM, DM}), WO_DOWN, DFF)
        ITEM(I8, (GetLora{a.in(I_WDEC) + (size_t)l * 2 * 64 * 1024, a.in(I_WICLR) + (size_t)l * 2 * 64 * 1024, a.in(I_WGATE) + (size_t)l * 160 * 1024}), WO_LORA, LORA_KB)
#undef ITEM
    }
}

__device__ __forceinline__ void phase_modnorm(const Ctx& C, int gw, int ngw, const float* xsrc, bf16* H, const float* g, const float* modb, int ksh, int ksc) {
    const int per = GROWS / ngw, r0 = gw * per;
    const float* mb = modb + (size_t)(r0 >> 12) * NMOD;
    f32x4 gm[8], sh[8];
#pragma unroll
    for (int j = 0; j < 8; ++j) { const int c = 256 * j + 4 * C.lane; const f32x4 gg = *(const f32x4*)(g + c), sc = *(const f32x4*)(mb + ksc * DM + c); sh[j] = *(const f32x4*)(mb + ksh * DM + c);
#pragma unroll
        for (int i = 0; i < 4; ++i) gm[j][i] = gg[i] * (1.f + sc[i]); }
#pragma unroll 2
    for (int row = r0; row < r0 + per; ++row) {
        const float* xr = xsrc + (size_t)row * DM;
        f32x4 v[8]; float ss = 0.f;
#pragma unroll
        for (int j = 0; j < 8; ++j) { v[j] = *(const f32x4*)(xr + 256 * j + 4 * C.lane); ss += (v[j][0] * v[j][0] + v[j][1] * v[j][1]) + (v[j][2] * v[j][2] + v[j][3] * v[j][3]); }
        const float rstd = rsqrtf(wave_sum(ss) * (1.f / DM) + 1e-6f);
#pragma unroll
        for (int j = 0; j < 8; ++j) { const int c = 256 * j + 4 * C.lane;
            f32x4 y;
#pragma unroll
            for (int i = 0; i < 4; ++i) y[i] = v[j][i] * rstd * gm[j][i] + sh[j][i];
            u32x2 w; w.x = cvt_pk_bf16(y[0], y[1]); w.y = cvt_pk_bf16(y[2], y[3]);
            *(u32x2*)(H + (size_t)row * DM + c) = w; }
    }
}
__device__ __forceinline__ void phase_final(const Ctx& C, int gw, int ngw, int row_lo, int row_hi, float* out, const float* g) {
    f32x4 gv[8];
#pragma unroll
    for (int j = 0; j < 8; ++j) gv[j] = *(const f32x4*)(g + 256 * j + 4 * C.lane);
#pragma unroll 2
    for (int row = row_lo + gw; row < row_hi; row += ngw) {
        float* xr = out + (size_t)row * DM;
        f32x4 v[8]; float ss = 0.f;
#pragma unroll
        for (int j = 0; j < 8; ++j) { v[j] = *(const f32x4*)(xr + 256 * j + 4 * C.lane); ss += (v[j][0] * v[j][0] + v[j][1] * v[j][1]) + (v[j][2] * v[j][2] + v[j][3] * v[j][3]); }
        const float rstd = rsqrtf(wave_sum(ss) * (1.f / DM) + 1e-6f);
#pragma unroll
        for (int j = 0; j < 8; ++j) { const int c = 256 * j + 4 * C.lane;
            f32x4 y;
#pragma unroll
            for (int i = 0; i < 4; ++i) y[i] = v[j][i] * rstd * gv[j][i];
            *(f32x4*)(xr + c) = y; }
    }
}
__device__ __forceinline__ void phase_prep(const Ctx& C, int l) {
    const PT a(C);
    const bf16* PRW = (const bf16*)(a.ws() + A_PRW); const bf16* PMLA = (const bf16*)(a.ws() + A_PMLA);
    bf16* AL = (bf16*)(a.ws() + A_ALORA); bf16* KF = (bf16*)(a.ws() + A_KF);
    float* rstd_q = (float*)(a.ws() + WS_RSTD); float* rstd_kv = rstd_q + GROWS;
    const float* rc = (const float*)(a.ws() + WS_ROPE); const float* rs = rc + SEQ * 32;
    const float* mu0 = a.in(I_MU) + (size_t)l * 2 * RWIN; const float* mu1 = mu0 + RWIN;
    const int lane = C.lane;
    constexpr int RB = 8, NU = GROWS / RB;
    for (int u = C.gw; u < NU; u += C.ngw) {
        const int r0 = u * RB, t0 = r0 & (SEQ - 1), c0 = (384 + lane) * 8;
        const bool act = lane < 52;
        float m0[8], m1[8];
#pragma unroll
        for (int i = 0; i < 8; ++i) { m0[i] = 0.f; m1[i] = 0.f; }
        if (act) {
#pragma unroll
            for (int h = 0; h < 2; ++h) { const f32x4 x0 = *(const f32x4*)(mu0 + c0 + 4 * h), x1 = *(const f32x4*)(mu1 + c0 + 4 * h);
#pragma unroll
                for (int i = 0; i < 4; ++i) { m0[4 * h + i] = x0[i]; m1[4 * h + i] = x1[i]; } }
        }
        const bf16* xr = PRW + (size_t)r0 * W_RW + c0;
        u32x4 pv = (u32x4){0u, 0u, 0u, 0u}, cv = *(const u32x4*)xr;
        if (t0 > 0) pv = *(const u32x4*)(xr - W_RW);
#pragma unroll
        for (int r = 0; r < RB; ++r) {
            const int row = r0 + r;
            const bool hn = t0 + r + 1 < SEQ;
            u32x4 nv = *(const u32x4*)(xr + (size_t)(hn ? r + 1 : r) * W_RW);
            if (!hn) nv = (u32x4){0u, 0u, 0u, 0u};
            float xp[8], x[8], xn[8], p[8], o[8];
            unpack8(pv, xp); unpack8(cv, x); unpack8(nv, xn);
#pragma unroll
            for (int i = 0; i < 8; ++i) p[i] = x[i] + m0[i] * (xp[i] - x[i]) + m1[i] * (xn[i] - x[i]);
            if (lane < 16) {
#pragma unroll
                for (int i = 0; i < 8; ++i) o[i] = tanhf(p[i]);
                store8(AL + (size_t)row * LORA_K + lane * 8, o);
            } else if (lane < 32) { store8(AL + (size_t)row * LORA_K + 128 + (lane - 16) * 8, p); }
            else if (lane < 52) {
#pragma unroll
                for (int i = 0; i < 8; ++i) o[i] = sigmoidf_(p[i]);
                store8(AL + (size_t)row * LORA_K + 256 + (lane - 32) * 8, o);
            } else {
#pragma unroll
                for (int i = 0; i < 8; ++i) o[i] = 0.f;
                store8(AL + (size_t)row * LORA_K + 416 + (lane - 52) * 8, o);
            }
            pv = cv; cv = nv;
        }
    }
    for (int row = C.gw; row < GROWS; row += C.ngw) {
        const int t = row & (SEQ - 1);
        const bf16* mr = PMLA + (size_t)row * W_MLA;
        { float q[8]; load8(mr + lane * 8, q); float ss = 0.f;
#pragma unroll
          for (int i = 0; i < 8; ++i) ss += q[i] * q[i];
          ss = wave_sum(ss); if (lane == 0) rstd_q[row] = rsqrtf(ss * (1.f / 512.f) + 1e-6f); }
        { float q[8]; float ss = 0.f;
          if (lane < 32) { load8(mr + 512 + lane * 8, q);
#pragma unroll
            for (int i = 0; i < 8; ++i) ss += q[i] * q[i]; }
          ss = wave_sum(ss); if (lane == 0) rstd_kv[row] = rsqrtf(ss * (1.f / 256.f) + 1e-6f); }
        if (lane < 8) {
            const u32x2 w1 = *(const u32x2*)(mr + 768 + 4 * lane), w2 = *(const u32x2*)(mr + 800 + 4 * lane);
            const float x1[4] = {bf_lo(w1.x), bf_hi(w1.x), bf_lo(w1.y), bf_hi(w1.y)}, x2[4] = {bf_lo(w2.x), bf_hi(w2.x), bf_lo(w2.y), bf_hi(w2.y)};
            const f32x4 cs = *(const f32x4*)(rc + t * 32 + 4 * lane), sn = *(const f32x4*)(rs + t * 32 + 4 * lane);
            float o[8];
#pragma unroll
            for (int i = 0; i < 4; ++i) { o[i] = x1[i] * cs[i] - x2[i] * sn[i]; o[4 + i] = x2[i] * cs[i] + x1[i] * sn[i]; }
            const u32x4 pk = pack8(o);
#pragma unroll
            for (int hh = 0; hh < 8; ++hh) *(u32x4*)(KF + (size_t)row * KFW + hh * 192 + 128 + 8 * lane) = pk;
        }
    }
}
__device__ __forceinline__ void phase_rwkv_post(const Ctx& C, int l) {
    const PT a(C);
    const bf16* OF = (const bf16*)(a.ws() + A_OF); const bf16* OB = (const bf16*)(a.ws() + A_OB); const bf16* PRW = (const bf16*)(a.ws() + A_PRW);
    const float* mu0 = a.in(I_MU) + (size_t)l * 2 * RWIN + 2048; const float* mu1 = mu0 + RWIN;
    const bf16* LO = (const bf16*)(a.ws() + A_LORAOUT); bf16* RO = (bf16*)(a.ws() + A_RWKVO);
    const float* bonus = (const float*)(a.ws() + WS_BONUS);
    const float* gng = a.in(I_GNG) + l * 1024; const float* gnb = a.in(I_GNB) + l * 1024;
    const int lane = C.lane;
    f32x4 maK[2], mbK[2], naK[2], nbK[2], g0K[2], g1K[2], b0K[2], b1K[2];
#pragma unroll
    for (int it = 0; it < 2; ++it) { const int c0 = (it * 64 + lane) * 8;
        maK[it] = *(const f32x4*)(mu0 + c0); mbK[it] = *(const f32x4*)(mu0 + c0 + 4); naK[it] = *(const f32x4*)(mu1 + c0); nbK[it] = *(const f32x4*)(mu1 + c0 + 4);
        g0K[it] = *(const f32x4*)(gng + c0); g1K[it] = *(const f32x4*)(gng + c0 + 4); b0K[it] = *(const f32x4*)(gnb + c0); b1K[it] = *(const f32x4*)(gnb + c0 + 4); }
    for (int row = C.gw; row < GROWS; row += C.ngw) {
        const int t = row & (SEQ - 1);
#pragma unroll
        for (int it = 0; it < 2; ++it) {
            const int c0 = (it * 64 + lane) * 8, hh = c0 >> 6;
            float of[8], ob[8], o[8], vv[8], gg[8];
            load8(OF + (size_t)row * 1024 + c0, of); load8(OB + (size_t)row * 1024 + c0, ob);
            { const bf16* vr = PRW + (size_t)row * W_RW + 2048 + c0; float x[8], xp[8], xn[8]; load8(vr, x); load8(t > 0 ? vr - W_RW : vr, xp); load8(t < SEQ - 1 ? vr + W_RW : vr, xn);
              const f32x4 ma = maK[it], mb = mbK[it], na = naK[it], nb = nbK[it];
              const float zp = t > 0 ? 1.f : 0.f, zn = t < SEQ - 1 ? 1.f : 0.f;
#pragma unroll
              for (int i = 0; i < 4; ++i) { vv[i] = x[i] + ma[i] * (xp[i] * zp - x[i]) + na[i] * (xn[i] * zn - x[i]); vv[4 + i] = x[4 + i] + mb[i] * (xp[4 + i] * zp - x[4 + i]) + nb[i] * (xn[4 + i] * zn - x[4 + i]); } }
            load8(LO + (size_t)row * LORA_N + 4096 + c0, gg);
            float s = 0.f;
#pragma unroll
            for (int i = 0; i < 8; ++i) { o[i] = of[i] + ob[i]; s += o[i]; }
            const float mean = reduce8(s) * (1.f / 64.f);
            float q = 0.f;
#pragma unroll
            for (int i = 0; i < 8; ++i) { o[i] -= mean; q += o[i] * o[i]; }
            const float rstd = rsqrtf(reduce8(q) * (1.f / 64.f) + 64e-5f);
            const float bn = bonus[(size_t)row * 16 + hh] + bonus[(size_t)(GROWS + row) * 16 + hh];
            const f32x4 g0 = g0K[it], g1 = g1K[it], b0 = b0K[it], b1 = b1K[it];
            float y[8];
#pragma unroll
            for (int i = 0; i < 4; ++i) { y[i] = (o[i] * rstd * g0[i] + b0[i] + bn * vv[i]) * gg[i]; y[4 + i] = (o[4 + i] * rstd * g1[i] + b1[i] + bn * vv[4 + i]) * gg[4 + i]; }
            store8(RO + (size_t)row * 1024 + c0, y);
        }
    }
}
__device__ __forceinline__ void phase_act_fix(const Ctx& C, int l) {
    const PT a(C);
    const bf16* EA = (const bf16*)(a.ws() + A_EA); const bf16* EB = (const bf16*)(a.ws() + A_EB); bf16* ACT = (bf16*)(a.ws() + A_ACT);
    const float* cw = a.in(I_CONVW) + (size_t)l * 3 * DFF; const float* cb = a.in(I_CONVB) + (size_t)l * DFF;
    constexpr int NT = GROWS / 256, NR = NT * 8;
    for (int u = C.gw; u < NR; u += C.ngw) {
        const int tile = u >> 3, blk = (u >> 1) & 3, e = u & 1;
        const size_t eb = (size_t)tile * 4 + blk, tok = (size_t)tile * 256 + blk * 64 + (e ? 63 : 0);
        const bf16* ac = EA + (eb * 4 + (e ? 3 : 0)) * DFF; const bf16* bc = EB + (eb * 2 + e) * DFF;
        const bf16* apv; const bf16* anx; float zp = 1.f, zn = 1.f;
        if (e == 0) { anx = EA + (eb * 4 + 1) * DFF;
            if (blk > 0) apv = EA + ((eb - 1) * 4 + 3) * DFF; else if ((tile & 15) != 0) apv = EA + ((eb - 1) * 4 + 3) * DFF; else { apv = ac; zp = 0.f; } }
        else { apv = EA + (eb * 4 + 2) * DFF;
            if (blk < 3) anx = EA + ((eb + 1) * 4 + 0) * DFF; else if ((tile & 15) != 15) anx = EA + ((eb + 1) * 4 + 0) * DFF; else { anx = ac; zn = 0.f; } }
#pragma unroll 1
        for (int it = 0; it < 11; ++it) {
            const int c0 = (it * 64 + C.lane) * 8;
            float x[8], xp[8], xn[8], b[8], o[8];
            load8(ac + c0, x); load8(apv + c0, xp); load8(anx + c0, xn); load8(bc + c0, b);
#pragma unroll
            for (int h = 0; h < 2; ++h) {
                const f32x4 w0 = *(const f32x4*)(cw + c0 + 4 * h), w1 = *(const f32x4*)(cw + DFF + c0 + 4 * h), w2 = *(const f32x4*)(cw + 2 * DFF + c0 + 4 * h), bb = *(const f32x4*)(cb + c0 + 4 * h);
#pragma unroll
                for (int i = 0; i < 4; ++i) { const int j = 4 * h + i; const float cc = xp[j] * zp * w0[i] + x[j] * w1[i] + xn[j] * zn * w2[i] + bb[i]; o[j] = cc * sigmoidf_(cc) * b[j]; }
            }
            store8(ACT + tok * DFF + c0, o);
        }
    }
}

constexpr int SCAN_T = 32, SCAN_STEP_F = 384, SCAN_BUF_F = SCAN_T * SCAN_STEP_F;
static_assert((2 * SCAN_BUF_F + 2 * SCAN_T * 64) * 4 + 2 * 2 * SCAN_T * 64 * 2 <= RING_BYTES, "scan LDS");
__device__ __forceinline__ void scan_chain(const Ctx& C, int l, int ch) {
    const PT a(C);
    const bf16* PRW = (const bf16*)(a.ws() + A_PRW); const bf16* AL = (const bf16*)(a.ws() + A_ALORA);
    float* bonus = (float*)(a.ws() + WS_BONUS);
    LAS float* buf = (LAS float*)C.lds;
    LAS float* obuf = buf + 2 * SCAN_BUF_F;
    LAS bf16* xs = (LAS bf16*)(obuf + 2 * SCAN_T * 64);
    const int tid = C.tid, lane = C.lane;
    const int d = ch & 1, hh = (ch >> 1) & 15, sq = ch >> 5;
    bf16* OD = (bf16*)(a.ws() + (d ? A_OB : A_OF));
    const bool loader = tid >= 256;
    const int lid = tid - 256, lj = lid >> 3, lg = lid & 7, chn = hh * 64 + lg * 8;
    float ka[8], rk[8], kkw[8], m0r[8], m1r[8], m0k[8], m1k[8], m0v[8], m1v[8];
    u32x4 g_r, g_rp, g_rn, g_k, g_kp, g_kn, g_v, g_vp, g_vn;
    const int mtx = (C.wave >> 1) & 1, nb = C.wave & 1, r32 = lane & 31, hi = lane >> 5;
    bf16x8 Bf[4]; float lbias = 0.f;
    if (loader) {
        const float* Wm = (mtx ? a.in(I_WICLR) : a.in(I_WDEC)) + (size_t)(l * 2 + d) * 64 * 1024 + hh * 64 + nb * 32 + r32;
#pragma unroll
        for (int ks = 0; ks < 4; ++ks) { float t_[8];
#pragma unroll
            for (int j = 0; j < 8; ++j) t_[j] = Wm[(size_t)(ks * 16 + hi * 8 + j) * 1024];
            Bf[ks] = __builtin_bit_cast(bf16x8, pack8(t_)); }
        lbias = (mtx ? a.in(I_A0) : a.in(I_W0))[l * 2048 + d * 1024 + hh * 64 + nb * 32 + r32];
    }
    if (loader) {
        const float* mu0 = a.in(I_MU) + (size_t)l * 2 * RWIN; const float* mu1 = mu0 + RWIN;
#define LD8F(dst, p) do { const f32x4 x0_ = *(const f32x4*)(p), x1_ = *(const f32x4*)((p) + 4); _Pragma("unroll") for (int i = 0; i < 4; ++i) { dst[i] = x0_[i]; dst[4 + i] = x1_[i]; } } while (0)
        LD8F(ka, a.in(I_KA) + l * 1024 + chn); LD8F(rk, a.in(I_RK) + ((size_t)(l * 2 + d) * 16 + hh) * 64 + lg * 8); LD8F(kkw, a.in(I_KK) + l * 1024 + chn);
        LD8F(m0r, mu0 + chn); LD8F(m1r, mu1 + chn); LD8F(m0k, mu0 + 1024 + chn); LD8F(m1k, mu1 + 1024 + chn); LD8F(m0v, mu0 + 2048 + chn); LD8F(m1v, mu1 + 2048 + chn);
#undef LD8F
    }
#define SC_TOK(step) (d ? (SEQ - 1 - (step)) : (step))
#define SC_ISSUE(cn) do { const int tok_ = SC_TOK((cn) * SCAN_T + lj), row_ = sq * SEQ + tok_; const bf16* rp_ = PRW + (size_t)row_ * W_RW + chn; \
        const int op_ = tok_ > 0 ? -W_RW : 0, on_ = tok_ < SEQ - 1 ? W_RW : 0; \
        g_r = *(const u32x4*)rp_; g_rp = *(const u32x4*)(rp_ + op_); g_rn = *(const u32x4*)(rp_ + on_); g_k = *(const u32x4*)(rp_ + 1024); g_kp = *(const u32x4*)(rp_ + 1024 + op_); g_kn = *(const u32x4*)(rp_ + 1024 + on_); \
        g_v = *(const u32x4*)(rp_ + 2048); g_vp = *(const u32x4*)(rp_ + 2048 + op_); g_vn = *(const u32x4*)(rp_ + 2048 + on_); } while (0)
#define ST8(p, x) do { *(LAS f32x4*)(p) = (f32x4){x[0], x[1], x[2], x[3]}; *(LAS f32x4*)((p) + 4) = (f32x4){x[4], x[5], x[6], x[7]}; } while (0)
#define SC_MIX(dst, gc, gp, gn, m0, m1) do { float x_[8], xp_[8], xn_[8]; unpack8(gc, x_); unpack8(gp, xp_); unpack8(gn, xn_); \
        _Pragma("unroll") for (int i = 0; i < 8; ++i) dst[i] = x_[i] + m0[i] * (xp_[i] * zp_ - x_[i]) + m1[i] * (xn_[i] * zn_ - x_[i]); } while (0)
#define SC_WRITE(cn) do { float r_[8], k_[8], v_[8], kk_[8], w_[8], a_[8]; unpack8(*(const LAS u32x4*)(xs + (((cn) & 1) * 2 + 0) * 2048 + lj * 64 + lg * 8), w_); unpack8(*(const LAS u32x4*)(xs + (((cn) & 1) * 2 + 1) * 2048 + lj * 64 + lg * 8), a_); \
        { const int tok_ = SC_TOK((cn) * SCAN_T + lj); const float zp_ = tok_ > 0 ? 1.f : 0.f, zn_ = tok_ < SEQ - 1 ? 1.f : 0.f; \
          SC_MIX(r_, g_r, g_rp, g_rn, m0r, m1r); SC_MIX(k_, g_k, g_kp, g_kn, m0k, m1k); SC_MIX(v_, g_v, g_vp, g_vn, m0v, m1v); \
          float ss_ = 0.f; _Pragma("unroll") for (int i = 0; i < 8; ++i) { kk_[i] = k_[i] * kkw[i]; ss_ += kk_[i] * kk_[i]; } \
          ss_ = reduce8(ss_); const float inv_ = 1.f / fmaxf(sqrtf(ss_), 1e-12f); _Pragma("unroll") for (int i = 0; i < 8; ++i) kk_[i] *= inv_; } \
        LAS float* bp_ = buf + ((cn) & 1) * SCAN_BUF_F + lj * SCAN_STEP_F + lg * 8; float bs_ = 0.f; \
        float G_[8], kt_[8], at_[8], bt_[8], rt_[8]; \
        _Pragma("unroll") for (int i = 0; i < 8; ++i) { G_[i] = __builtin_amdgcn_exp2f(-0.8750387749f * w_[i]); const float kd_ = k_[i] * (1.f + (a_[i] - 1.f) * ka[i]); bs_ += r_[i] * kd_ * rk[i]; bt_[i] = kd_; at_[i] = kk_[i] * a_[i]; } \
        _Pragma("unroll") for (int off_ = 8; off_ < 64; off_ <<= 1) { _Pragma("unroll") for (int i = 0; i < 8; ++i) { const float y_ = __shfl_up(G_[i], off_); if (lane >= off_) G_[i] *= y_; } } \
        _Pragma("unroll") for (int i = 0; i < 8; ++i) { float gp_ = __shfl_up(G_[i], 8); if (lane < 8) gp_ = 1.f; const float rg_ = 1.f / G_[i]; kt_[i] = kk_[i] * gp_; at_[i] *= rg_; bt_[i] *= rg_; rt_[i] = r_[i] * G_[i]; } \
        ST8(bp_, G_); ST8(bp_ + 64, kt_); ST8(bp_ + 128, at_); ST8(bp_ + 192, bt_); ST8(bp_ + 256, rt_); ST8(bp_ + 320, v_); \
        bs_ = reduce8(bs_); if (lg == 0) { const int row_ = sq * SEQ + SC_TOK((cn) * SCAN_T + lj); bonus[((size_t)d * GROWS + row_) * 16 + hh] = bs_; } } while (0)
#define SC_LORA(cn) do { const bf16* ap_ = AL + (size_t)(sq * SEQ + SC_TOK((cn) * SCAN_T + r32)) * LORA_K + mtx * 128 + d * 64 + hi * 8; f32x16 acc_ = {}; \
        _Pragma("unroll") for (int ks = 0; ks < 4; ++ks) acc_ = __builtin_amdgcn_mfma_f32_32x32x16_bf16(*(const bf16x8*)(ap_ + ks * 16), Bf[ks], acc_, 0, 0, 0); \
        LAS bf16* xp_ = xs + (((cn) & 1) * 2 + mtx) * 2048 + nb * 32 + r32; \
        _Pragma("unroll") for (int r = 0; r < 16; ++r) xp_[att::crow(r, hi) * 64] = (bf16)(cvt_pk_bf16(sigmoidf_(acc_[r] + lbias), 0.f) & 0xffffu); } while (0)
#define SC_OUT(cn) do { const LAS float* op_ = obuf + ((cn) & 1) * (SCAN_T * 64) + lj * 64 + lg * 8; const f32x4 o0_ = *(const LAS f32x4*)op_, o1_ = *(const LAS f32x4*)(op_ + 4); \
        const int row_ = sq * SEQ + SC_TOK((cn) * SCAN_T + lj); u32x4 w_; w_.x = cvt_pk_bf16(o0_[0], o0_[1]); w_.y = cvt_pk_bf16(o0_[2], o0_[3]); w_.z = cvt_pk_bf16(o1_[0], o1_[1]); w_.w = cvt_pk_bf16(o1_[2], o1_[3]); \
        *(u32x4*)(OD + (size_t)row_ * 1024 + hh * 64 + lg * 8) = w_; } while (0)
    constexpr int NCH = SEQ / SCAN_T;
    const int rloc = (C.wave & 3) * 8 + (lane >> 3), cg = lane & 7;
    f32x2 s01 = {0.f, 0.f}, s23 = {0.f, 0.f}, s45 = {0.f, 0.f}, s67 = {0.f, 0.f};
    f32x2 t01 = {0.f, 0.f}, t23 = {0.f, 0.f}, t45 = {0.f, 0.f}, t67 = {0.f, 0.f};
    if (loader) SC_LORA(0);
    __syncthreads();
    if (loader) { SC_ISSUE(0); SC_WRITE(0); SC_LORA(1); }
    __syncthreads();
#pragma unroll 1
    for (int cn = 0; cn < NCH; ++cn) {
        if (loader) {
            if (cn + 1 < NCH) SC_ISSUE(cn + 1);
            if (cn + 2 < NCH) SC_LORA(cn + 2);
            if (cn > 0) SC_OUT(cn - 1);
            if (cn + 1 < NCH) SC_WRITE(cn + 1);
        } else {
            const unsigned ba = (unsigned)(uintptr_t)(buf + (cn & 1) * SCAN_BUF_F + cg * 8);
            const unsigned va = (unsigned)(uintptr_t)(buf + (cn & 1) * SCAN_BUF_F + 320 + rloc);
            LAS float* op = obuf + (cn & 1) * (SCAN_T * 64) + rloc;
#define DSR128(dst, addr, off) asm volatile("ds_read_b128 %0, %1 offset:%2" : "=v"(dst) : "v"(addr), "n"(off))
#define DSR32(dst, addr, off) asm volatile("ds_read_b32 %0, %1 offset:%2" : "=v"(dst) : "v"(addr), "n"(off))
#define SC_LDE(j) do { DSR128(Ek0, ba, (j) * 1536 + 256); DSR128(Ek1, ba, (j) * 1536 + 272); DSR128(Ed0, ba, (j) * 1536 + 768); DSR128(Ed1, ba, (j) * 1536 + 784); DSR32(Evv, va, (j) * 1536); DSR32(Evu, va, (j) * 1536 + 128); } while (0)
#define SC_LDL(j) do { DSR128(La0, ba, (j) * 1536 + 512); DSR128(La1, ba, (j) * 1536 + 528); DSR128(Lr0, ba, (j) * 1536 + 1024); DSR128(Lr1, ba, (j) * 1536 + 1040); \
        if ((((j) & 7) == 7)) { DSR128(Lg0, ba, (j) * 1536); DSR128(Lg1, ba, (j) * 1536 + 16); } } while (0)
#define LO2(v) __builtin_shufflevector(v, v, 0, 1)
#define HI2(v) __builtin_shufflevector(v, v, 2, 3)
#define SC_STEP(j) do { \
        if ((((j) & 7) == 7)) asm volatile("s_waitcnt lgkmcnt(6)" : "+v"(Ek0), "+v"(Ek1), "+v"(Ed0), "+v"(Ed1), "+v"(Evv), "+v"(Evu)); \
        else asm volatile("s_waitcnt lgkmcnt(4)" : "+v"(Ek0), "+v"(Ek1), "+v"(Ed0), "+v"(Ed1), "+v"(Evv), "+v"(Evu)); \
        if ((j) > 0) { const float q_ = reduce8(cqs_); const float qv_ = reduce8(cqt_); op[((j) - 1) * 64] = q_; op[((j) - 1) * 64 + 32] = qv_; }     \
        f32x2 pp_ = s01 * LO2(Ek0); f32x2 pu_ = t01 * LO2(Ek0); pp_ = s23 * HI2(Ek0) + pp_; pu_ = t23 * HI2(Ek0) + pu_; pp_ = s45 * LO2(Ek1) + pp_; pu_ = t45 * LO2(Ek1) + pu_; pp_ = s67 * HI2(Ek1) + pp_; pu_ = t67 * HI2(Ek1) + pu_; \
        float p_ = reduce8(pp_[0] + pp_[1]); float pq_ = reduce8(pu_[0] + pu_[1]); const f32x2 v2_ = {Evv, Evv}, u2_ = {Evu, Evu}; \
        s01 = v2_ * LO2(Ed0) + s01; s23 = v2_ * HI2(Ed0) + s23; s45 = v2_ * LO2(Ed1) + s45; s67 = v2_ * HI2(Ed1) + s67; \
        t01 = u2_ * LO2(Ed0) + t01; t23 = u2_ * HI2(Ed0) + t23; t45 = u2_ * LO2(Ed1) + t45; t67 = u2_ * HI2(Ed1) + t67; \
        asm volatile("" : "+v"(s01), "+v"(s23), "+v"(s45), "+v"(s67), "+v"(t01), "+v"(t23), "+v"(t45), "+v"(t67), "+v"(p_), "+v"(pq_));     \
        SC_LDE((j) + 1); \
        if ((((j) & 7) == 7)) asm volatile("s_waitcnt lgkmcnt(6)" : "+v"(La0), "+v"(La1), "+v"(Lr0), "+v"(Lr1), "+v"(Lg0), "+v"(Lg1)); \
        else asm volatile("s_waitcnt lgkmcnt(6)" : "+v"(La0), "+v"(La1), "+v"(Lr0), "+v"(Lr1)); \
        { const f32x2 p2_ = {p_, p_}, q2_ = {pq_, pq_}; \
        s01 = s01 - p2_ * LO2(La0); s23 = s23 - p2_ * HI2(La0); s45 = s45 - p2_ * LO2(La1); s67 = s67 - p2_ * HI2(La1); \
        t01 = t01 - q2_ * LO2(La0); t23 = t23 - q2_ * HI2(La0); t45 = t45 - q2_ * LO2(La1); t67 = t67 - q2_ * HI2(La1); } \
        f32x2 qq_ = s01 * LO2(Lr0); f32x2 qu_ = t01 * LO2(Lr0); qq_ = s23 * HI2(Lr0) + qq_; qu_ = t23 * HI2(Lr0) + qu_; qq_ = s45 * LO2(Lr1) + qq_; qu_ = t45 * LO2(Lr1) + qu_; qq_ = s67 * HI2(Lr1) + qq_; qu_ = t67 * HI2(Lr1) + qu_; \
        if ((((j) & 7) == 7)) { s01 *= LO2(Lg0); s23 *= HI2(Lg0); s45 *= LO2(Lg1); s67 *= HI2(Lg1); t01 *= LO2(Lg0); t23 *= HI2(Lg0); t45 *= LO2(Lg1); t67 *= HI2(Lg1); }     \
        asm volatile("" : "+v"(qq_), "+v"(qu_), "+v"(s01), "+v"(s23), "+v"(s45), "+v"(s67), "+v"(t01), "+v"(t23), "+v"(t45), "+v"(t67));     \
        SC_LDL((j) + 1); \
        cqs_ = qq_[0] + qq_[1]; cqt_ = qu_[0] + qu_[1]; } while (0)
            f32x4 Ek0, Ek1, Ed0, Ed1, La0, La1, Lr0, Lr1, Lg0, Lg1; float Evv, Evu; float cqs_ = 0.f, cqt_ = 0.f;
            SC_LDE(0); SC_LDL(0);
#pragma unroll
            for (int j = 0; j < SCAN_T; ++j) SC_STEP(j);
            { const float q_ = reduce8(cqs_); const float qv_ = reduce8(cqt_); op[(SCAN_T - 1) * 64] = q_; op[(SCAN_T - 1) * 64 + 32] = qv_; }
            asm volatile("s_waitcnt lgkmcnt(0)" : "+v"(Ek0), "+v"(Ek1), "+v"(Ed0), "+v"(Ed1), "+v"(Evv), "+v"(Evu), "+v"(La0), "+v"(La1), "+v"(Lr0), "+v"(Lr1), "+v"(Lg0), "+v"(Lg1));
#undef DSR128
#undef DSR32
#undef SC_LDE
#undef SC_LDL
#undef SC_STEP
#undef LO2
#undef HI2
        }
        __syncthreads();
    }
    if (loader) SC_OUT(NCH - 1);
    __syncthreads();
#undef SC_TOK
#undef SC_ISSUE
#undef SC_LORA
#undef SC_MIX
#undef SC_WRITE
#undef SC_OUT
#undef ST8
}

constexpr int NT_STEPS = 12;
constexpr int N_STEPS = 1 + NLAYER * (1 + NGRP * NT_STEPS) + 1;
#ifndef NL_BUILD
#define NL_BUILD NLAYER
#endif
#ifndef NG_BUILD
#define NG_BUILD NGRP
#endif

#define IN_STEP(k) (lo <= (sbase + (k)) && (sbase + (k)) < hi)
#define END_STEP(k) do { if (sbase + (k) + 1 < hi) { const PT pb_(C); XcdBarrier bar_; bar_.bar = (unsigned*)(pb_.ws() + WS_CTL) + CW_BAR; bar_.x = xb_xcc_id(); bar_.st = (volatile LAS unsigned*)(C.lds + MISC_OFF) + 8; xcd_barrier(bar_); } } while (0)
#define STEP_PTRS const PT a(C); unsigned char* const ws = a.ws(); (void)ws; \
    const float* const mod = (const float*)(ws + WS_MOD); bf16* const wb = (bf16*)(ws + WS_W); (void)wb; \
    const float* const xsrc = (L == 0) ? ((GI < 2) ? a.in(I_XP) + grow0 * DM : a.in(I_XS) + (grow0 - 32768) * DM) : a.out() + grow0 * DM; (void)xsrc; \
    float* const xout = a.out() + grow0 * DM; (void)xout; \
    const float* const modb = mod + ((size_t)L * 12 + GI * 4) * NMOD; (void)modb;

template <int L, int GI>
__device__ __forceinline__ void group_program(const Ctx& C, const int lo, const int hi) {
    constexpr int sbase = 1 + L * (1 + NGRP * NT_STEPS) + 1 + GI * NT_STEPS;
    constexpr size_t grow0 = (size_t)GI * GROWS;
    const int gdim = gridDim.x, bidx = blockIdx.x;
    if (EN(2) && IN_STEP(0)) { if constexpr (L == 0 && GI == 0) { REPEAT(2) { STEP_PTRS; phase_modnorm(C, C.gw, C.ngw, xsrc, (bf16*)(ws + A_H), a.in(I_NMIXG) + L * DM, modb, 0, 1); } END_STEP(0); } }
    if (EN(3) && IN_STEP(1)) { REPEAT(3) { STEP_PTRS;
        pg8::Gemm gm{(const bf16*)(ws + A_H), (const bf16*)((char*)wb + WO_IN), GROWS, NPROJ - 256, DM, DM, DM}; pg8::StaticOrder S; S.init(GROWS, NPROJ - 256, gdim, bidx);
        pg8::EpiG<FProj> E{FProj{(bf16*)(ws + A_PMLA), (bf16*)(ws + A_PRW), (bf16*)(ws + A_PGATE)}};
        pg8::gemm_phase<pg8::EpiG<FProj>, pg8::StaticOrder, PG8_ALIGN, PG8_SP2>(C.lds, gm, S, E); }
        END_STEP(1); }
    if (EN(4) && IN_STEP(2)) { REPEAT(4) { phase_prep(C, L); } END_STEP(2); }
    if (EN(5) && IN_STEP(3)) { REPEAT(5) {
        { STEP_PTRS; pg8::Gemm gm{(const bf16*)(ws + A_ALORA) + 256, (const bf16*)((char*)wb + WO_LORA) + (size_t)4096 * LORA_KB, GROWS, 1024, LORA_KB, LORA_K, LORA_KB}; pg8::StaticOrder S; S.init(GROWS, 1024, gdim, bidx);
          pg8::EpiG<FLora> E{FLora{(bf16*)(ws + A_LORAOUT), a.in(I_W0) + L * 2048, a.in(I_A0) + L * 2048, 4096}};
          pg8::gemm_phase<pg8::EpiG<FLora>, pg8::StaticOrder, PG8_ALIGN, PG8_SP2>(C.lds, gm, S, E); }
        { STEP_PTRS; pg8::Gemm gm{(const bf16*)(ws + A_PMLA), (const bf16*)((char*)wb + WO_UQ), GROWS, QW, 512, W_MLA, 512}; pg8::SkewOrder<2, 0, 2> S; S.init(GROWS, QW, gdim, bidx);
          pg8::EpiG<FQ> E{FQ{(bf16*)(ws + A_Q), (const float*)(ws + WS_RSTD), (const float*)(ws + WS_ROPE), (const float*)(ws + WS_ROPE) + SEQ * 32}};
          pg8::gemm_phase<pg8::EpiG<FQ>, pg8::SkewOrder<2, 0, 2>, PG8_ALIGN, PG8_SP2>(C.lds, gm, S, E); }
        { STEP_PTRS; pg8::Gemm gm{(const bf16*)(ws + A_PMLA) + 512, (const bf16*)((char*)wb + WO_UKV), GROWS, 2048, 256, W_MLA, 256}; pg8::SkewOrder<3, 0, 2> S; S.init(GROWS, 2048, gdim, bidx);
          pg8::EpiG<FKV> E{FKV{(bf16*)(ws + A_KF), (bf16*)(ws + A_V), (const float*)(ws + WS_RSTD) + GROWS}};
          pg8::gemm_phase<pg8::EpiG<FKV>, pg8::SkewOrder<3, 0, 2>, PG8_ALIGN, PG8_SP2>(C.lds, gm, S, E); }
        { STEP_PTRS; pg8::Gemm gm{(const bf16*)(ws + A_H), (const bf16*)((char*)wb + WO_IN) + (size_t)(NPROJ - 256) * DM, GROWS, 256, DM, DM, DM}; pg8::SkewOrder<0, 1, 0> S; S.init(GROWS, 256, gdim, bidx);
          pg8::EpiG<FStore> E{FStore{(bf16*)(ws + A_PGATE) + (W_GATE - 256), W_GATE}};
          pg8::gemm_phase<pg8::EpiG<FStore>, pg8::SkewOrder<0, 1, 0>, PG8_ALIGN, PG8_SP2>(C.lds, gm, S, E); } }
        END_STEP(3); }
    if (EN(6) && IN_STEP(4)) { { STEP_PTRS;
        const bool split = (gdim == 256);
        const int xcd = bidx & 7, bi = (bidx >> 3) & 15;
        for (int rp_ = 0; rp_ < (((PROBE_MASK >> 6) & 1) ? 2 : 1); ++rp_)
        for (int pr = bidx; pr < 128; pr += gdim) scan_chain(C, L, pr);
        const int r0 = 0, nr = split ? (bidx < 128 ? 0 : 4) : (512 - bidx + gdim - 1) / gdim;
        for (int k = 0; k < nr * (((PROBE_MASK >> 7) & 1) ? 2 : 1); ++k) {
            const int kk = k % (nr > 0 ? nr : 1);
            int pi, qb;
            if (split) { pi = xcd + 8 * (r0 + kk); qb = bi; } else { const int u = bidx + kk * gdim; pi = u >> 4; qb = u & 15; }
            const int hh = pi & 7, sq = pi >> 3;
            const bf16* Qb = (const bf16*)(ws + A_Q) + ((size_t)sq * SEQ + qb * 256) * QW + hh * 192;
            const bf16* Kh = (const bf16*)(ws + A_KF) + (size_t)sq * SEQ * KFW + hh * 192;
            const bf16* Vh = (const bf16*)(ws + A_V) + (size_t)sq * SEQ * VW + hh * 128;
            bf16* Ob = (bf16*)(ws + A_ATTO) + ((size_t)sq * SEQ + qb * 256) * 1024 + hh * 128;
            att::attn_unit(Qb, Kh, Vh, Ob, SEQ, (LAS char*)C.lds);
        }
        constexpr int NL_ = (GI == NGRP - 1) ? L + 1 : L, NG_ = (GI == NGRP - 1) ? 0 : GI + 1;
        if constexpr (NL_ < NLAYER) {
            constexpr size_t ngrow0 = (size_t)NG_ * GROWS;
            const float* nx = (NL_ == 0) ? ((NG_ < 2) ? a.in(I_XP) + ngrow0 * DM : a.in(I_XS) + (ngrow0 - 32768) * DM) : a.out() + ngrow0 * DM;
            const float* nmodb = mod + ((size_t)NL_ * 12 + NG_ * 4) * NMOD;
            if (split) { if (bidx >= 128) phase_modnorm(C, (bidx - 128) * NWAVES + C.wave, 128 * NWAVES, nx, (bf16*)(ws + A_H), a.in(I_NMIXG) + NL_ * DM, nmodb, 0, 1); }
            else phase_modnorm(C, C.gw, C.ngw, nx, (bf16*)(ws + A_H), a.in(I_NMIXG) + NL_ * DM, nmodb, 0, 1);
        }
        if constexpr (L == NLAYER - 1 && GI >= 1) {
            if (split) { if (bidx >= 128) phase_final(C, (bidx - 128) * NWAVES + C.wave, 128 * NWAVES, (GI - 1) * GROWS, GI * GROWS, a.out(), a.in(I_FNG)); }
            else phase_final(C, C.gw, C.ngw, (GI - 1) * GROWS, GI * GROWS, a.out(), a.in(I_FNG));
        } }
        END_STEP(4); }
    if (EN(7) && IN_STEP(5)) { REPEAT(15) { phase_rwkv_post(C, L); } END_STEP(5); }
    if (EN(8) && IN_STEP(6)) { REPEAT(8) {
        { STEP_PTRS; pg8::Gemm gm{(const bf16*)(ws + A_ATTO), (const bf16*)((char*)wb + WO_OATT), GROWS, DM, 1024, 1024, 1024}; pg8::StaticOrder S; S.init(GROWS, DM, gdim, bidx);
          pg8::EpiG<FMergeA> E{FMergeA{(bf16*)(ws + A_MERGED), (const bf16*)(ws + A_PGATE)}};
          pg8::gemm_phase<pg8::EpiG<FMergeA>, pg8::StaticOrder, PG8_ALIGN, PG8_SP2>(C.lds, gm, S, E); }
        VM_WAIT(); __syncthreads();
        { STEP_PTRS; pg8::Gemm gm{(const bf16*)(ws + A_RWKVO), (const bf16*)((char*)wb + WO_ORWKV), GROWS, DM, 1024, 1024, 1024}; pg8::StaticOrder S; S.init(GROWS, DM, gdim, bidx);
          pg8::EpiG<FMergeB> E{FMergeB{(bf16*)(ws + A_MERGED), (const bf16*)(ws + A_PGATE)}};
          pg8::gemm_phase<pg8::EpiG<FMergeB>, pg8::StaticOrder, PG8_ALIGN, PG8_SP2>(C.lds, gm, S, E); }
          VM_WAIT(); __syncthreads(); }
        END_STEP(6); }
    if (EN(9) && IN_STEP(7)) { _Pragma("unroll") for (int rep_ = 0; rep_ < ((((PROBE_MASK >> 9) & 1) && L == 0) ? 2 : 1); ++rep_) { STEP_PTRS;
        pg8::Gemm gm{(const bf16*)(ws + A_MERGED), (const bf16*)((char*)wb + WO_OUT), GROWS, DM, DM, DM, DM}; pg8::StaticOrder S; S.init(GROWS, DM, gdim, bidx);
        pg8::EpiG<FResid> E{FResid{xsrc, xout, modb + 2 * DM}};
        pg8::gemm_phase<pg8::EpiG<FResid>, pg8::StaticOrder, false, PG8_SP2>(C.lds, gm, S, E); }
        END_STEP(7); }
    if (EN(10) && IN_STEP(8)) { REPEAT(10) { STEP_PTRS; phase_modnorm(C, C.gw, C.ngw, xout, (bf16*)(ws + A_H2), a.in(I_NFFNG) + L * DM, modb, 3, 4); } END_STEP(8); }
    if (EN(11) && IN_STEP(9)) { { STEP_PTRS;
        pg8::Gemm gm{(const bf16*)(ws + A_H2), (const bf16*)((char*)wb + WO_UP), GROWS, 2 * DFF, DM, DM, DM}; pg8::StaticOrder S; S.init(GROWS, 2 * DFF, gdim, bidx);
        EpiAct E{(bf16*)(ws + A_ACT), (bf16*)(ws + A_EA), (bf16*)(ws + A_EB), a.in(I_CONVW) + (size_t)L * 3 * DFF, a.in(I_CONVB) + (size_t)L * DFF};
        pg8::gemm_phase<EpiAct, pg8::StaticOrder, PG8_ALIGN, PG8_SP2, true>(C.lds, gm, S, E); }
        END_STEP(9); }
    if (EN(12) && IN_STEP(10)) { phase_act_fix(C, L); END_STEP(10); }
    if (EN(13) && IN_STEP(11)) { { STEP_PTRS;
        pg8::Gemm gm{(const bf16*)(ws + A_ACT), (const bf16*)((char*)wb + WO_DOWN), GROWS, DM, DFF, DFF, DFF}; pg8::StaticOrder S; S.init(GROWS, DM, gdim, bidx);
        pg8::EpiG<FResid> E{FResid{xout, xout, modb + 5 * DM}};
        pg8::gemm_phase<pg8::EpiG<FResid>, pg8::StaticOrder, false, PG8_SP2>(C.lds, gm, S, E); }
        if constexpr (GI == NGRP - 1) END_STEP(11);
    }
}
template <int L>
__device__ __forceinline__ void layer_program(const Ctx& C, const int lo, const int hi) {
    constexpr int sbase = 1 + L * (1 + NGRP * NT_STEPS);
    if (EN(1) && IN_STEP(0)) { if constexpr (L > 0) { phase_convert(C, L); END_STEP(0); } }
    group_program<L, 0>(C, lo, hi);
    if constexpr (NG_BUILD > 1) group_program<L, 1>(C, lo, hi);
    if constexpr (NG_BUILD > 2) group_program<L, 2>(C, lo, hi);
}

__global__ void __launch_bounds__(NWAVES * 64, 2) mk_fwd(Args a) {
    extern __shared__ __attribute__((aligned(16))) unsigned char lds_raw[];
    Ctx C;
    C.lds = (LAS unsigned char*)lds_raw;
    C.tid = threadIdx.x; C.lane = C.tid & 63; C.wave = __builtin_amdgcn_readfirstlane(C.tid >> 6);
    C.gw = blockIdx.x * NWAVES + C.wave; C.ngw = gridDim.x * NWAVES;
    for (int u = C.tid; u < (LDS_BYTES - LDSCTL_OFF) / 4; u += NWAVES * 64) ((LAS unsigned*)(C.lds + LDSCTL_OFF))[u] = 0u;
    __syncthreads();
    if (C.tid == 0) {
        LAS unsigned long long* t = (LAS unsigned long long*)(C.lds + ARGTAB_OFF);
#pragma unroll
        for (int i = 0; i < 32; ++i) t[i] = (unsigned long long)a.in[i];
        t[32] = (unsigned long long)a.out; t[33] = (unsigned long long)a.ws;
    }
    __syncthreads();
    const int lo = a.lo, hi = a.hi;
    if (hi - lo > 1) (void)xcd_barrier_post((unsigned*)(a.ws + WS_CTL) + CW_BAR, (volatile LAS unsigned*)(C.lds + MISC_OFF) + 8);
    { constexpr int sbase = 0; if (EN(0) && IN_STEP(0)) { phase_mod(C); __syncthreads(); phase_convert(C, 0); END_STEP(0); } }
    layer_program<0>(C, lo, hi);
    if constexpr (NL_BUILD > 1) layer_program<1>(C, lo, hi);
    { constexpr int sbase = N_STEPS - 1; if (EN(14) && IN_STEP(0)) { const PT p(C); phase_final(C, C.gw, C.ngw, (NGRP - 1) * GROWS, MALL, p.out(), p.in(I_FNG)); } }
}
#undef IN_STEP
#undef END_STEP

extern "C" void kernel_launch(void* const* d_in, const int* in_sizes, int n_in, void* d_out, int out_size, void* d_ws, size_t ws_size, hipStream_t stream) {
    static int grid = 0;
    if (grid == 0) {
        if (n_in != 32 || out_size != MALL * DM || ws_size < WS_NEED) { fprintf(stderr, "kernel_launch: unexpected shapes: n_in %d out %d ws %zu (need %zu)\n", n_in, out_size, ws_size, (size_t)WS_NEED); grid = -1; return; }
        int dev = 0, cus = 0, per_cu = 0;
        if (hipGetDevice(&dev) != hipSuccess || hipDeviceGetAttribute(&cus, hipDeviceAttributeMultiprocessorCount, dev) != hipSuccess) { grid = -1; return; }
        if (hipFuncSetAttribute((const void*)mk_fwd, hipFuncAttributeMaxDynamicSharedMemorySize, LDS_BYTES) != hipSuccess) { fprintf(stderr, "kernel_launch: hipFuncSetAttribute failed\n"); grid = -1; return; }
        if (hipOccupancyMaxActiveBlocksPerMultiprocessor(&per_cu, (const void*)mk_fwd, NWAVES * 64, LDS_BYTES) != hipSuccess || per_cu < 1) fprintf(stderr, "kernel_launch: occupancy query reports %d\n", per_cu);
        (void)hipGetLastError();
        grid = cus;
    }
    if (grid < 0) return;
    if (hipMemsetAsync((char*)d_ws + WS_CTL, 0, CTL_ZERO_BYTES, stream) != hipSuccess) return;
    Args a{};
    for (int i = 0; i < 32; ++i) a.in[i] = (const float*)d_in[i];
    a.out = (float*)d_out; a.ws = (unsigned char*)d_ws;
#if MK_MODE == 1
    a.lo = 0; a.hi = N_STEPS;
    hipLaunchKernelGGL(mk_fwd, dim3(grid), dim3(NWAVES * 64), LDS_BYTES, stream, a);
#else
    for (int s = 0; s < N_STEPS; ++s) { a.lo = s; a.hi = s + 1; hipLaunchKernelGGL(mk_fwd, dim3(grid), dim3(NWAVES * 64), LDS_BYTES, stream, a); }
#endif
}
```

```cpp
#include <hip/hip_runtime.h>
#include <cstdio>
#include <cstdint>

#ifndef MK_MODE
#define MK_MODE 1
#endif

#ifndef ONLY
#define ONLY -1
#endif
#ifndef PROBE_MASK
#define PROBE_MASK 0
#endif
#define REPEAT(k) _Pragma("unroll") for (int rep_ = 0; rep_ < (((PROBE_MASK >> (k)) & 1) ? 2 : 1); ++rep_)
#define EN(k) (ONLY < 0 || ONLY == (k))
#define LAS __attribute__((address_space(3)))
#define GAS __attribute__((address_space(1)))
typedef unsigned short bf16;
typedef short bf16x8 __attribute__((ext_vector_type(8)));
typedef short s16x4 __attribute__((ext_vector_type(4)));
typedef float f32x4 __attribute__((ext_vector_type(4)));
typedef float f32x2 __attribute__((ext_vector_type(2)));
typedef float f32x16 __attribute__((ext_vector_type(16)));
typedef unsigned u32x4 __attribute__((ext_vector_type(4)));
typedef unsigned u32x2 __attribute__((ext_vector_type(2)));
typedef GAS unsigned gu32;

constexpr int DM = 2048, NSEQ = 12, SEQ = 4096, MALL = NSEQ * SEQ;
constexpr int NLAYER = 2;
constexpr int GROWS = 16384, NGRP = MALL / GROWS;
constexpr int DIN = 8416, W_MLA = 832, W_RW = 3520, W_GATE = 4096, NPROJ = W_MLA + W_RW + W_GATE;
constexpr int RWIN = 3488;
constexpr int DFF = 5632;
constexpr int NMOD = 6 * DM;
constexpr int QW = 1536, KFW = 1536, VW = 1024;
constexpr int LORA_K = 512, LORA_N = 5120, LORA_KB = 256;
constexpr int NWAVES = 8;

constexpr size_t MiB = 1u << 20;
constexpr size_t WS_CTL = 0, CTL_ZERO_BYTES = 3 * MiB;
constexpr size_t WS_MOD = 1 * MiB;
constexpr size_t WS_ROPE = 3 * MiB;
constexpr size_t WS_RSTD = 4 * MiB;
constexpr size_t WS_BONUS = 5 * MiB;
constexpr size_t WS_W = 8 * MiB;
constexpr size_t WO_IN = 0, WO_UQ = WO_IN + (size_t)NPROJ * DM * 2, WO_UKV = WO_UQ + (size_t)QW * 512 * 2, WO_OATT = WO_UKV + (size_t)2048 * 256 * 2,
                 WO_ORWKV = WO_OATT + (size_t)DM * 1024 * 2, WO_OUT = WO_ORWKV + (size_t)DM * 1024 * 2, WO_UP = WO_OUT + (size_t)DM * DM * 2,
                 WO_DOWN = WO_UP + (size_t)2 * DFF * DM * 2, WO_LORA = WO_DOWN + (size_t)DM * DFF * 2, WO_END = WO_LORA + (size_t)LORA_N * LORA_K * 2;
static_assert(WO_END <= 124 * MiB, "weights");
constexpr size_t WS_A = 132 * MiB;
constexpr size_t A_H = WS_A;
constexpr size_t A_PMLA = WS_A + 64 * MiB;
constexpr size_t A_PGATE = A_PMLA + 32 * MiB;
constexpr size_t A_PRW = A_PGATE + 128 * MiB;
constexpr size_t A_RKVKK = A_PRW + 112 * MiB;
constexpr size_t A_OF = A_RKVKK;
constexpr size_t A_OB = A_RKVKK + 32 * MiB;
constexpr size_t A_RWKVO = A_RKVKK + 64 * MiB;
constexpr size_t A_ALORA = A_RKVKK + 96 * MiB;
constexpr size_t A_MERGED = A_RKVKK;
constexpr size_t A_LORAOUT = A_RKVKK + 128 * MiB;
constexpr size_t A_Q = A_LORAOUT + 160 * MiB;
constexpr size_t A_KF = A_Q + 48 * MiB;
constexpr size_t A_V = A_KF + 48 * MiB;
constexpr size_t A_ATTO = A_V + 32 * MiB;
constexpr size_t A_TM_END = A_ATTO + 32 * MiB;
constexpr size_t A_MID = WS_A + 64 * MiB;
constexpr size_t A_EA = A_MID;
constexpr size_t A_EB = A_MID + 16 * MiB;
constexpr size_t A_ACT = A_MID + 352 * MiB;
constexpr size_t A_H2 = A_ACT + 176 * MiB;
constexpr size_t A_FF_END = A_H2 + 64 * MiB;
constexpr size_t WS_NEED = (A_TM_END > A_FF_END ? A_TM_END : A_FF_END);
static_assert(WS_NEED <= 1000 * MiB, "workspace map");

constexpr int CW_BAR = 4096;

constexpr int RING_BYTES = 131072, LDSCTL_OFF = RING_BYTES, MISC_OFF = LDSCTL_OFF + 320, LDS_BYTES = 147456;

#define LDS_WAIT() asm volatile("s_waitcnt lgkmcnt(0)" ::: "memory")
#define VM_WAIT() asm volatile("s_waitcnt vmcnt(0)" ::: "memory")
typedef __bf16 bf16x2_t __attribute__((ext_vector_type(2)));
__device__ __forceinline__ unsigned cvt_pk_bf16(float lo, float hi) { const f32x2 v = {lo, hi}; const bf16x2_t b = __builtin_convertvector(v, bf16x2_t); return __builtin_bit_cast(unsigned, b); }
__device__ __forceinline__ float bf_lo(unsigned w) { return __uint_as_float(w << 16); }
__device__ __forceinline__ float bf_hi(unsigned w) { return __uint_as_float(w & 0xffff0000u); }
__device__ __forceinline__ void unpack8(const u32x4 w, float (&f)[8]) { f[0] = bf_lo(w.x); f[1] = bf_hi(w.x); f[2] = bf_lo(w.y); f[3] = bf_hi(w.y); f[4] = bf_lo(w.z); f[5] = bf_hi(w.z); f[6] = bf_lo(w.w); f[7] = bf_hi(w.w); }
__device__ __forceinline__ void load8(const bf16* p, float (&f)[8]) { unpack8(*(const u32x4*)p, f); }
__device__ __forceinline__ u32x4 pack8(const float (&f)[8]) { u32x4 w; w.x = cvt_pk_bf16(f[0], f[1]); w.y = cvt_pk_bf16(f[2], f[3]); w.z = cvt_pk_bf16(f[4], f[5]); w.w = cvt_pk_bf16(f[6], f[7]); return w; }
__device__ __forceinline__ void store8(bf16* p, const float (&f)[8]) { *(u32x4*)p = pack8(f); }
__device__ __forceinline__ float sigmoidf_(float x) { return __builtin_amdgcn_rcpf(1.f + __expf(-x)); }
__device__ __forceinline__ float sigmoid_div(float x) { return 1.f / (1.f + __expf(-x)); }
__device__ __forceinline__ float wave_sum(float v) {
#pragma unroll
    for (int o = 1; o < 64; o <<= 1) v += __shfl_xor(v, o);
    return v;
}
__device__ __forceinline__ float reduce8(float x) {
    x += __builtin_bit_cast(float, __builtin_amdgcn_update_dpp(0, __builtin_bit_cast(int, x), 0xB1, 0xF, 0xF, true));
    x += __builtin_bit_cast(float, __builtin_amdgcn_update_dpp(0, __builtin_bit_cast(int, x), 0x4E, 0xF, 0xF, true));
    x += __builtin_bit_cast(float, __builtin_amdgcn_update_dpp(0, __builtin_bit_cast(int, x), 0x141, 0xF, 0xF, true));
    return x;
}

namespace pg8 {
constexpr int BM = 256, BK = 64, HALF = 128, HTB = HALF * BK * 2, STAGE_BYTES = 8 * HTB, NXCD = 8, WGM = 4;
__host__ __device__ __forceinline__ int lds_byte(int r, int c) { const int st = (r >> 4) * 2 + (c >> 5), rr = r & 15, cc = c & 31, ob = rr * 64 + cc * 2; return st * 1024 + (ob ^ (((ob >> 9) & 1) << 5)); }
__host__ __device__ __forceinline__ void stage_rc(int b, int& R, int& C) { const int st = b / 1024, sb = b % 1024, swz = sb ^ (((sb >> 9) & 1) << 5); R = (st >> 1) * 16 + swz / 64; C = (st & 1) * 32 + (swz % 64) / 2; }
__host__ __device__ __forceinline__ int perm32(int rho) { const int n = rho >> 4, i = rho & 15; return 8 * (i >> 2) + 4 * n + (i & 3); }
struct Unit { int pm, pn; };
struct Gemm { const bf16* A; const bf16* Bt; int M, N, K, lda, ldb; };
struct StaticOrder {
    int nM, nN, nwg, G, c;
    __host__ __device__ void init(int M, int N, int G_, int c_) { nM = M / BM; nN = N / BM; nwg = nM * nN; G = G_; c = c_; }
    __host__ __device__ bool next(int i, Unit& u) const {
        const long L = (long)i * G + c; if (L >= nwg) return false;
        int wgid = (int)L; { const int q = nwg / NXCD, r = nwg % NXCD, xcd = wgid % NXCD, off = wgid / NXCD; wgid = (xcd < r ? xcd * (q + 1) : r * (q + 1) + (xcd - r) * q) + off; }
        const int nig = WGM * nN, gid = wgid / nig, fm = gid * WGM, gsz = (nM - fm) < WGM ? (nM - fm) : WGM;
        u.pm = fm + ((wgid % nig) % gsz); u.pn = (wgid % nig) / gsz; return true;
    }
    __device__ __forceinline__ void a_ready(const Unit&) const {}
    __device__ __forceinline__ void done(const Unit&) const {}
};
template <int N0, int N1, int N2> struct SkewOrder {
    int nM, nN, nwg, G, c;
    __host__ __device__ void init(int M, int N, int G_, int c_) { nM = M / BM; nN = N / BM; nwg = nM * nN; G = G_; c = c_; }
    __host__ __device__ bool next(int i, Unit& u) const {
        long L;
        if (G == 256 && nwg == 128 * N0 + 64 * N1 + 64 * N2) {
            if (c < 128) { if (i >= N0) return false; L = i * 128 + c; }
            else if (c < 192) { if (i >= N1) return false; L = N0 * 128 + i * 64 + (c - 128); }
            else { if (i >= N2) return false; L = N0 * 128 + N1 * 64 + i * 64 + (c - 192); }
        } else { L = (long)i * G + c; if (L >= nwg) return false; }
        int wgid = (int)L; { const int q = nwg / NXCD, r = nwg % NXCD, xcd = wgid % NXCD, off = wgid / NXCD; wgid = (xcd < r ? xcd * (q + 1) : r * (q + 1) + (xcd - r) * q) + off; }
        const int nig = WGM * nN, gid = wgid / nig, fm = gid * WGM, gsz = (nM - fm) < WGM ? (nM - fm) : WGM;
        u.pm = fm + ((wgid % nig) % gsz); u.pn = (wgid % nig) / gsz; return true;
    }
    __device__ __forceinline__ void a_ready(const Unit&) const {}
    __device__ __forceinline__ void done(const Unit&) const {}
};
template <class F> struct EpiG {
    static constexpr bool PERM = true, AFTER_DRAIN = false;
    F f;
    __device__ __forceinline__ void operator()(const f32x4 (&acc)[2][2][4][2], const Unit& u, int wr, int wc, int fr, int fq) const {
        const int row0 = u.pm * BM + wr * 64 + fr, col0 = u.pn * BM + wc * 32 + 8 * fq;
#pragma unroll
        for (int ai = 0; ai < 2; ++ai)
#pragma unroll
            for (int m = 0; m < 4; ++m) {
                const int row = row0 + ai * HALF + m * 16;
#pragma unroll
                for (int bj = 0; bj < 2; ++bj) {
                    float v[8]; const f32x4 a0 = acc[ai][bj][m][0], a1 = acc[ai][bj][m][1];
                    v[0] = a0[0]; v[1] = a0[1]; v[2] = a0[2]; v[3] = a0[3]; v[4] = a1[0]; v[5] = a1[1]; v[6] = a1[2]; v[7] = a1[3];
                    f(row, col0 + bj * HALF, v);
                }
                asm volatile("" ::: "memory");
            }
    }
};

template <class Epi, class Sched, bool ALIGN_EPI = false, bool SP2 = false, bool PERMA = false>
__device__ __forceinline__ void gemm_phase(LAS unsigned char* lds, const Gemm g, const Sched& S, const Epi& E) {
    const int tid = threadIdx.x, wid = __builtin_amdgcn_readfirstlane(tid >> 6), lane = tid & 63, wr = wid >> 2, wc = wid & 3, fr = lane & 15, fq = lane >> 4;
    const int K = g.K, nt = K / BK;
    unsigned voffA[2], voffB[2];
#pragma unroll
    for (int i = 0; i < 2; ++i) { int R, C; stage_rc(tid * 16 + i * 8192, R, C); const int Rb = Epi::PERM ? ((R & ~31) + perm32(R & 31)) : R;
        const int Ra = PERMA ? ((R & 64) | ((R & 15) << 2) | ((R >> 4) & 3)) : R;
        voffA[i] = (unsigned)(Ra * g.lda + C) * 2u; voffB[i] = (unsigned)(Rb * g.ldb + C) * 2u; }
    const size_t kstep = (size_t)(BK * 2);
    const size_t hstepA = (size_t)HALF * g.lda * 2, hstepB = (size_t)HALF * g.ldb * 2;
    const size_t tstepA = 2 * hstepA, tstepB = 2 * hstepB;
    const unsigned ldsw = (unsigned)wid * 1024u;
    const int aoff = lds_byte(wr * 64 + fr, fq * 8), boff = lds_byte(wc * 32 + fr, fq * 8);
#define PG8_SA(b, h) (((b) * 2 + (h)) * HTB)
#define PG8_SB(b, h) ((4 + (b) * 2 + (h)) * HTB)
#define PG8_STAGE(bufoff, gbase, voff) do { _Pragma("unroll") for (int _i = 0; _i < 2; ++_i) \
        __builtin_amdgcn_global_load_lds((const unsigned*)((const char*)(gbase) + (voff)[_i]), (LAS unsigned*)(lds + (bufoff) + ldsw + _i * 8192), 16, 0, 0); } while (0)
#define PG8_LDA(dst, b, h) do { _Pragma("unroll") for (int m = 0; m < 4; ++m) _Pragma("unroll") for (int k = 0; k < 2; ++k) dst[m][k] = *(const LAS bf16x8*)(lds + PG8_SA(b, h) + aoff + m * 2048 + k * 1024); } while (0)
#define PG8_LDB(dst, b, h) do { _Pragma("unroll") for (int n = 0; n < 2; ++n) _Pragma("unroll") for (int k = 0; k < 2; ++k) dst[n][k] = *(const LAS bf16x8*)(lds + PG8_SB(b, h) + boff + n * 2048 + k * 1024); } while (0)
#define PG8_MMA(ai, bj, At, Bt) do { __builtin_amdgcn_s_setprio(1); _Pragma("unroll") for (int m = 0; m < 4; ++m) _Pragma("unroll") for (int n = 0; n < 2; ++n) _Pragma("unroll") for (int k = 0; k < 2; ++k) \
        acc[ai][bj][m][n] = __builtin_amdgcn_mfma_f32_16x16x32_bf16(Bt[n][k], At[m][k], acc[ai][bj][m][n], 0, 0, 0); __builtin_amdgcn_s_setprio(0); } while (0)
#define PG8_WAIT_V(n) asm volatile("s_waitcnt vmcnt(" #n ")" ::: "memory")
#define PG8_WAIT_L(n) asm volatile("s_waitcnt lgkmcnt(" #n ")" ::: "memory")
#define PG8_BAR __builtin_amdgcn_s_barrier()
#define PG8_SCHED __builtin_amdgcn_sched_barrier(0)
    Unit cur, nxt; int ui = 0;
    if (!S.next(0, cur)) return;
    f32x4 acc[2][2][4][2];
#pragma unroll
    for (int a = 0; a < 2; ++a)
#pragma unroll
        for (int b = 0; b < 2; ++b)
#pragma unroll
            for (int m = 0; m < 4; ++m)
#pragma unroll
                for (int n = 0; n < 2; ++n) acc[a][b][m][n] = (f32x4){0.f, 0.f, 0.f, 0.f};
    bf16x8 At[4][2], B0[2][2], B1[2][2];
    const char* cA = (const char*)g.A + (size_t)cur.pm * tstepA; const char* cB = (const char*)g.Bt + (size_t)cur.pn * tstepB;
    S.a_ready(cur);
    if constexpr (SP2) {
        PG8_STAGE(PG8_SB(0, 0), cB, voffB); PG8_STAGE(PG8_SB(0, 1), cB + hstepB, voffB); PG8_STAGE(PG8_SA(0, 0), cA, voffA); PG8_STAGE(PG8_SA(0, 1), cA + hstepA, voffA);
        if (wr == 1) PG8_BAR;
        PG8_WAIT_V(2); PG8_BAR;
        PG8_STAGE(PG8_SB(1, 0), cB + kstep, voffB); PG8_STAGE(PG8_SA(1, 0), cA + kstep, voffA); PG8_STAGE(PG8_SB(1, 1), cB + hstepB + kstep, voffB);
        PG8_WAIT_V(6); PG8_BAR;
    } else {
        PG8_STAGE(PG8_SB(0, 0), cB, voffB); PG8_STAGE(PG8_SA(0, 0), cA, voffA); PG8_STAGE(PG8_SB(0, 1), cB + hstepB, voffB); PG8_STAGE(PG8_SA(0, 1), cA + hstepA, voffA);
        if (wr == 1) PG8_BAR;
        PG8_WAIT_V(4); PG8_BAR;
        PG8_STAGE(PG8_SB(1, 0), cB + kstep, voffB); PG8_STAGE(PG8_SA(1, 0), cA + kstep, voffA); PG8_STAGE(PG8_SB(1, 1), cB + hstepB + kstep, voffB);
        PG8_WAIT_V(6); PG8_BAR;
    }
    for (;;) {
        const bool has_next = S.next(ui + 1, nxt);
        const char* nA = has_next ? (const char*)g.A + (size_t)nxt.pm * tstepA : cA; const char* nB = has_next ? (const char*)g.Bt + (size_t)nxt.pn * tstepB : cB;
#pragma unroll 1
        for (int t = 0; t < nt; t += 2) {
            const bool last = (t == nt - 2);
            const char* a1 = cA + (size_t)(t + 1) * kstep;
            const char* a2 = last ? nA : cA + (size_t)(t + 2) * kstep; const char* b2 = last ? nB : cB + (size_t)(t + 2) * kstep;
            const char* a3 = a2 + kstep; const char* b3 = b2 + kstep;
            if (last && has_next) S.a_ready(nxt);
            if constexpr (SP2) {
            PG8_LDB(B0, 0, 0); PG8_LDB(B1, 0, 1); PG8_SCHED; PG8_LDA(At, 0, 0); PG8_STAGE(PG8_SA(1, 1), a1 + hstepA, voffA);
            PG8_WAIT_V(8); PG8_WAIT_L(0); PG8_BAR; PG8_MMA(0, 0, At, B0); PG8_MMA(0, 1, At, B1); PG8_BAR; PG8_SCHED;
            PG8_LDA(At, 0, 1); PG8_STAGE(PG8_SB(0, 0), b2, voffB); PG8_STAGE(PG8_SB(0, 1), b2 + hstepB, voffB); PG8_STAGE(PG8_SA(0, 0), a2, voffA);
            PG8_WAIT_V(8); PG8_WAIT_L(0); PG8_BAR; PG8_MMA(1, 0, At, B0); PG8_MMA(1, 1, At, B1); PG8_BAR; PG8_SCHED;
            PG8_LDB(B0, 1, 0); PG8_LDB(B1, 1, 1); PG8_SCHED; PG8_LDA(At, 1, 0); PG8_STAGE(PG8_SA(0, 1), a2 + hstepA, voffA);
            PG8_WAIT_V(8); PG8_WAIT_L(0); PG8_BAR; PG8_MMA(0, 0, At, B0); PG8_MMA(0, 1, At, B1); PG8_BAR; PG8_SCHED;
            PG8_LDA(At, 1, 1); PG8_STAGE(PG8_SB(1, 0), b3, voffB); PG8_STAGE(PG8_SB(1, 1), b3 + hstepB, voffB); PG8_STAGE(PG8_SA(1, 0), a3, voffA);
            PG8_WAIT_V(8); PG8_WAIT_L(0); PG8_BAR; PG8_MMA(1, 0, At, B0); PG8_MMA(1, 1, At, B1); PG8_BAR; PG8_SCHED;
            } else {
            PG8_LDB(B0, 0, 0); PG8_SCHED; PG8_LDA(At, 0, 0); PG8_STAGE(PG8_SA(1, 1), a1 + hstepA, voffA);
            PG8_WAIT_L(8); PG8_BAR; PG8_WAIT_L(0); PG8_MMA(0, 0, At, B0); PG8_BAR; PG8_SCHED;
            PG8_LDB(B1, 0, 1); PG8_STAGE(PG8_SB(0, 0), b2, voffB);
            PG8_BAR; PG8_WAIT_L(0); PG8_MMA(0, 1, At, B1); PG8_BAR;
            PG8_LDA(At, 0, 1); PG8_STAGE(PG8_SA(0, 0), a2, voffA);
            PG8_BAR; PG8_WAIT_L(0); PG8_MMA(1, 0, At, B0); PG8_BAR; PG8_SCHED;
            PG8_STAGE(PG8_SB(0, 1), b2 + hstepB, voffB);
            PG8_WAIT_V(6); PG8_BAR; PG8_MMA(1, 1, At, B1); PG8_BAR;
            PG8_LDB(B0, 1, 0); PG8_SCHED; PG8_LDA(At, 1, 0); PG8_STAGE(PG8_SA(0, 1), a2 + hstepA, voffA);
            PG8_WAIT_L(8); PG8_BAR; PG8_WAIT_L(0); PG8_MMA(0, 0, At, B0); PG8_BAR; PG8_SCHED;
            PG8_LDB(B1, 1, 1); PG8_STAGE(PG8_SB(1, 0), b3, voffB);
            PG8_BAR; PG8_WAIT_L(0); PG8_MMA(0, 1, At, B1); PG8_BAR;
            PG8_LDA(At, 1, 1); PG8_STAGE(PG8_SA(1, 0), a3, voffA);
            PG8_BAR; PG8_WAIT_L(0); PG8_MMA(1, 0, At, B0); PG8_BAR; PG8_SCHED;
            PG8_STAGE(PG8_SB(1, 1), b3 + hstepB, voffB);
            PG8_WAIT_V(6); PG8_BAR; PG8_MMA(1, 1, At, B1); PG8_BAR;
            }
        }
        if constexpr (ALIGN_EPI) { if (wr == 0) PG8_BAR; }
        E(acc, cur, wr, wc, fr, fq); S.done(cur);
        if (!has_next) break;
#pragma unroll
        for (int a = 0; a < 2; ++a)
#pragma unroll
            for (int b = 0; b < 2; ++b)
#pragma unroll
                for (int m = 0; m < 4; ++m)
#pragma unroll
                    for (int n = 0; n < 2; ++n) acc[a][b][m][n] = (f32x4){0.f, 0.f, 0.f, 0.f};
        cur = nxt; cA = nA; cB = nB; ++ui;
        if constexpr (ALIGN_EPI) { if (wr == 1) PG8_BAR; }
    }
    PG8_WAIT_V(0);
    if constexpr (!ALIGN_EPI) { if (wr == 0) PG8_BAR; }
    PG8_BAR;
#undef PG8_SA
#undef PG8_SB
#undef PG8_STAGE
#undef PG8_LDA
#undef PG8_LDB
#undef PG8_MMA
#undef PG8_WAIT_V
#undef PG8_WAIT_L
#undef PG8_BAR
#undef PG8_SCHED
}
}
#define PG8_SP2 true
#define PG8_ALIGN true

struct FProj {
    bf16* mla; bf16* rw; bf16* gate;
    __device__ __forceinline__ void operator()(int row, int col, const float (&v)[8]) const {
        bf16* p;
        if (col < W_MLA) p = mla + (size_t)row * W_MLA + col;
        else if (col < W_MLA + W_RW) p = rw + (size_t)row * W_RW + (col - W_MLA);
        else p = gate + (size_t)row * W_GATE + (col - W_MLA - W_RW);
        store8(p, v);
    }
};
struct FStore {
    bf16* O; int ldc;
    __device__ __forceinline__ void operator()(int row, int col, const float (&v)[8]) const { store8(O + (size_t)row * ldc + col, v); }
};
struct FQ {
    bf16* Q; const float* rstd; const float* rc; const float* rs;
    __device__ __forceinline__ void operator()(int row, int col, const float (&v)[8]) const {
        const float s = rstd[row]; float o[8];
        const int c = col % 192;
        if (c >= 128) {
            const int j0 = ((c - 128) >> 3) * 4, pos = row & (SEQ - 1);
            const f32x4 cs = *(const f32x4*)(rc + pos * 32 + j0), sn = *(const f32x4*)(rs + pos * 32 + j0);
#pragma unroll
            for (int i = 0; i < 4; ++i) { const float x1 = v[i] * s, x2 = v[4 + i] * s; o[i] = x1 * cs[i] - x2 * sn[i]; o[4 + i] = x2 * cs[i] + x1 * sn[i]; }
        } else {
#pragma unroll
            for (int i = 0; i < 8; ++i) o[i] = v[i] * s;
        }
        store8(Q + (size_t)row * QW + col, o);
    }
};
struct FKV {
    bf16* KF; bf16* V; const float* rstd;
    __device__ __forceinline__ void operator()(int row, int col, const float (&v)[8]) const {
        const float s = rstd[row]; float o[8];
#pragma unroll
        for (int i = 0; i < 8; ++i) o[i] = v[i] * s;
        const int hh = col >> 8, w = col & 255;
        bf16* p = (w < 128) ? KF + (size_t)row * KFW + hh * 192 + w : V + (size_t)row * VW + hh * 128 + (w - 128);
        store8(p, o);
    }
};
struct FLora {
    bf16* O; const float* w0; const float* a0; int col0;
    __device__ __forceinline__ void operator()(int row, int colr, const float (&v)[8]) const {
        float o[8]; const int col = colr + col0;
        if (col < 4096) {
            const float* b = (col < 2048) ? w0 + col : a0 + (col - 2048);
            const f32x4 b0 = *(const f32x4*)b, b1 = *(const f32x4*)(b + 4);
#pragma unroll
            for (int i = 0; i < 4; ++i) { o[i] = sigmoidf_(v[i] + b0[i]); o[4 + i] = sigmoidf_(v[4 + i] + b1[i]); }
        } else {
#pragma unroll
            for (int i = 0; i < 8; ++i) o[i] = v[i];
        }
        store8(O + (size_t)row * LORA_N + col, o);
    }
};
struct FMergeA {
    bf16* MG; const bf16* gate;
    __device__ __forceinline__ void operator()(int row, int col, const float (&v)[8]) const {
        float gt[8], o[8]; load8(gate + (size_t)row * W_GATE + col, gt);
#pragma unroll
        for (int i = 0; i < 8; ++i) o[i] = sigmoidf_(gt[i]) * v[i];
        store8(MG + (size_t)row * DM + col, o);
    }
};
struct FMergeB {
    bf16* MG; const bf16* gate;
    __device__ __forceinline__ void operator()(int row, int col, const float (&v)[8]) const {
        float gt[8], o[8], m[8]; load8(gate + (size_t)row * W_GATE + DM + col, gt); load8(MG + (size_t)row * DM + col, m);
#pragma unroll
        for (int i = 0; i < 8; ++i) o[i] = m[i] + sigmoidf_(gt[i]) * v[i];
        store8(MG + (size_t)row * DM + col, o);
    }
};
struct FResid {
    const float* xin; float* out; const float* gt;
    __device__ __forceinline__ void operator()(int row, int col, const float (&v)[8]) const {
        const float* gp = gt + (size_t)(row >> 12) * NMOD + col;
        const f32x4 g0 = *(const f32x4*)gp, g1 = *(const f32x4*)(gp + 4);
        const float* xp = xin + (size_t)row * DM + col;
        const f32x4 x0 = *(const f32x4*)xp, x1 = *(const f32x4*)(xp + 4);
        f32x4 o0, o1;
#pragma unroll
        for (int i = 0; i < 4; ++i) { o0[i] = x0[i] + g0[i] * v[i]; o1[i] = x1[i] + g1[i] * v[4 + i]; }
        float* op = out + (size_t)row * DM + col;
        *(f32x4*)op = o0; *(f32x4*)(op + 4) = o1;
    }
};

__device__ __forceinline__ float dpp_shr1(float x) { return __builtin_bit_cast(float, __builtin_amdgcn_update_dpp(0, __builtin_bit_cast(int, x), 0x111, 0xF, 0xF, true)); }
__device__ __forceinline__ float dpp_shl1(float x) { return __builtin_bit_cast(float, __builtin_amdgcn_update_dpp(0, __builtin_bit_cast(int, x), 0x101, 0xF, 0xF, true)); }
struct EpiAct {
    static constexpr bool PERM = true, AFTER_DRAIN = false;
    bf16* ACT; bf16* EA; bf16* EB; const float* cw; const float* cb;
    __device__ __forceinline__ void operator()(const f32x4 (&acc)[2][2][4][2], const pg8::Unit& u, int wr, int wc, int fr, int fq) const {
        const int j0 = u.pn * 128 + wc * 32 + 8 * fq;
        float w0[8], w1[8], w2[8], bb[8];
#pragma unroll
        for (int h = 0; h < 2; ++h) { const f32x4 x0 = *(const f32x4*)(cw + j0 + 4 * h), x1 = *(const f32x4*)(cw + DFF + j0 + 4 * h), x2 = *(const f32x4*)(cw + 2 * DFF + j0 + 4 * h), x3 = *(const f32x4*)(cb + j0 + 4 * h);
#pragma unroll
            for (int i = 0; i < 4; ++i) { w0[4 * h + i] = x0[i]; w1[4 * h + i] = x1[i]; w2[4 * h + i] = x2[i]; bb[4 * h + i] = x3[i]; } }
#pragma unroll
        for (int ai = 0; ai < 2; ++ai) {
            float av[4][8], bv[4][8];
#pragma unroll
            for (int m = 0; m < 4; ++m)
#pragma unroll
                for (int i = 0; i < 4; ++i) { av[m][i] = acc[ai][0][m][0][i]; av[m][4 + i] = acc[ai][0][m][1][i]; bv[m][i] = acc[ai][1][m][0][i]; bv[m][4 + i] = acc[ai][1][m][1][i]; }
            float ap[8], an[8];
#pragma unroll
            for (int i = 0; i < 8; ++i) { ap[i] = dpp_shr1(av[3][i]); an[i] = dpp_shl1(av[0][i]); }
            const int blk = ai * 2 + wr; const size_t tok0 = (size_t)u.pm * 256 + blk * 64 + 4 * fr;
#pragma unroll
            for (int m = 0; m < 4; ++m) {
                float o[8];
#pragma unroll
                for (int i = 0; i < 8; ++i) { const float xm = (m == 0) ? ap[i] : av[m == 0 ? 0 : m - 1][i], xp = (m == 3) ? an[i] : av[m == 3 ? 3 : m + 1][i];
                    const float c = w0[i] * xm + w1[i] * av[m][i] + w2[i] * xp + bb[i]; o[i] = c * sigmoidf_(c) * bv[m][i]; }
                store8(ACT + (tok0 + m) * DFF + j0, o);
            }
            const size_t eb = ((size_t)u.pm * 4 + blk);
            if (fr == 0) { store8(EA + (eb * 4 + 0) * DFF + j0, av[0]); store8(EA + (eb * 4 + 1) * DFF + j0, av[1]); store8(EB + (eb * 2 + 0) * DFF + j0, bv[0]); }
            if (fr == 15) { store8(EA + (eb * 4 + 2) * DFF + j0, av[2]); store8(EA + (eb * 4 + 3) * DFF + j0, av[3]); store8(EB + (eb * 2 + 1) * DFF + j0, bv[3]); }
            asm volatile("" ::: "memory");
        }
    }
};

namespace att {
constexpr int DQK = 192, DV = 128, NW = 8, QBLK = 32, KVBLK = 64;
constexpr float SCALE = 0.07216878364870322f;
constexpr float THR = 8.f;
constexpr int LDQ = QW, LDK = KFW, LDV = VW, LDO = 1024;
constexpr int SHM_V = KVBLK * DV * 2, SHM_K = KVBLK * DQK * 2, SHM_ATTN = 2 * SHM_V + 2 * SHM_K + NW * 64 * 4;
#define KSWZ(row, colB) ((row) * 384 + ((colB) ^ (((row) & 7) << 4)))
#define SBAR() __builtin_amdgcn_sched_barrier(0)
__device__ __forceinline__ int crow(int r, int hi) { return (r & 3) + 8 * (r >> 2) + 4 * hi; }
__device__ __forceinline__ void partialSM(f32x16& p0, f32x16& p1, float& m_reg, float& mn, float& alpha) {
    constexpr float C = SCALE * 1.4426950408889634f;
    float pmax = p0[0];
#pragma unroll
    for (int r = 1; r < 16; ++r) pmax = fmaxf(pmax, p0[r]);
#pragma unroll
    for (int r = 0; r < 16; ++r) pmax = fmaxf(pmax, p1[r]);
    { auto rr = __builtin_amdgcn_permlane32_swap(__float_as_uint(pmax), __float_as_uint(pmax), false, false);
      pmax = fmaxf(__uint_as_float(rr[0]), __uint_as_float(rr[1])); }
    if (__builtin_expect(__all(pmax - m_reg <= THR / SCALE), 1)) { mn = m_reg; alpha = 1.f; }
    else { mn = fmaxf(m_reg, pmax); alpha = __builtin_amdgcn_exp2f((m_reg - mn) * C); m_reg = mn; }
    const float mnC = -mn * C;
#pragma unroll
    for (int r = 0; r < 16; ++r) p0[r] = fmaf(p0[r], C, mnC);
#pragma unroll
    for (int r = 0; r < 16; ++r) p1[r] = fmaf(p1[r], C, mnC);
#pragma unroll
    for (int r = 0; r < 16; ++r) p0[r] = __builtin_amdgcn_exp2f(p0[r]);
}
__device__ __forceinline__ void finishSM(f32x16& p0, f32x16& p1, float alpha, float& l_reg, bf16x8& pa0, bf16x8& pa1, bf16x8& pa2, bf16x8& pa3) {
#pragma unroll
    for (int r = 0; r < 16; ++r) p1[r] = __builtin_amdgcn_exp2f(p1[r]);
    float ps = 0;
#pragma unroll
    for (int r = 0; r < 16; ++r) ps += p0[r];
#pragma unroll
    for (int r = 0; r < 16; ++r) ps += p1[r];
    { auto rr = __builtin_amdgcn_permlane32_swap(__float_as_uint(ps), __float_as_uint(ps), false, false);
      ps = __uint_as_float(rr[0]) + __uint_as_float(rr[1]); }
    l_reg = l_reg * alpha + ps;
#define PK4(P, BASE, OUT) do { unsigned a0 = cvt_pk_bf16(P[BASE + 0], P[BASE + 1]), a1 = cvt_pk_bf16(P[BASE + 2], P[BASE + 3]);   \
    unsigned b0 = cvt_pk_bf16(P[BASE + 4], P[BASE + 5]), b1 = cvt_pk_bf16(P[BASE + 6], P[BASE + 7]);                              \
    auto r0 = __builtin_amdgcn_permlane32_swap(a0, b0, false, false); auto r1 = __builtin_amdgcn_permlane32_swap(a1, b1, false, false); \
    u32x4 w = {r0[0], r1[0], r0[1], r1[1]}; OUT = __builtin_bit_cast(bf16x8, w); } while (0)
    PK4(p0, 0, pa0); PK4(p0, 8, pa1); PK4(p1, 0, pa2); PK4(p1, 8, pa3);
#undef PK4
}
__device__ __forceinline__ void qkt(f32x16& p0, f32x16& p1, const LAS char* Ks, const bf16x8* qr, int r32, int hi) {
    p0 = f32x16{}; p1 = f32x16{};
#pragma unroll
    for (int d0 = 0; d0 < 12; ++d0) { const int cb = (d0 * 16 + hi * 8) * 2;
        const bf16x8 b0 = *(const LAS bf16x8*)(Ks + KSWZ(r32, cb));
        const bf16x8 b1 = *(const LAS bf16x8*)(Ks + KSWZ(32 + r32, cb));
        p0 = __builtin_amdgcn_mfma_f32_32x32x16_bf16(b0, qr[d0], p0, 0, 0, 0);
        p1 = __builtin_amdgcn_mfma_f32_32x32x16_bf16(b1, qr[d0], p1, 0, 0, 0); }
}
__device__ __forceinline__ int v_st(int k, int c) { const int kk = (k & ~0xC) | ((k & 4) << 1) | ((k & 8) >> 1); return ((kk >> 3) * 4 + (c >> 5)) * 512 + ((kk & 7) * 32 + (c & 31)) * 2; }
__device__ __forceinline__ int v_rd_base(int lane) { return ((lane & 3) << 3) | (((lane >> 2) & 3) << 6) | (((lane >> 4) & 1) << 5) | (((lane >> 5) & 1) << 8); }
constexpr int v_rd_off(int d0, int ks, int half) { return d0 * 512 + ks * 4096 + half * 2048; }
template <int OFF> __device__ __forceinline__ s16x4 tr_read(int vb) {
    s16x4 r; asm volatile("ds_read_b64_tr_b16 %0, %1 offset:%2" : "=&v"(r) : "v"(vb), "i"(OFF) : "memory"); return r;
}
template <int D0> __device__ __forceinline__ void pv_one(f32x16& od, int vb, bf16x8 pa0, bf16x8 pa1, bf16x8 pa2, bf16x8 pa3) {
    const s16x4 l0 = tr_read<v_rd_off(D0, 0, 0)>(vb), h0 = tr_read<v_rd_off(D0, 0, 1)>(vb), l1 = tr_read<v_rd_off(D0, 1, 0)>(vb), h1 = tr_read<v_rd_off(D0, 1, 1)>(vb);
    const s16x4 l2 = tr_read<v_rd_off(D0, 2, 0)>(vb), h2 = tr_read<v_rd_off(D0, 2, 1)>(vb), l3 = tr_read<v_rd_off(D0, 3, 0)>(vb), h3 = tr_read<v_rd_off(D0, 3, 1)>(vb);
    asm volatile("s_waitcnt lgkmcnt(0)" ::: "memory"); SBAR();
#define PK(L, H) (bf16x8){L[0], L[1], L[2], L[3], H[0], H[1], H[2], H[3]}
    od = __builtin_amdgcn_mfma_f32_32x32x16_bf16(pa0, PK(l0, h0), od, 0, 0, 0);
    od = __builtin_amdgcn_mfma_f32_32x32x16_bf16(pa1, PK(l1, h1), od, 0, 0, 0);
    od = __builtin_amdgcn_mfma_f32_32x32x16_bf16(pa2, PK(l2, h2), od, 0, 0, 0);
    od = __builtin_amdgcn_mfma_f32_32x32x16_bf16(pa3, PK(l3, h3), od, 0, 0, 0);
#undef PK
}
__device__ __forceinline__ void pv_d0(f32x16* o, int vb, bf16x8 pa0, bf16x8 pa1, bf16x8 pa2, bf16x8 pa3) {
    pv_one<0>(o[0], vb, pa0, pa1, pa2, pa3); pv_one<1>(o[1], vb, pa0, pa1, pa2, pa3); pv_one<2>(o[2], vb, pa0, pa1, pa2, pa3); pv_one<3>(o[3], vb, pa0, pa1, pa2, pa3);
}
__device__ __forceinline__ void attn_unit(const bf16* __restrict__ Qb, const bf16* __restrict__ Kh, const bf16* __restrict__ Vh, bf16* __restrict__ Ob, int seq, LAS char* lds) {
    const int tid = threadIdx.x, wid = tid >> 6, lane = tid & 63, r32 = lane & 31, hi = lane >> 5;
    LAS char* V_lds = lds; LAS char* K_lds = lds + 2 * SHM_V;
    LAS float* ws = (LAS float*)(lds + 2 * SHM_V + 2 * SHM_K) + wid * 64; LAS float* li_l = ws; LAS float* al_l = ws + 32;
    float m_reg = -1e30f, l_reg = 0; f32x16 o[4] = {}; bf16x8 qr[12];
    const bf16* Qw = Qb + (long)(wid * QBLK + r32) * LDQ + hi * 8;
#pragma unroll
    for (int d0 = 0; d0 < 12; ++d0) qr[d0] = *(const bf16x8*)(Qw + d0 * 16);
    const int sr = tid >> 4, sc = (tid & 15) * 8, vst0 = v_st(sr, sc), vst1 = v_st(32 + sr, sc);
    const int krow0 = tid >> 3, kch0 = tid & 7;
    const int vb0 = (int)(unsigned)(uintptr_t)V_lds + v_rd_base(lane);
    bf16x8 vs0, vs1, ks0, ks1, ks2;
#define SLOAD(k0) do { vs0 = *(const bf16x8*)(&Vh[(long)((k0) + sr) * LDV + sc]); vs1 = *(const bf16x8*)(&Vh[(long)((k0) + 32 + sr) * LDV + sc]); \
    { const bf16* kp_ = &Kh[(long)((k0) + krow0) * LDK + kch0 * 8]; ks0 = *(const bf16x8*)kp_; ks1 = *(const bf16x8*)(kp_ + 64); ks2 = *(const bf16x8*)(kp_ + 128); } } while (0)
#define SWRITE(b) do { *(LAS bf16x8*)(V_lds + (b) * SHM_V + vst0) = vs0; *(LAS bf16x8*)(V_lds + (b) * SHM_V + vst1) = vs1; \
    *(LAS bf16x8*)(K_lds + (b) * SHM_K + KSWZ(krow0, kch0 * 16)) = ks0; *(LAS bf16x8*)(K_lds + (b) * SHM_K + KSWZ(krow0, (kch0 + 8) * 16)) = ks1; \
    *(LAS bf16x8*)(K_lds + (b) * SHM_K + KSWZ(krow0, (kch0 + 16) * 16)) = ks2; } while (0)
#define RESC(a) do { if (__any((a) < 1.f)) { if (hi == 0) al_l[r32] = (a); asm volatile("s_waitcnt lgkmcnt(0)" ::: "memory"); \
    _Pragma("unroll") for (int d = 0; d < 4; ++d) _Pragma("unroll") for (int r = 0; r < 16; ++r) o[d][r] *= al_l[crow(r, hi)]; } } while (0)
    f32x16 p0, p1; float mn, al; bf16x8 pa0, pa1, pa2, pa3; const int NT = seq / KVBLK;
    SLOAD(0); VM_WAIT(); SWRITE(0); __syncthreads();
    for (int j = 0; j < NT; ++j) {
        const int b = j & 1;
        if (j + 1 < NT) SLOAD((j + 1) * KVBLK);
        SBAR(); qkt(p0, p1, K_lds + b * SHM_K, qr, r32, hi);
        partialSM(p0, p1, m_reg, mn, al);
        finishSM(p0, p1, al, l_reg, pa0, pa1, pa2, pa3); SBAR();
        RESC(al);
        pv_d0(o, vb0 + b * SHM_V, pa0, pa1, pa2, pa3);
        if (j + 1 < NT) { VM_WAIT(); SWRITE(b ^ 1); }
        __syncthreads();
    }
    if (hi == 0) li_l[r32] = l_reg; asm volatile("s_waitcnt lgkmcnt(0)" ::: "memory");
    float rli[16];
#pragma unroll
    for (int r = 0; r < 16; ++r) rli[r] = __builtin_amdgcn_rcpf(li_l[crow(r, hi)]);
    LAS char* ost = lds + wid * (QBLK * 272);
#pragma unroll
    for (int r = 0; r < 16; ++r) { const int orow = crow(r, hi);
#pragma unroll
        for (int d0 = 0; d0 < 4; ++d0) *(LAS bf16*)(ost + orow * 272 + (d0 * 32 + r32) * 2) = (bf16)(cvt_pk_bf16(o[d0][r] * rli[r], 0.f) & 0xffffu); }
    asm volatile("s_waitcnt lgkmcnt(0)" ::: "memory");
    bf16* Ow = Ob + (long)(wid * QBLK) * LDO;
#pragma unroll
    for (int i = 0; i < 8; ++i) { const int id = lane + 64 * i, orow = id >> 4, ch = id & 15;
        *(u32x4*)(Ow + (long)orow * LDO + ch * 8) = *(const LAS u32x4*)(ost + orow * 272 + ch * 16); }
    __syncthreads();
#undef SLOAD
#undef SWRITE
#undef RESC
}
}

#define XB_TMO      128
#define XB_XCNT(j)  (256  + 64 * (j))
#define XB_XSUB(j)  (1280 + 64 * (j))
#define XB_XGEN(j)  (2304 + 64 * (j))
#define XB_TOP      3328
#define XB_TOPGEN   3392
#define XCD_BAR_WORDS 3456
#define XB_SPIN_CAP (1u << 22)
__device__ __forceinline__ unsigned xb_ld(unsigned* p)              { return __hip_atomic_load(p, __ATOMIC_RELAXED, __HIP_MEMORY_SCOPE_AGENT); }
__device__ __forceinline__ unsigned xb_add(unsigned* p, unsigned v) { return __hip_atomic_fetch_add(p, v, __ATOMIC_RELAXED, __HIP_MEMORY_SCOPE_AGENT); }
__device__ __forceinline__ unsigned xb_xcc_id() { return (unsigned)__builtin_amdgcn_s_getreg((3 << 11) | 20) & 0xFu; }
#define XB_SPIN(cond, bar) do { unsigned _sp = 0; while (cond) { __builtin_amdgcn_s_sleep(1); \
    if ((++_sp & 255u) == 0u) { if (xb_ld(&(bar)[XB_TMO])) break; if (_sp > XB_SPIN_CAP) { atomicAdd(&(bar)[XB_TMO], 1u); break; } } } } while (0)
struct XcdBarrier { unsigned* bar; unsigned x; volatile LAS unsigned* st; };
__device__ __forceinline__ XcdBarrier xcd_barrier_post(unsigned* bar, volatile LAS unsigned* st) {
    XcdBarrier b; b.bar = bar; b.x = xb_xcc_id(); b.st = st;
    if (threadIdx.x == 0) (void)xb_add(&bar[XB_XCNT(b.x)], 1u);
    return b;
}
__device__ __forceinline__ void xcd_barrier_complete(unsigned* bar, unsigned x, unsigned& nloc, unsigned& nx) {
    const unsigned G = gridDim.x * gridDim.y * gridDim.z;
    unsigned sum, cnt, mine, sp = 0u;
    for (;;) {
        sum = 0u; cnt = 0u; mine = 0u;
#pragma unroll
        for (unsigned j = 0; j < 16; ++j) { const unsigned c = xb_ld(&bar[XB_XCNT(j)]); sum += c; cnt += (c > 0u) ? 1u : 0u; mine = (j == x) ? c : mine; }
        if (sum == G) break;
        __builtin_amdgcn_s_sleep(1);
        if ((++sp & 255u) == 0u) { if (xb_ld(&bar[XB_TMO])) break; if (sp > XB_SPIN_CAP) { atomicAdd(&bar[XB_TMO], 1u); break; } }
    }
    nloc = mine > 0u ? mine : 1u; nx = cnt > 0u ? cnt : 1u;
}
__device__ __forceinline__ void xcd_barrier(const XcdBarrier& b) {
    asm volatile("s_waitcnt vmcnt(0)" ::: "memory");
    __syncthreads();
    if (threadIdx.x == 0) {
        unsigned* bar = b.bar;
        __builtin_amdgcn_s_waitcnt(0);
        unsigned nloc = b.st[0], nx = b.st[1];
        if (nloc == 0u) { xcd_barrier_complete(bar, b.x, nloc, nx); b.st[0] = nloc; b.st[1] = nx; }
        const unsigned old = xb_add(&bar[XB_XSUB(b.x)], 1u);
        const unsigned gen = old / nloc;
        if (old + 1u == (gen + 1u) * nloc) {
            __builtin_amdgcn_fence(__ATOMIC_RELEASE, "agent");
            asm volatile("s_waitcnt vmcnt(0)" ::: "memory");
            const unsigned og = xb_add(&bar[XB_TOP], 1u);
            const unsigned tg = og / nx;
            if (og + 1u == (tg + 1u) * nx) xb_add(&bar[XB_TOPGEN], 1u);
            else XB_SPIN(xb_ld(&bar[XB_TOPGEN]) == tg, bar);
            __builtin_amdgcn_fence(__ATOMIC_ACQUIRE, "agent");
            xb_add(&bar[XB_XGEN(b.x)], 1u);
            asm volatile("s_waitcnt vmcnt(0)" ::: "memory");
        } else {
            XB_SPIN(xb_ld(&bar[XB_XGEN(b.x)]) == gen, bar);
            __builtin_amdgcn_fence(__ATOMIC_ACQUIRE, "agent");
            asm volatile("s_waitcnt vmcnt(0)" ::: "memory");
        }
    }
    __syncthreads();
}

struct Args {
    const float* in[32];
    float* out; unsigned char* ws;
    int lo, hi, pad0, pad1;
};
enum { I_XP = 0, I_XS, I_CP, I_CS, I_ADAW, I_ADAB, I_NMIXG, I_WIN, I_QNG, I_WUQ, I_KVNG, I_WUKV, I_WOATT, I_MU, I_W0, I_WDEC, I_A0, I_WICLR, I_WGATE,
       I_KK, I_KA, I_RK, I_GNG, I_GNB, I_WORWKV, I_WOUT, I_NFFNG, I_WUP, I_CONVW, I_CONVB, I_WDOWN, I_FNG };

constexpr int ARGTAB_OFF = MISC_OFF + 256;
struct Ctx { LAS unsigned char* lds; int tid, lane, wave, gw, ngw; };
struct PT {
    LAS unsigned char* lds; int toff;
    __device__ __forceinline__ explicit PT(const Ctx& C) { lds = C.lds; int t = ARGTAB_OFF; asm volatile("" : "+s"(t)); toff = t; }
    __device__ __forceinline__ unsigned long long raw(int i) const { const LAS unsigned* p = (const LAS unsigned*)(lds + toff) + 2 * i;
        const unsigned lo = __builtin_amdgcn_readfirstlane(p[0]), hi = __builtin_amdgcn_readfirstlane(p[1]); return ((unsigned long long)hi << 32) | lo; }
    __device__ __forceinline__ const float* in(int i) const { return (const float*)raw(i); }
    __device__ __forceinline__ float* out() const { return (float*)raw(32); }
    __device__ __forceinline__ unsigned char* ws() const { return (unsigned char*)raw(33); }
};

__device__ __forceinline__ void phase_mod(const Ctx& C) {
    const PT a(C);
    float* mod = (float*)(a.ws() + WS_MOD);
    LAS float* sil = (LAS float*)C.lds;
    for (int u = blockIdx.x; u < 192; u += gridDim.x) {
        const int cu = u % 96, kh = u / 96, l = cu / 48, n0 = (cu % 48) * 256;
        for (int i = C.tid; i < 1024 * 12; i += 512) { const int kk = i / 12, s = i % 12;
            const float c = (s < 8) ? a.in(I_CP)[s * DM + kh * 1024 + kk] : a.in(I_CS)[(s - 8) * DM + kh * 1024 + kk];
            sil[i] = c / (1.f + __expf(-c)); }
        __syncthreads();
        f32x4 acc[12];
#pragma unroll
        for (int s = 0; s < 12; ++s) acc[s] = (f32x4){0.f, 0.f, 0.f, 0.f};
        const int kb = C.wave * 128;
        const float* wp = a.in(I_ADAW) + ((size_t)l * DM + kh * 1024 + kb) * NMOD + n0 + C.lane * 4;
        for (int kk = 0; kk < 128; kk += 4) {
            f32x4 wv[4];
#pragma unroll
            for (int i = 0; i < 4; ++i) wv[i] = *(const f32x4*)(wp + (size_t)(kk + i) * NMOD);
#pragma unroll
            for (int i = 0; i < 4; ++i) {
                const LAS f32x4* sp = (const LAS f32x4*)(sil + (kb + kk + i) * 12);
                const f32x4 s0 = sp[0], s1 = sp[1], s2 = sp[2];
                acc[0] += wv[i] * s0[0]; acc[1] += wv[i] * s0[1]; acc[2] += wv[i] * s0[2]; acc[3] += wv[i] * s0[3];
                acc[4] += wv[i] * s1[0]; acc[5] += wv[i] * s1[1]; acc[6] += wv[i] * s1[2]; acc[7] += wv[i] * s1[3];
                acc[8] += wv[i] * s2[0]; acc[9] += wv[i] * s2[1]; acc[10] += wv[i] * s2[2]; acc[11] += wv[i] * s2[3];
            }
        }
        __syncthreads();
        LAS f32x4* part = (LAS f32x4*)C.lds;
#pragma unroll
        for (int s = 0; s < 12; ++s) part[(C.wave * 12 + s) * 64 + C.lane] = acc[s];
        __syncthreads();
        for (int i = C.tid; i < 12 * 64; i += 512) {
            f32x4 t = part[i];
#pragma unroll
            for (int w = 1; w < 8; ++w) t += part[w * 12 * 64 + i];
            const int s_ = i >> 6, ln = i & 63;
            if (kh == 0) t += *(const f32x4*)(a.in(I_ADAB) + (size_t)l * NMOD + n0 + ln * 4);
            float* mp = mod + ((size_t)l * 12 + s_) * NMOD + n0 + ln * 4;
#pragma unroll
            for (int j = 0; j < 4; ++j) __hip_atomic_fetch_add(mp + j, t[j], __ATOMIC_RELAXED, __HIP_MEMORY_SCOPE_AGENT);
        }
        __syncthreads();
    }
    float* rc = (float*)(a.ws() + WS_ROPE); float* rs = rc + SEQ * 32;
    for (int i = blockIdx.x * 512 + C.tid; i < SEQ * 32; i += gridDim.x * 512) {
        const int pos = i >> 5, j = i & 31;
        const double inv = 1.0 / pow(10000.0, (double)j / 32.0), ang = (double)pos * inv;
        rc[i] = (float)cos(ang); rs[i] = (float)sin(ang);
    }
}

constexpr f32x4 ZERO4 = {0.f, 0.f, 0.f, 0.f};
template <class Get> __device__ __forceinline__ void tr_tile(const Get& get, bf16* WT, int ldt, int n0, int k0, LAS float* T, int tid) {
    const int n4 = (tid & 63) * 4, kq = tid >> 6;
    f32x4 v[8];
#pragma unroll
    for (int i = 0; i < 8; ++i) v[i] = get.get4(n0 + n4, k0 + kq + 8 * i);
#pragma unroll
    for (int i = 0; i < 8; ++i) *(LAS f32x4*)(T + (kq + 8 * i) * 260 + n4) = v[i];
    __syncthreads();
    const int n = tid >> 1, kh = (tid & 1) * 32;
#pragma unroll
    for (int j = 0; j < 4; ++j) { const LAS float* t = T + (kh + 8 * j) * 260 + n;
        u32x4 o; o.x = cvt_pk_bf16(t[0], t[260]); o.y = cvt_pk_bf16(t[2 * 260], t[3 * 260]); o.z = cvt_pk_bf16(t[4 * 260], t[5 * 260]); o.w = cvt_pk_bf16(t[6 * 260], t[7 * 260]);
        *(u32x4*)(WT + (size_t)(n0 + n) * ldt + k0 + kh + 8 * j) = o; }
    __syncthreads();
}
struct GetPlain { const float* W; int ldw; __device__ __forceinline__ f32x4 get4(int n, int k) const { return *(const f32x4*)(W + (size_t)k * ldw + n); } };
struct GetWin { const float* W; __device__ __forceinline__ f32x4 get4(int n, int k) const {
    int s;
    if (n < 832) s = n; else if (n < W_MLA) s = -1; else if (n < W_MLA + RWIN) s = 832 + (n - W_MLA); else if (n < W_MLA + W_RW) s = -1; else s = 4320 + (n - W_MLA - W_RW);
    return s < 0 ? ZERO4 : *(const f32x4*)(W + (size_t)k * DIN + s); } };
struct GetUq { const float* W; const float* g; __device__ __forceinline__ f32x4 get4(int n, int k) const {
    const int hh = n / 192, c = n % 192; int s;
    if (c < 128) s = hh * 192 + c; else { const int p = c - 128, grp = p >> 3, w = p & 7; s = hh * 192 + 128 + (w >> 2) * 32 + grp * 4; }
    return *(const f32x4*)(W + (size_t)k * QW + s) * g[k]; } };
struct GetUp { const float* W; __device__ __forceinline__ f32x4 get4(int n, int k) const {
    const int t = n >> 8, w = n & 255; const int sc = (w < 128) ? t * 128 + w : DFF + t * 128 + (w - 128); return *(const f32x4*)(W + (size_t)k * (2 * DFF) + sc); } };
struct GetUkv { const float* W; const float* g; __device__ __forceinline__ f32x4 get4(int n, int k) const { return *(const f32x4*)(W + (size_t)k * 2048 + n) * g[k]; } };
struct GetLora { const float* wdec; const float* wiclr; const float* wgate;
    __device__ __forceinline__ f32x4 get4(int n, int k) const {
        if (n < 2048) { const int d = n >> 10, c = n & 1023, kk = k - d * 64; return (kk >= 0 && kk < 64) ? *(const f32x4*)(wdec + ((size_t)d * 64 + kk) * 1024 + c) : ZERO4; }
        if (n < 4096) { const int d = (n - 2048) >> 10, c = n & 1023, kk = k - 128 - d * 64; return (kk >= 0 && kk < 64) ? *(const f32x4*)(wiclr + ((size_t)d * 64 + kk) * 1024 + c) : ZERO4; }
        const int c = n - 4096; return (k < 160) ? *(const f32x4*)(wgate + (size_t)k * 1024 + c) : ZERO4; } };

__device__ __forceinline__ void phase_convert(const Ctx& C, int l) {
    const PT a(C);
    LAS float* T = (LAS float*)C.lds;
    bf16* wb = (bf16*)(a.ws() + WS_W);
    constexpr int I0 = (NPROJ / 256) * (DM / 64), I1 = (QW / 256) * (512 / 64), I2 = (2048 / 256) * (256 / 64), I3 = (DM / 256) * (1024 / 64), I4 = I3,
                  I5 = (DM / 256) * (DM / 64), I6 = (2 * DFF / 256) * (DM / 64), I7 = (DM / 256) * (DFF / 64), I8 = (LORA_N / 256) * (LORA_KB / 64);
    constexpr int NIT = I0 + I1 + I2 + I3 + I4 + I5 + I6 + I7 + I8;
    for (int it = blockIdx.x; it < NIT; it += gridDim.x) {
        int r = it;
#define ITEM(CNT, GET, OFF, KD) if (r < (CNT)) { const int nblk_k = (KD) / 64; const int nb = r / nblk_k, kb = r % nblk_k; tr_tile(GET, (bf16*)((char*)wb + (OFF)), (KD), nb * 256, kb * 64, T, C.tid); continue; } r -= (CNT);
        ITEM(I0, (GetWin{a.in(I_WIN) + (size_t)l * DM * DIN}), WO_IN, DM)
        ITEM(I1, (GetUq{a.in(I_WUQ) + (size_t)l * 512 * QW, a.in(I_QNG) + l * 512}), WO_UQ, 512)
        ITEM(I2, (GetUkv{a.in(I_WUKV) + (size_t)l * 256 * 2048, a.in(I_KVNG) + l * 256}), WO_UKV, 256)
        ITEM(I3, (GetPlain{a.in(I_WOATT) + (size_t)l * 1024 * DM, DM}), WO_OATT, 1024)
        ITEM(I4, (GetPlain{a.in(I_WORWKV) + (size_t)l * 1024 * DM, DM}), WO_ORWKV, 1024)
        ITEM(I5, (GetPlain{a.in(I_WOUT) + (size_t)l * DM * DM, DM}), WO_OUT, DM)
        ITEM(I6, (GetUp{a.in(I_WUP) + (size_t)l * DM * 2 * DFF}), WO_UP, DM)
        ITEM(I7, (GetPlain{a.in(I_WDOWN) + (size_t)l * DFF * DM, DM}), WO_DOWN, DFF)
        ITEM(I8, (GetLora{a.in(I_WDEC) + (size_t)l * 2 * 64 * 1024, a.in(I_WICLR) + (size_t)l * 2 * 64 * 1024, a.in(I_WGATE) + (size_t)l * 160 * 1024}), WO_LORA, LORA_KB)
#undef ITEM
    }
}

__device__ __forceinline__ void phase_modnorm(const Ctx& C, int gw, int ngw, const float* xsrc, bf16* H, const float* g, const float* modb, int ksh, int ksc) {
    const int per = GROWS / ngw, r0 = gw * per;
    const float* mb = modb + (size_t)(r0 >> 12) * NMOD;
    f32x4 gm[8], sh[8];
#pragma unroll
    for (int j = 0; j < 8; ++j) { const int c = 256 * j + 4 * C.lane; const f32x4 gg = *(const f32x4*)(g + c), sc = *(const f32x4*)(mb + ksc * DM + c); sh[j] = *(const f32x4*)(mb + ksh * DM + c);
#pragma unroll
        for (int i = 0; i < 4; ++i) gm[j][i] = gg[i] * (1.f + sc[i]); }
#pragma unroll 2
    for (int row = r0; row < r0 + per; ++row) {
        const float* xr = xsrc + (size_t)row * DM;
        f32x4 v[8]; float ss = 0.f;
#pragma unroll
        for (int j = 0; j < 8; ++j) { v[j] = *(const f32x4*)(xr + 256 * j + 4 * C.lane); ss += (v[j][0] * v[j][0] + v[j][1] * v[j][1]) + (v[j][2] * v[j][2] + v[j][3] * v[j][3]); }
        const float rstd = rsqrtf(wave_sum(ss) * (1.f / DM) + 1e-6f);
#pragma unroll
        for (int j = 0; j < 8; ++j) { const int c = 256 * j + 4 * C.lane;
            f32x4 y;
#pragma unroll
            for (int i = 0; i < 4; ++i) y[i] = v[j][i] * rstd * gm[j][i] + sh[j][i];
            u32x2 w; w.x = cvt_pk_bf16(y[0], y[1]); w.y = cvt_pk_bf16(y[2], y[3]);
            *(u32x2*)(H + (size_t)row * DM + c) = w; }
    }
}
__device__ __forceinline__ void phase_final(const Ctx& C, int gw, int ngw, int row_lo, int row_hi, float* out, const float* g) {
    f32x4 gv[8];
#pragma unroll
    for (int j = 0; j < 8; ++j) gv[j] = *(const f32x4*)(g + 256 * j + 4 * C.lane);
#pragma unroll 2
    for (int row = row_lo + gw; row < row_hi; row += ngw) {
        float* xr = out + (size_t)row * DM;
        f32x4 v[8]; float ss = 0.f;
#pragma unroll
        for (int j = 0; j < 8; ++j) { v[j] = *(const f32x4*)(xr + 256 * j + 4 * C.lane); ss += (v[j][0] * v[j][0] + v[j][1] * v[j][1]) + (v[j][2] * v[j][2] + v[j][3] * v[j][3]); }
        const float rstd = rsqrtf(wave_sum(ss) * (1.f / DM) + 1e-6f);
#pragma unroll
        for (int j = 0; j < 8; ++j) { const int c = 256 * j + 4 * C.lane;
            f32x4 y;
#pragma unroll
            for (int i = 0; i < 4; ++i) y[i] = v[j][i] * rstd * gv[j][i];
            *(f32x4*)(xr + c) = y; }
    }
}
__device__ __forceinline__ void phase_prep(const Ctx& C, int l) {
    const PT a(C);
    const bf16* PRW = (const bf16*)(a.ws() + A_PRW); const bf16* PMLA = (const bf16*)(a.ws() + A_PMLA);
    bf16* AL = (bf16*)(a.ws() + A_ALORA); bf16* KF = (bf16*)(a.ws() + A_KF);
    float* rstd_q = (float*)(a.ws() + WS_RSTD); float* rstd_kv = rstd_q + GROWS;
    const float* rc = (const float*)(a.ws() + WS_ROPE); const float* rs = rc + SEQ * 32;
    const float* mu0 = a.in(I_MU) + (size_t)l * 2 * RWIN; const float* mu1 = mu0 + RWIN;
    const int lane = C.lane;
    constexpr int RB = 8, NU = GROWS / RB;
    for (int u = C.gw; u < NU; u += C.ngw) {
        const int r0 = u * RB, t0 = r0 & (SEQ - 1), c0 = (384 + lane) * 8;
        const bool act = lane < 52;
        float m0[8], m1[8];
#pragma unroll
        for (int i = 0; i < 8; ++i) { m0[i] = 0.f; m1[i] = 0.f; }
        if (act) {
#pragma unroll
            for (int h = 0; h < 2; ++h) { const f32x4 x0 = *(const f32x4*)(mu0 + c0 + 4 * h), x1 = *(const f32x4*)(mu1 + c0 + 4 * h);
#pragma unroll
                for (int i = 0; i < 4; ++i) { m0[4 * h + i] = x0[i]; m1[4 * h + i] = x1[i]; } }
        }
        const bf16* xr = PRW + (size_t)r0 * W_RW + c0;
        u32x4 rwn[RB + 2];
        rwn[0] = (u32x4){0u, 0u, 0u, 0u}; rwn[RB + 1] = (u32x4){0u, 0u, 0u, 0u};
        if (t0 > 0) rwn[0] = *(const u32x4*)(xr - W_RW);
#pragma unroll
        for (int r = 0; r < RB; ++r) rwn[r + 1] = *(const u32x4*)(xr + (size_t)r * W_RW);
        if (t0 + RB < SEQ) rwn[RB + 1] = *(const u32x4*)(xr + (size_t)RB * W_RW);
#pragma unroll
        for (int r = 0; r < RB; ++r) {
            const int row = r0 + r;
            float xp[8], x[8], xn[8], p[8], o[8];
            unpack8(rwn[r], xp); unpack8(rwn[r + 1], x); unpack8(rwn[r + 2], xn);
#pragma unroll
            for (int i = 0; i < 8; ++i) p[i] = x[i] + m0[i] * (xp[i] - x[i]) + m1[i] * (xn[i] - x[i]);
            if (lane < 16) {
#pragma unroll
                for (int i = 0; i < 8; ++i) o[i] = tanhf(p[i]);
                store8(AL + (size_t)row * LORA_K + lane * 8, o);
            } else if (lane < 32) { store8(AL + (size_t)row * LORA_K + 128 + (lane - 16) * 8, p); }
            else if (lane < 52) {
#pragma unroll
                for (int i = 0; i < 8; ++i) o[i] = sigmoidf_(p[i]);
                store8(AL + (size_t)row * LORA_K + 256 + (lane - 32) * 8, o);
            } else {
#pragma unroll
                for (int i = 0; i < 8; ++i) o[i] = 0.f;
                store8(AL + (size_t)row * LORA_K + 416 + (lane - 52) * 8, o);
            }
        }
    }
    for (int row0 = C.gw * 4; row0 < GROWS; row0 += C.ngw * 4) {
        u32x4 qv[4], kv4[4]; u32x2 w1[4], w2[4];
#pragma unroll
        for (int j = 0; j < 4; ++j) { const bf16* mr = PMLA + (size_t)(row0 + j) * W_MLA;
            qv[j] = *(const u32x4*)(mr + lane * 8); kv4[j] = *(const u32x4*)(mr + 512 + (lane & 31) * 8);
            w1[j] = *(const u32x2*)(mr + 768 + 4 * (lane & 7)); w2[j] = *(const u32x2*)(mr + 800 + 4 * (lane & 7)); }
#pragma unroll
        for (int j = 0; j < 4; ++j) {
            const int row = row0 + j, t = row & (SEQ - 1);
            { float q[8]; unpack8(qv[j], q); float ss = 0.f;
#pragma unroll
              for (int i = 0; i < 8; ++i) ss += q[i] * q[i];
              ss = wave_sum(ss); if (lane == 0) rstd_q[row] = rsqrtf(ss * (1.f / 512.f) + 1e-6f); }
            { float q[8]; unpack8(kv4[j], q); float ss = 0.f;
#pragma unroll
              for (int i = 0; i < 8; ++i) ss += q[i] * q[i];
              ss = wave_sum(lane < 32 ? ss : 0.f); if (lane == 0) rstd_kv[row] = rsqrtf(ss * (1.f / 256.f) + 1e-6f); }
            if (lane < 8) {
                const float x1[4] = {bf_lo(w1[j].x), bf_hi(w1[j].x), bf_lo(w1[j].y), bf_hi(w1[j].y)}, x2[4] = {bf_lo(w2[j].x), bf_hi(w2[j].x), bf_lo(w2[j].y), bf_hi(w2[j].y)};
                const f32x4 cs = *(const f32x4*)(rc + t * 32 + 4 * lane), sn = *(const f32x4*)(rs + t * 32 + 4 * lane);
                float o[8];
#pragma unroll
                for (int i = 0; i < 4; ++i) { o[i] = x1[i] * cs[i] - x2[i] * sn[i]; o[4 + i] = x2[i] * cs[i] + x1[i] * sn[i]; }
                const u32x4 pk = pack8(o);
#pragma unroll
                for (int hh = 0; hh < 8; ++hh) *(u32x4*)(KF + (size_t)row * KFW + hh * 192 + 128 + 8 * lane) = pk;
            }
        }
    }
}
__device__ __forceinline__ void phase_rwkv_post(const Ctx& C, int l) {
    const PT a(C);
    const bf16* OF = (const bf16*)(a.ws() + A_OF); const bf16* OB = (const bf16*)(a.ws() + A_OB); const bf16* PRW = (const bf16*)(a.ws() + A_PRW);
    const float* mu0 = a.in(I_MU) + (size_t)l * 2 * RWIN + 2048; const float* mu1 = mu0 + RWIN;
    const bf16* LO = (const bf16*)(a.ws() + A_LORAOUT); bf16* RO = (bf16*)(a.ws() + A_RWKVO);
    const float* bonus = (const float*)(a.ws() + WS_BONUS);
    const float* gng = a.in(I_GNG) + l * 1024; const float* gnb = a.in(I_GNB) + l * 1024;
    const int lane = C.lane;
    f32x4 maK[2], mbK[2], naK[2], nbK[2], g0K[2], g1K[2], b0K[2], b1K[2];
#pragma unroll
    for (int it = 0; it < 2; ++it) { const int c0 = (it * 64 + lane) * 8;
        maK[it] = *(const f32x4*)(mu0 + c0); mbK[it] = *(const f32x4*)(mu0 + c0 + 4); naK[it] = *(const f32x4*)(mu1 + c0); nbK[it] = *(const f32x4*)(mu1 + c0 + 4);
        g0K[it] = *(const f32x4*)(gng + c0); g1K[it] = *(const f32x4*)(gng + c0 + 4); b0K[it] = *(const f32x4*)(gnb + c0); b1K[it] = *(const f32x4*)(gnb + c0 + 4); }
    for (int row = C.gw; row < GROWS; row += C.ngw) {
        const int t = row & (SEQ - 1);
#pragma unroll
        for (int it = 0; it < 2; ++it) {
            const int c0 = (it * 64 + lane) * 8, hh = c0 >> 6;
            float of[8], ob[8], o[8], vv[8], gg[8];
            load8(OF + (size_t)row * 1024 + c0, of); load8(OB + (size_t)row * 1024 + c0, ob);
            { const bf16* vr = PRW + (size_t)row * W_RW + 2048 + c0; float x[8], xp[8], xn[8]; load8(vr, x); load8(t > 0 ? vr - W_RW : vr, xp); load8(t < SEQ - 1 ? vr + W_RW : vr, xn);
              const f32x4 ma = maK[it], mb = mbK[it], na = naK[it], nb = nbK[it];
              const float zp = t > 0 ? 1.f : 0.f, zn = t < SEQ - 1 ? 1.f : 0.f;
#pragma unroll
              for (int i = 0; i < 4; ++i) { vv[i] = x[i] + ma[i] * (xp[i] * zp - x[i]) + na[i] * (xn[i] * zn - x[i]); vv[4 + i] = x[4 + i] + mb[i] * (xp[4 + i] * zp - x[4 + i]) + nb[i] * (xn[4 + i] * zn - x[4 + i]); } }
            load8(LO + (size_t)row * LORA_N + 4096 + c0, gg);
            float s = 0.f;
#pragma unroll
            for (int i = 0; i < 8; ++i) { o[i] = of[i] + ob[i]; s += o[i]; }
            const float mean = reduce8(s) * (1.f / 64.f);
            float q = 0.f;
#pragma unroll
            for (int i = 0; i < 8; ++i) { o[i] -= mean; q += o[i] * o[i]; }
            const float rstd = rsqrtf(reduce8(q) * (1.f / 64.f) + 64e-5f);
            const float bn = bonus[(size_t)row * 16 + hh] + bonus[(size_t)(GROWS + row) * 16 + hh];
            const f32x4 g0 = g0K[it], g1 = g1K[it], b0 = b0K[it], b1 = b1K[it];
            float y[8];
#pragma unroll
            for (int i = 0; i < 4; ++i) { y[i] = (o[i] * rstd * g0[i] + b0[i] + bn * vv[i]) * gg[i]; y[4 + i] = (o[4 + i] * rstd * g1[i] + b1[i] + bn * vv[4 + i]) * gg[4 + i]; }
            store8(RO + (size_t)row * 1024 + c0, y);
        }
    }
}
__device__ __forceinline__ void phase_act_fix(const Ctx& C, int l) {
    const PT a(C);
    const bf16* EA = (const bf16*)(a.ws() + A_EA); const bf16* EB = (const bf16*)(a.ws() + A_EB); bf16* ACT = (bf16*)(a.ws() + A_ACT);
    const float* cw = a.in(I_CONVW) + (size_t)l * 3 * DFF; const float* cb = a.in(I_CONVB) + (size_t)l * DFF;
    constexpr int NT = GROWS / 256, NR = NT * 8;
    for (int u = C.gw; u < NR; u += C.ngw) {
        const int tile = u >> 3, blk = (u >> 1) & 3, e = u & 1;
        const size_t eb = (size_t)tile * 4 + blk, tok = (size_t)tile * 256 + blk * 64 + (e ? 63 : 0);
        const bf16* ac = EA + (eb * 4 + (e ? 3 : 0)) * DFF; const bf16* bc = EB + (eb * 2 + e) * DFF;
        const bf16* apv; const bf16* anx; float zp = 1.f, zn = 1.f;
        if (e == 0) { anx = EA + (eb * 4 + 1) * DFF;
            if (blk > 0) apv = EA + ((eb - 1) * 4 + 3) * DFF; else if ((tile & 15) != 0) apv = EA + ((eb - 1) * 4 + 3) * DFF; else { apv = ac; zp = 0.f; } }
        else { apv = EA + (eb * 4 + 2) * DFF;
            if (blk < 3) anx = EA + ((eb + 1) * 4 + 0) * DFF; else if ((tile & 15) != 15) anx = EA + ((eb + 1) * 4 + 0) * DFF; else { anx = ac; zn = 0.f; } }
#pragma unroll 1
        for (int it = 0; it < 11; ++it) {
            const int c0 = (it * 64 + C.lane) * 8;
            float x[8], xp[8], xn[8], b[8], o[8];
            load8(ac + c0, x); load8(apv + c0, xp); load8(anx + c0, xn); load8(bc + c0, b);
#pragma unroll
            for (int h = 0; h < 2; ++h) {
                const f32x4 w0 = *(const f32x4*)(cw + c0 + 4 * h), w1 = *(const f32x4*)(cw + DFF + c0 + 4 * h), w2 = *(const f32x4*)(cw + 2 * DFF + c0 + 4 * h), bb = *(const f32x4*)(cb + c0 + 4 * h);
#pragma unroll
                for (int i = 0; i < 4; ++i) { const int j = 4 * h + i; const float cc = xp[j] * zp * w0[i] + x[j] * w1[i] + xn[j] * zn * w2[i] + bb[i]; o[j] = cc * sigmoidf_(cc) * b[j]; }
            }
            store8(ACT + tok * DFF + c0, o);
        }
    }
}

constexpr int SCAN_T = 32, SCAN_STEP_F = 384, SCAN_BUF_F = SCAN_T * SCAN_STEP_F;
static_assert((2 * SCAN_BUF_F + 2 * SCAN_T * 64) * 4 + 2 * 2 * SCAN_T * 64 * 2 <= RING_BYTES, "scan LDS");
__device__ __forceinline__ void scan_chain(const Ctx& C, int l, int ch) {
    const PT a(C);
    const bf16* PRW = (const bf16*)(a.ws() + A_PRW); const bf16* AL = (const bf16*)(a.ws() + A_ALORA);
    float* bonus = (float*)(a.ws() + WS_BONUS);
    LAS float* buf = (LAS float*)C.lds;
    LAS float* obuf = buf + 2 * SCAN_BUF_F;
    LAS bf16* xs = (LAS bf16*)(obuf + 2 * SCAN_T * 64);
    const int tid = C.tid, lane = C.lane;
    const int d = ch & 1, hh = (ch >> 1) & 15, sq = ch >> 5;
    bf16* OD = (bf16*)(a.ws() + (d ? A_OB : A_OF));
    const bool loader = tid >= 256;
    const int lid = tid - 256, lj = lid >> 3, lg = lid & 7, chn = hh * 64 + lg * 8;
    float ka[8], rk[8], kkw[8], m0r[8], m1r[8], m0k[8], m1k[8], m0v[8], m1v[8];
    u32x4 g_r, g_rp, g_rn, g_k, g_kp, g_kn, g_v, g_vp, g_vn;
    const int mtx = (C.wave >> 1) & 1, nb = C.wave & 1, r32 = lane & 31, hi = lane >> 5;
    bf16x8 Bf[4]; float lbias = 0.f;
    if (loader) {
        const float* Wm = (mtx ? a.in(I_WICLR) : a.in(I_WDEC)) + (size_t)(l * 2 + d) * 64 * 1024 + hh * 64 + nb * 32 + r32;
#pragma unroll
        for (int ks = 0; ks < 4; ++ks) { float t_[8];
#pragma unroll
            for (int j = 0; j < 8; ++j) t_[j] = Wm[(size_t)(ks * 16 + hi * 8 + j) * 1024];
            Bf[ks] = __builtin_bit_cast(bf16x8, pack8(t_)); }
        lbias = (mtx ? a.in(I_A0) : a.in(I_W0))[l * 2048 + d * 1024 + hh * 64 + nb * 32 + r32];
    }
    if (loader) {
        const float* mu0 = a.in(I_MU) + (size_t)l * 2 * RWIN; const float* mu1 = mu0 + RWIN;
#define LD8F(dst, p) do { const f32x4 x0_ = *(const f32x4*)(p), x1_ = *(const f32x4*)((p) + 4); _Pragma("unroll") for (int i = 0; i < 4; ++i) { dst[i] = x0_[i]; dst[4 + i] = x1_[i]; } } while (0)
        LD8F(ka, a.in(I_KA) + l * 1024 + chn); LD8F(rk, a.in(I_RK) + ((size_t)(l * 2 + d) * 16 + hh) * 64 + lg * 8); LD8F(kkw, a.in(I_KK) + l * 1024 + chn);
        LD8F(m0r, mu0 + chn); LD8F(m1r, mu1 + chn); LD8F(m0k, mu0 + 1024 + chn); LD8F(m1k, mu1 + 1024 + chn); LD8F(m0v, mu0 + 2048 + chn); LD8F(m1v, mu1 + 2048 + chn);
#undef LD8F
    }
#define SC_TOK(step) (d ? (SEQ - 1 - (step)) : (step))
#define SC_ISSUE(cn) do { const int tok_ = SC_TOK((cn) * SCAN_T + lj), row_ = sq * SEQ + tok_; const bf16* rp_ = PRW + (size_t)row_ * W_RW + chn; \
        const int op_ = tok_ > 0 ? -W_RW : 0, on_ = tok_ < SEQ - 1 ? W_RW : 0; \
        g_r = *(const u32x4*)rp_; g_rp = *(const u32x4*)(rp_ + op_); g_rn = *(const u32x4*)(rp_ + on_); g_k = *(const u32x4*)(rp_ + 1024); g_kp = *(const u32x4*)(rp_ + 1024 + op_); g_kn = *(const u32x4*)(rp_ + 1024 + on_); \
        g_v = *(const u32x4*)(rp_ + 2048); g_vp = *(const u32x4*)(rp_ + 2048 + op_); g_vn = *(const u32x4*)(rp_ + 2048 + on_); } while (0)
#define ST8(p, x) do { *(LAS f32x4*)(p) = (f32x4){x[0], x[1], x[2], x[3]}; *(LAS f32x4*)((p) + 4) = (f32x4){x[4], x[5], x[6], x[7]}; } while (0)
#define SC_MIX(dst, gc, gp, gn, m0, m1) do { float x_[8], xp_[8], xn_[8]; unpack8(gc, x_); unpack8(gp, xp_); unpack8(gn, xn_); \
        _Pragma("unroll") for (int i = 0; i < 8; ++i) dst[i] = x_[i] + m0[i] * (xp_[i] * zp_ - x_[i]) + m1[i] * (xn_[i] * zn_ - x_[i]); } while (0)
#define SC_WRITE(cn) do { float r_[8], k_[8], v_[8], kk_[8], w_[8], a_[8]; unpack8(*(const LAS u32x4*)(xs + (((cn) & 1) * 2 + 0) * 2048 + lj * 64 + lg * 8), w_); unpack8(*(const LAS u32x4*)(xs + (((cn) & 1) * 2 + 1) * 2048 + lj * 64 + lg * 8), a_); \
        { const int tok_ = SC_TOK((cn) * SCAN_T + lj); const float zp_ = tok_ > 0 ? 1.f : 0.f, zn_ = tok_ < SEQ - 1 ? 1.f : 0.f; \
          SC_MIX(r_, g_r, g_rp, g_rn, m0r, m1r); SC_MIX(k_, g_k, g_kp, g_kn, m0k, m1k); SC_MIX(v_, g_v, g_vp, g_vn, m0v, m1v); \
          float ss_ = 0.f; _Pragma("unroll") for (int i = 0; i < 8; ++i) { kk_[i] = k_[i] * kkw[i]; ss_ += kk_[i] * kk_[i]; } \
          ss_ = reduce8(ss_); const float inv_ = 1.f / fmaxf(sqrtf(ss_), 1e-12f); _Pragma("unroll") for (int i = 0; i < 8; ++i) kk_[i] *= inv_; } \
        LAS float* bp_ = buf + ((cn) & 1) * SCAN_BUF_F + lj * SCAN_STEP_F + lg * 8; float bs_ = 0.f; \
        float G_[8], kt_[8], at_[8], bt_[8], rt_[8]; \
        _Pragma("unroll") for (int i = 0; i < 8; ++i) { G_[i] = __builtin_amdgcn_exp2f(-0.8750387749f * w_[i]); const float kd_ = k_[i] * (1.f + (a_[i] - 1.f) * ka[i]); bs_ += r_[i] * kd_ * rk[i]; bt_[i] = kd_; at_[i] = kk_[i] * a_[i]; } \
        _Pragma("unroll") for (int off_ = 8; off_ < 64; off_ <<= 1) { _Pragma("unroll") for (int i = 0; i < 8; ++i) { const float y_ = __shfl_up(G_[i], off_); if (lane >= off_) G_[i] *= y_; } } \
        _Pragma("unroll") for (int i = 0; i < 8; ++i) { float gp_ = __shfl_up(G_[i], 8); if (lane < 8) gp_ = 1.f; const float rg_ = 1.f / G_[i]; kt_[i] = kk_[i] * gp_; at_[i] *= rg_; bt_[i] *= rg_; rt_[i] = r_[i] * G_[i]; } \
        ST8(bp_, G_); ST8(bp_ + 64, kt_); ST8(bp_ + 128, at_); ST8(bp_ + 192, bt_); ST8(bp_ + 256, rt_); ST8(bp_ + 320, v_); \
        bs_ = reduce8(bs_); if (lg == 0) { const int row_ = sq * SEQ + SC_TOK((cn) * SCAN_T + lj); bonus[((size_t)d * GROWS + row_) * 16 + hh] = bs_; } } while (0)
#define SC_LORA(cn) do { const bf16* ap_ = AL + (size_t)(sq * SEQ + SC_TOK((cn) * SCAN_T + r32)) * LORA_K + mtx * 128 + d * 64 + hi * 8; f32x16 acc_ = {}; \
        _Pragma("unroll") for (int ks = 0; ks < 4; ++ks) acc_ = __builtin_amdgcn_mfma_f32_32x32x16_bf16(*(const bf16x8*)(ap_ + ks * 16), Bf[ks], acc_, 0, 0, 0); \
        LAS bf16* xp_ = xs + (((cn) & 1) * 2 + mtx) * 2048 + nb * 32 + r32; \
        _Pragma("unroll") for (int r = 0; r < 16; ++r) xp_[att::crow(r, hi) * 64] = (bf16)(cvt_pk_bf16(sigmoidf_(acc_[r] + lbias), 0.f) & 0xffffu); } while (0)
#define SC_OUT(cn) do { const LAS float* op_ = obuf + ((cn) & 1) * (SCAN_T * 64) + lj * 64 + lg * 8; const f32x4 o0_ = *(const LAS f32x4*)op_, o1_ = *(const LAS f32x4*)(op_ + 4); \
        const int row_ = sq * SEQ + SC_TOK((cn) * SCAN_T + lj); u32x4 w_; w_.x = cvt_pk_bf16(o0_[0], o0_[1]); w_.y = cvt_pk_bf16(o0_[2], o0_[3]); w_.z = cvt_pk_bf16(o1_[0], o1_[1]); w_.w = cvt_pk_bf16(o1_[2], o1_[3]); \
        *(u32x4*)(OD + (size_t)row_ * 1024 + hh * 64 + lg * 8) = w_; } while (0)
    constexpr int NCH = SEQ / SCAN_T;
    const int rloc = (C.wave & 3) * 8 + (lane >> 3), cg = lane & 7;
    f32x2 s01 = {0.f, 0.f}, s23 = {0.f, 0.f}, s45 = {0.f, 0.f}, s67 = {0.f, 0.f};
    f32x2 t01 = {0.f, 0.f}, t23 = {0.f, 0.f}, t45 = {0.f, 0.f}, t67 = {0.f, 0.f};
    if (loader) SC_LORA(0);
    __syncthreads();
    if (loader) { SC_ISSUE(0); SC_WRITE(0); SC_LORA(1); }
    __syncthreads();
#pragma unroll 1
    for (int cn = 0; cn < NCH; ++cn) {
        if (loader) {
            if (cn + 1 < NCH) SC_ISSUE(cn + 1);
            if (cn + 2 < NCH) SC_LORA(cn + 2);
            if (cn > 0) SC_OUT(cn - 1);
            if (cn + 1 < NCH) SC_WRITE(cn + 1);
        } else {
            const unsigned ba = (unsigned)(uintptr_t)(buf + (cn & 1) * SCAN_BUF_F + cg * 8);
            const unsigned va = (unsigned)(uintptr_t)(buf + (cn & 1) * SCAN_BUF_F + 320 + rloc);
            LAS float* op = obuf + (cn & 1) * (SCAN_T * 64) + rloc;
#define DSR128(dst, addr, off) asm volatile("ds_read_b128 %0, %1 offset:%2" : "=v"(dst) : "v"(addr), "n"(off))
#define DSR32(dst, addr, off) asm volatile("ds_read_b32 %0, %1 offset:%2" : "=v"(dst) : "v"(addr), "n"(off))
#define SC_LDE(j) do { DSR128(Ek0, ba, (j) * 1536 + 256); DSR128(Ek1, ba, (j) * 1536 + 272); DSR128(Ed0, ba, (j) * 1536 + 768); DSR128(Ed1, ba, (j) * 1536 + 784); DSR32(Evv, va, (j) * 1536); DSR32(Evu, va, (j) * 1536 + 128); } while (0)
#define SC_LDL(j) do { DSR128(La0, ba, (j) * 1536 + 512); DSR128(La1, ba, (j) * 1536 + 528); DSR128(Lr0, ba, (j) * 1536 + 1024); DSR128(Lr1, ba, (j) * 1536 + 1040); \
        if ((((j) & 7) == 7)) { DSR128(Lg0, ba, (j) * 1536); DSR128(Lg1, ba, (j) * 1536 + 16); } } while (0)
#define LO2(v) __builtin_shufflevector(v, v, 0, 1)
#define HI2(v) __builtin_shufflevector(v, v, 2, 3)
#define SC_STEP(j) do { \
        if ((((j) & 7) == 7)) asm volatile("s_waitcnt lgkmcnt(6)" : "+v"(Ek0), "+v"(Ek1), "+v"(Ed0), "+v"(Ed1), "+v"(Evv), "+v"(Evu)); \
        else asm volatile("s_waitcnt lgkmcnt(4)" : "+v"(Ek0), "+v"(Ek1), "+v"(Ed0), "+v"(Ed1), "+v"(Evv), "+v"(Evu)); \
        if ((j) > 0) { const float q_ = reduce8(cqs_); const float qv_ = reduce8(cqt_); op[((j) - 1) * 64] = q_; op[((j) - 1) * 64 + 32] = qv_; }     \
        f32x2 pp_ = s01 * LO2(Ek0); f32x2 pu_ = t01 * LO2(Ek0); pp_ = s23 * HI2(Ek0) + pp_; pu_ = t23 * HI2(Ek0) + pu_; pp_ = s45 * LO2(Ek1) + pp_; pu_ = t45 * LO2(Ek1) + pu_; pp_ = s67 * HI2(Ek1) + pp_; pu_ = t67 * HI2(Ek1) + pu_; \
        float p_ = reduce8(pp_[0] + pp_[1]); float pq_ = reduce8(pu_[0] + pu_[1]); const f32x2 v2_ = {Evv, Evv}, u2_ = {Evu, Evu}; \
        s01 = v2_ * LO2(Ed0) + s01; s23 = v2_ * HI2(Ed0) + s23; s45 = v2_ * LO2(Ed1) + s45; s67 = v2_ * HI2(Ed1) + s67; \
        t01 = u2_ * LO2(Ed0) + t01; t23 = u2_ * HI2(Ed0) + t23; t45 = u2_ * LO2(Ed1) + t45; t67 = u2_ * HI2(Ed1) + t67; \
        asm volatile("" : "+v"(s01), "+v"(s23), "+v"(s45), "+v"(s67), "+v"(t01), "+v"(t23), "+v"(t45), "+v"(t67), "+v"(p_), "+v"(pq_));     \
        SC_LDE((j) + 1); \
        if ((((j) & 7) == 7)) asm volatile("s_waitcnt lgkmcnt(6)" : "+v"(La0), "+v"(La1), "+v"(Lr0), "+v"(Lr1), "+v"(Lg0), "+v"(Lg1)); \
        else asm volatile("s_waitcnt lgkmcnt(6)" : "+v"(La0), "+v"(La1), "+v"(Lr0), "+v"(Lr1)); \
        { const f32x2 p2_ = {p_, p_}, q2_ = {pq_, pq_}; \
        s01 = s01 - p2_ * LO2(La0); s23 = s23 - p2_ * HI2(La0); s45 = s45 - p2_ * LO2(La1); s67 = s67 - p2_ * HI2(La1); \
        t01 = t01 - q2_ * LO2(La0); t23 = t23 - q2_ * HI2(La0); t45 = t45 - q2_ * LO2(La1); t67 = t67 - q2_ * HI2(La1); } \
        f32x2 qq_ = s01 * LO2(Lr0); f32x2 qu_ = t01 * LO2(Lr0); qq_ = s23 * HI2(Lr0) + qq_; qu_ = t23 * HI2(Lr0) + qu_; qq_ = s45 * LO2(Lr1) + qq_; qu_ = t45 * LO2(Lr1) + qu_; qq_ = s67 * HI2(Lr1) + qq_; qu_ = t67 * HI2(Lr1) + qu_; \
        if ((((j) & 7) == 7)) { s01 *= LO2(Lg0); s23 *= HI2(Lg0); s45 *= LO2(Lg1); s67 *= HI2(Lg1); t01 *= LO2(Lg0); t23 *= HI2(Lg0); t45 *= LO2(Lg1); t67 *= HI2(Lg1); }     \
        asm volatile("" : "+v"(qq_), "+v"(qu_), "+v"(s01), "+v"(s23), "+v"(s45), "+v"(s67), "+v"(t01), "+v"(t23), "+v"(t45), "+v"(t67));     \
        SC_LDL((j) + 1); \
        cqs_ = qq_[0] + qq_[1]; cqt_ = qu_[0] + qu_[1]; } while (0)
            f32x4 Ek0, Ek1, Ed0, Ed1, La0, La1, Lr0, Lr1, Lg0, Lg1; float Evv, Evu; float cqs_ = 0.f, cqt_ = 0.f;
            SC_LDE(0); SC_LDL(0);
#pragma unroll
            for (int j = 0; j < SCAN_T; ++j) SC_STEP(j);
            { const float q_ = reduce8(cqs_); const float qv_ = reduce8(cqt_); op[(SCAN_T - 1) * 64] = q_; op[(SCAN_T - 1) * 64 + 32] = qv_; }
            asm volatile("s_waitcnt lgkmcnt(0)" : "+v"(Ek0), "+v"(Ek1), "+v"(Ed0), "+v"(Ed1), "+v"(Evv), "+v"(Evu), "+v"(La0), "+v"(La1), "+v"(Lr0), "+v"(Lr1), "+v"(Lg0), "+v"(Lg1));
#undef DSR128
#undef DSR32
#undef SC_LDE
#undef SC_LDL
#undef SC_STEP
#undef LO2
#undef HI2
        }
        __syncthreads();
    }
    if (loader) SC_OUT(NCH - 1);
    __syncthreads();
#undef SC_TOK
#undef SC_ISSUE
#undef SC_LORA
#undef SC_MIX
#undef SC_WRITE
#undef SC_OUT
#undef ST8
}

constexpr int NT_STEPS = 12;
constexpr int N_STEPS = 1 + NLAYER * (1 + NGRP * NT_STEPS) + 1;
#ifndef NL_BUILD
#define NL_BUILD NLAYER
#endif
#ifndef NG_BUILD
#define NG_BUILD NGRP
#endif

#define IN_STEP(k) (lo <= (sbase + (k)) && (sbase + (k)) < hi)
#define END_STEP(k) do { if (sbase + (k) + 1 < hi) { const PT pb_(C); XcdBarrier bar_; bar_.bar = (unsigned*)(pb_.ws() + WS_CTL) + CW_BAR; bar_.x = xb_xcc_id(); bar_.st = (volatile LAS unsigned*)(C.lds + MISC_OFF) + 8; xcd_barrier(bar_); } } while (0)
#define STEP_PTRS const PT a(C); unsigned char* const ws = a.ws(); (void)ws; \
    const float* const mod = (const float*)(ws + WS_MOD); bf16* const wb = (bf16*)(ws + WS_W); (void)wb; \
    const float* const xsrc = (L == 0) ? ((GI < 2) ? a.in(I_XP) + grow0 * DM : a.in(I_XS) + (grow0 - 32768) * DM) : a.out() + grow0 * DM; (void)xsrc; \
    float* const xout = a.out() + grow0 * DM; (void)xout; \
    const float* const modb = mod + ((size_t)L * 12 + GI * 4) * NMOD; (void)modb;

template <int L, int GI>
__device__ __forceinline__ void group_program(const Ctx& C, const int lo, const int hi) {
    constexpr int sbase = 1 + L * (1 + NGRP * NT_STEPS) + 1 + GI * NT_STEPS;
    constexpr size_t grow0 = (size_t)GI * GROWS;
    const int gdim = gridDim.x, bidx = blockIdx.x;
    if (EN(2) && IN_STEP(0)) { if constexpr (L == 0 && GI == 0) { REPEAT(2) { STEP_PTRS; phase_modnorm(C, C.gw, C.ngw, xsrc, (bf16*)(ws + A_H), a.in(I_NMIXG) + L * DM, modb, 0, 1); } END_STEP(0); } }
    if (EN(3) && IN_STEP(1)) { REPEAT(3) { STEP_PTRS;
        pg8::Gemm gm{(const bf16*)(ws + A_H), (const bf16*)((char*)wb + WO_IN), GROWS, NPROJ - 256, DM, DM, DM}; pg8::StaticOrder S; S.init(GROWS, NPROJ - 256, gdim, bidx);
        pg8::EpiG<FProj> E{FProj{(bf16*)(ws + A_PMLA), (bf16*)(ws + A_PRW), (bf16*)(ws + A_PGATE)}};
        pg8::gemm_phase<pg8::EpiG<FProj>, pg8::StaticOrder, PG8_ALIGN, PG8_SP2>(C.lds, gm, S, E); }
        END_STEP(1); }
    if (EN(4) && IN_STEP(2)) { REPEAT(4) { phase_prep(C, L); } END_STEP(2); }
    if (EN(5) && IN_STEP(3)) { REPEAT(5) {
        { STEP_PTRS; pg8::Gemm gm{(const bf16*)(ws + A_ALORA) + 256, (const bf16*)((char*)wb + WO_LORA) + (size_t)4096 * LORA_KB, GROWS, 1024, LORA_KB, LORA_K, LORA_KB}; pg8::StaticOrder S; S.init(GROWS, 1024, gdim, bidx);
          pg8::EpiG<FLora> E{FLora{(bf16*)(ws + A_LORAOUT), a.in(I_W0) + L * 2048, a.in(I_A0) + L * 2048, 4096}};
          pg8::gemm_phase<pg8::EpiG<FLora>, pg8::StaticOrder, PG8_ALIGN, PG8_SP2>(C.lds, gm, S, E); }
        { STEP_PTRS; pg8::Gemm gm{(const bf16*)(ws + A_PMLA), (const bf16*)((char*)wb + WO_UQ), GROWS, QW, 512, W_MLA, 512}; pg8::SkewOrder<2, 0, 2> S; S.init(GROWS, QW, gdim, bidx);
          pg8::EpiG<FQ> E{FQ{(bf16*)(ws + A_Q), (const float*)(ws + WS_RSTD), (const float*)(ws + WS_ROPE), (const float*)(ws + WS_ROPE) + SEQ * 32}};
          pg8::gemm_phase<pg8::EpiG<FQ>, pg8::SkewOrder<2, 0, 2>, PG8_ALIGN, PG8_SP2>(C.lds, gm, S, E); }
        { STEP_PTRS; pg8::Gemm gm{(const bf16*)(ws + A_PMLA) + 512, (const bf16*)((char*)wb + WO_UKV), GROWS, 2048, 256, W_MLA, 256}; pg8::SkewOrder<3, 0, 2> S; S.init(GROWS, 2048, gdim, bidx);
          pg8::EpiG<FKV> E{FKV{(bf16*)(ws + A_KF), (bf16*)(ws + A_V), (const float*)(ws + WS_RSTD) + GROWS}};
          pg8::gemm_phase<pg8::EpiG<FKV>, pg8::SkewOrder<3, 0, 2>, PG8_ALIGN, PG8_SP2>(C.lds, gm, S, E); }
        { STEP_PTRS; pg8::Gemm gm{(const bf16*)(ws + A_H), (const bf16*)((char*)wb + WO_IN) + (size_t)(NPROJ - 256) * DM, GROWS, 256, DM, DM, DM}; pg8::SkewOrder<0, 1, 0> S; S.init(GROWS, 256, gdim, bidx);
          pg8::EpiG<FStore> E{FStore{(bf16*)(ws + A_PGATE) + (W_GATE - 256), W_GATE}};
          pg8::gemm_phase<pg8::EpiG<FStore>, pg8::SkewOrder<0, 1, 0>, PG8_ALIGN, PG8_SP2>(C.lds, gm, S, E); } }
        END_STEP(3); }
    if (EN(6) && IN_STEP(4)) { { STEP_PTRS;
        const bool split = (gdim == 256);
        const int xcd = bidx & 7, bi = (bidx >> 3) & 15;
        for (int rp_ = 0; rp_ < (((PROBE_MASK >> 6) & 1) ? 2 : 1); ++rp_)
        for (int pr = bidx; pr < 128; pr += gdim) scan_chain(C, L, pr);
        const int r0 = 0, nr = split ? (bidx < 128 ? 0 : 4) : (512 - bidx + gdim - 1) / gdim;
        for (int k = 0; k < nr * (((PROBE_MASK >> 7) & 1) ? 2 : 1); ++k) {
            const int kk = k % (nr > 0 ? nr : 1);
            int pi, qb;
            if (split) { pi = xcd + 8 * (r0 + kk); qb = bi; } else { const int u = bidx + kk * gdim; pi = u >> 4; qb = u & 15; }
            const int hh = pi & 7, sq = pi >> 3;
            const bf16* Qb = (const bf16*)(ws + A_Q) + ((size_t)sq * SEQ + qb * 256) * QW + hh * 192;
            const bf16* Kh = (const bf16*)(ws + A_KF) + (size_t)sq * SEQ * KFW + hh * 192;
            const bf16* Vh = (const bf16*)(ws + A_V) + (size_t)sq * SEQ * VW + hh * 128;
            bf16* Ob = (bf16*)(ws + A_ATTO) + ((size_t)sq * SEQ + qb * 256) * 1024 + hh * 128;
            att::attn_unit(Qb, Kh, Vh, Ob, SEQ, (LAS char*)C.lds);
        }
        constexpr int NL_ = (GI == NGRP - 1) ? L + 1 : L, NG_ = (GI == NGRP - 1) ? 0 : GI + 1;
        if constexpr (NL_ < NLAYER) {
            constexpr size_t ngrow0 = (size_t)NG_ * GROWS;
            const float* nx = (NL_ == 0) ? ((NG_ < 2) ? a.in(I_XP) + ngrow0 * DM : a.in(I_XS) + (ngrow0 - 32768) * DM) : a.out() + ngrow0 * DM;
            const float* nmodb = mod + ((size_t)NL_ * 12 + NG_ * 4) * NMOD;
            if (split) { if (bidx >= 128) phase_modnorm(C, (bidx - 128) * NWAVES + C.wave, 128 * NWAVES, nx, (bf16*)(ws + A_H), a.in(I_NMIXG) + NL_ * DM, nmodb, 0, 1); }
            else phase_modnorm(C, C.gw, C.ngw, nx, (bf16*)(ws + A_H), a.in(I_NMIXG) + NL_ * DM, nmodb, 0, 1);
        }
        if constexpr (L == NLAYER - 1 && GI >= 1) {
            if (split) { if (bidx >= 128) phase_final(C, (bidx - 128) * NWAVES + C.wave, 128 * NWAVES, (GI - 1) * GROWS, GI * GROWS, a.out(), a.in(I_FNG)); }
            else phase_final(C, C.gw, C.ngw, (GI - 1) * GROWS, GI * GROWS, a.out(), a.in(I_FNG));
        } }
        END_STEP(4); }
    if (EN(7) && IN_STEP(5)) { REPEAT(15) { phase_rwkv_post(C, L); } END_STEP(5); }
    if (EN(8) && IN_STEP(6)) { REPEAT(8) {
        { STEP_PTRS; pg8::Gemm gm{(const bf16*)(ws + A_ATTO), (const bf16*)((char*)wb + WO_OATT), GROWS, DM, 1024, 1024, 1024}; pg8::StaticOrder S; S.init(GROWS, DM, gdim, bidx);
          pg8::EpiG<FMergeA> E{FMergeA{(bf16*)(ws + A_MERGED), (const bf16*)(ws + A_PGATE)}};
          pg8::gemm_phase<pg8::EpiG<FMergeA>, pg8::StaticOrder, PG8_ALIGN, PG8_SP2>(C.lds, gm, S, E); }
        VM_WAIT(); __syncthreads();
        { STEP_PTRS; pg8::Gemm gm{(const bf16*)(ws + A_RWKVO), (const bf16*)((char*)wb + WO_ORWKV), GROWS, DM, 1024, 1024, 1024}; pg8::StaticOrder S; S.init(GROWS, DM, gdim, bidx);
          pg8::EpiG<FMergeB> E{FMergeB{(bf16*)(ws + A_MERGED), (const bf16*)(ws + A_PGATE)}};
          pg8::gemm_phase<pg8::EpiG<FMergeB>, pg8::StaticOrder, PG8_ALIGN, PG8_SP2>(C.lds, gm, S, E); }
          VM_WAIT(); __syncthreads(); }
        END_STEP(6); }
    if (EN(9) && IN_STEP(7)) { _Pragma("unroll") for (int rep_ = 0; rep_ < ((((PROBE_MASK >> 9) & 1) && L == 0) ? 2 : 1); ++rep_) { STEP_PTRS;
        pg8::Gemm gm{(const bf16*)(ws + A_MERGED), (const bf16*)((char*)wb + WO_OUT), GROWS, DM, DM, DM, DM}; pg8::StaticOrder S; S.init(GROWS, DM, gdim, bidx);
        pg8::EpiG<FResid> E{FResid{xsrc, xout, modb + 2 * DM}};
        pg8::gemm_phase<pg8::EpiG<FResid>, pg8::StaticOrder, false, PG8_SP2>(C.lds, gm, S, E); }
        END_STEP(7); }
    if (EN(10) && IN_STEP(8)) { REPEAT(10) { STEP_PTRS; phase_modnorm(C, C.gw, C.ngw, xout, (bf16*)(ws + A_H2), a.in(I_NFFNG) + L * DM, modb, 3, 4); } END_STEP(8); }
    if (EN(11) && IN_STEP(9)) { { STEP_PTRS;
        pg8::Gemm gm{(const bf16*)(ws + A_H2), (const bf16*)((char*)wb + WO_UP), GROWS, 2 * DFF, DM, DM, DM}; pg8::StaticOrder S; S.init(GROWS, 2 * DFF, gdim, bidx);
        EpiAct E{(bf16*)(ws + A_ACT), (bf16*)(ws + A_EA), (bf16*)(ws + A_EB), a.in(I_CONVW) + (size_t)L * 3 * DFF, a.in(I_CONVB) + (size_t)L * DFF};
        pg8::gemm_phase<EpiAct, pg8::StaticOrder, PG8_ALIGN, PG8_SP2, true>(C.lds, gm, S, E); }
        END_STEP(9); }
    if (EN(12) && IN_STEP(10)) { phase_act_fix(C, L); END_STEP(10); }
    if (EN(13) && IN_STEP(11)) { { STEP_PTRS;
        pg8::Gemm gm{(const bf16*)(ws + A_ACT), (const bf16*)((char*)wb + WO_DOWN), GROWS, DM, DFF, DFF, DFF}; pg8::StaticOrder S; S.init(GROWS, DM, gdim, bidx);
        pg8::EpiG<FResid> E{FResid{xout, xout, modb + 5 * DM}};
        pg8::gemm_phase<pg8::EpiG<FResid>, pg8::StaticOrder, false, PG8_SP2>(C.lds, gm, S, E); }
        if constexpr (GI == NGRP - 1) END_STEP(11);
    }
}
template <int L>
__device__ __forceinline__ void layer_program(const Ctx& C, const int lo, const int hi) {
    constexpr int sbase = 1 + L * (1 + NGRP * NT_STEPS);
    if (EN(1) && IN_STEP(0)) { if constexpr (L > 0) { phase_convert(C, L); END_STEP(0); } }
    group_program<L, 0>(C, lo, hi);
    if constexpr (NG_BUILD > 1) group_program<L, 1>(C, lo, hi);
    if constexpr (NG_BUILD > 2) group_program<L, 2>(C, lo, hi);
}

__global__ void __launch_bounds__(NWAVES * 64, 2) mk_fwd(Args a) {
    extern __shared__ __attribute__((aligned(16))) unsigned char lds_raw[];
    Ctx C;
    C.lds = (LAS unsigned char*)lds_raw;
    C.tid = threadIdx.x; C.lane = C.tid & 63; C.wave = __builtin_amdgcn_readfirstlane(C.tid >> 6);
    C.gw = blockIdx.x * NWAVES + C.wave; C.ngw = gridDim.x * NWAVES;
    for (int u = C.tid; u < (LDS_BYTES - LDSCTL_OFF) / 4; u += NWAVES * 64) ((LAS unsigned*)(C.lds + LDSCTL_OFF))[u] = 0u;
    __syncthreads();
    if (C.tid == 0) {
        LAS unsigned long long* t = (LAS unsigned long long*)(C.lds + ARGTAB_OFF);
#pragma unroll
        for (int i = 0; i < 32; ++i) t[i] = (unsigned long long)a.in[i];
        t[32] = (unsigned long long)a.out; t[33] = (unsigned long long)a.ws;
    }
    __syncthreads();
    const int lo = a.lo, hi = a.hi;
    if (hi - lo > 1) (void)xcd_barrier_post((unsigned*)(a.ws + WS_CTL) + CW_BAR, (volatile LAS unsigned*)(C.lds + MISC_OFF) + 8);
    { constexpr int sbase = 0; if (EN(0) && IN_STEP(0)) { phase_mod(C); __syncthreads(); phase_convert(C, 0); END_STEP(0); } }
    layer_program<0>(C, lo, hi);
    if constexpr (NL_BUILD > 1) layer_program<1>(C, lo, hi);
    { constexpr int sbase = N_STEPS - 1; if (EN(14) && IN_STEP(0)) { const PT p(C); phase_final(C, C.gw, C.ngw, (NGRP - 1) * GROWS, MALL, p.out(), p.in(I_FNG)); } }
}
#undef IN_STEP
#undef END_STEP

extern "C" void kernel_launch(void* const* d_in, const int* in_sizes, int n_in, void* d_out, int out_size, void* d_ws, size_t ws_size, hipStream_t stream) {
    static int grid = 0;
    if (grid == 0) {
        if (n_in != 32 || out_size != MALL * DM || ws_size < WS_NEED) { fprintf(stderr, "kernel_launch: unexpected shapes: n_in %d out %d ws %zu (need %zu)\n", n_in, out_size, ws_size, (size_t)WS_NEED); grid = -1; return; }
        int dev = 0, cus = 0, per_cu = 0;
        if (hipGetDevice(&dev) != hipSuccess || hipDeviceGetAttribute(&cus, hipDeviceAttributeMultiprocessorCount, dev) != hipSuccess) { grid = -1; return; }
        if (hipFuncSetAttribute((const void*)mk_fwd, hipFuncAttributeMaxDynamicSharedMemorySize, LDS_BYTES) != hipSuccess) { fprintf(stderr, "kernel_launch: hipFuncSetAttribute failed\n"); grid = -1; return; }
        if (hipOccupancyMaxActiveBlocksPerMultiprocessor(&per_cu, (const void*)mk_fwd, NWAVES * 64, LDS_BYTES) != hipSuccess || per_cu < 1) fprintf(stderr, "kernel_launch: occupancy query reports %d\n", per_cu);
        (void)hipGetLastError();
        grid = cus;
    }
    if (grid < 0) return;
    if (hipMemsetAsync((char*)d_ws + WS_CTL, 0, CTL_ZERO_BYTES, stream) != hipSuccess) return;
    Args a{};
    for (int i = 0; i < 32; ++i) a.in[i] = (const float*)d_in[i];
    a.out = (float*)d_out; a.ws = (unsigned char*)d_ws;
#if MK_MODE == 1
    a.lo = 0; a.hi = N_STEPS;
    hipLaunchKernelGGL(mk_fwd, dim3(grid), dim3(NWAVES * 64), LDS_BYTES, stream, a);
#else
    for (int s = 0; s < N_STEPS; ++s) { a.lo = s; a.hi = s + 1; hipLaunchKernelGGL(mk_fwd, dim3(grid), dim3(NWAVES * 64), LDS_BYTES, stream, a); }
#endif
}
```

```cpp
#include <hip/hip_runtime.h>
#include <cstdio>
#include <cstdint>

#ifndef MK_MODE
#define MK_MODE 1
#endif

#ifndef ONLY
#define ONLY -1
#endif
#ifndef PROBE_MASK
#define PROBE_MASK 0
#endif
#define REPEAT(k) _Pragma("unroll") for (int rep_ = 0; rep_ < (((PROBE_MASK >> (k)) & 1) ? 2 : 1); ++rep_)
#define EN(k) (ONLY < 0 || ONLY == (k))
#define LAS __attribute__((address_space(3)))
#define GAS __attribute__((address_space(1)))
typedef unsigned short bf16;
typedef short bf16x8 __attribute__((ext_vector_type(8)));
typedef short s16x4 __attribute__((ext_vector_type(4)));
typedef float f32x4 __attribute__((ext_vector_type(4)));
typedef float f32x2 __attribute__((ext_vector_type(2)));
typedef float f32x16 __attribute__((ext_vector_type(16)));
typedef unsigned u32x4 __attribute__((ext_vector_type(4)));
typedef unsigned u32x2 __attribute__((ext_vector_type(2)));
typedef GAS unsigned gu32;

constexpr int DM = 2048, NSEQ = 12, SEQ = 4096, MALL = NSEQ * SEQ;
constexpr int NLAYER = 2;
constexpr int GROWS = 16384, NGRP = MALL / GROWS;
constexpr int DIN = 8416, W_MLA = 832, W_RW = 3520, W_GATE = 4096, NPROJ = W_MLA + W_RW + W_GATE;
constexpr int RWIN = 3488;
constexpr int DFF = 5632;
constexpr int NMOD = 6 * DM;
constexpr int QW = 1536, KFW = 1536, VW = 1024;
constexpr int LORA_K = 512, LORA_N = 5120, LORA_KB = 256;
constexpr int NWAVES = 8;

constexpr size_t MiB = 1u << 20;
constexpr size_t WS_CTL = 0, CTL_ZERO_BYTES = 3 * MiB;
constexpr size_t WS_MOD = 1 * MiB;
constexpr size_t WS_ROPE = 3 * MiB;
constexpr size_t WS_RSTD = 4 * MiB;
constexpr size_t WS_BONUS = 5 * MiB;
constexpr size_t WS_W = 8 * MiB;
constexpr size_t WO_IN = 0, WO_UQ = WO_IN + (size_t)NPROJ * DM * 2, WO_UKV = WO_UQ + (size_t)QW * 512 * 2, WO_OATT = WO_UKV + (size_t)2048 * 256 * 2,
                 WO_ORWKV = WO_OATT + (size_t)DM * 1024 * 2, WO_OUT = WO_ORWKV + (size_t)DM * 1024 * 2, WO_UP = WO_OUT + (size_t)DM * DM * 2,
                 WO_DOWN = WO_UP + (size_t)2 * DFF * DM * 2, WO_LORA = WO_DOWN + (size_t)DM * DFF * 2, WO_END = WO_LORA + (size_t)LORA_N * LORA_K * 2;
static_assert(WO_END <= 124 * MiB, "weights");
constexpr size_t WS_A = 132 * MiB;
constexpr size_t A_H = WS_A;
constexpr size_t A_PMLA = WS_A + 64 * MiB;
constexpr size_t A_PGATE = A_PMLA + 32 * MiB;
constexpr size_t A_PRW = A_PGATE + 128 * MiB;
constexpr size_t A_RKVKK = A_PRW + 112 * MiB;
constexpr size_t A_OF = A_RKVKK;
constexpr size_t A_OB = A_RKVKK + 32 * MiB;
constexpr size_t A_RWKVO = A_RKVKK + 64 * MiB;
constexpr size_t A_ALORA = A_RKVKK + 96 * MiB;
constexpr size_t A_MERGED = A_RKVKK;
constexpr size_t A_LORAOUT = A_RKVKK + 128 * MiB;
constexpr size_t A_Q = A_LORAOUT + 160 * MiB;
constexpr size_t A_KF = A_Q + 48 * MiB;
constexpr size_t A_V = A_KF + 48 * MiB;
constexpr size_t A_ATTO = A_V + 32 * MiB;
constexpr size_t A_TM_END = A_ATTO + 32 * MiB;
constexpr size_t A_MID = WS_A + 64 * MiB;
constexpr size_t A_EA = A_MID;
constexpr size_t A_EB = A_MID + 16 * MiB;
constexpr size_t A_ACT = A_MID + 352 * MiB;
constexpr size_t A_H2 = A_ACT + 176 * MiB;
constexpr size_t A_FF_END = A_H2 + 64 * MiB;
constexpr size_t WS_NEED = (A_TM_END > A_FF_END ? A_TM_END : A_FF_END);
static_assert(WS_NEED <= 1000 * MiB, "workspace map");

constexpr int CW_BAR = 4096;

constexpr int RING_BYTES = 131072, LDSCTL_OFF = RING_BYTES, MISC_OFF = LDSCTL_OFF + 320, LDS_BYTES = 147456;

#define LDS_WAIT() asm volatile("s_waitcnt lgkmcnt(0)" ::: "memory")
#define VM_WAIT() asm volatile("s_waitcnt vmcnt(0)" ::: "memory")
typedef __bf16 bf16x2_t __attribute__((ext_vector_type(2)));
__device__ __forceinline__ unsigned cvt_pk_bf16(float lo, float hi) { const f32x2 v = {lo, hi}; const bf16x2_t b = __builtin_convertvector(v, bf16x2_t); return __builtin_bit_cast(unsigned, b); }
__device__ __forceinline__ float bf_lo(unsigned w) { return __uint_as_float(w << 16); }
__device__ __forceinline__ float bf_hi(unsigned w) { return __uint_as_float(w & 0xffff0000u); }
__device__ __forceinline__ void unpack8(const u32x4 w, float (&f)[8]) { f[0] = bf_lo(w.x); f[1] = bf_hi(w.x); f[2] = bf_lo(w.y); f[3] = bf_hi(w.y); f[4] = bf_lo(w.z); f[5] = bf_hi(w.z); f[6] = bf_lo(w.w); f[7] = bf_hi(w.w); }
__device__ __forceinline__ void load8(const bf16* p, float (&f)[8]) { unpack8(*(const u32x4*)p, f); }
__device__ __forceinline__ u32x4 pack8(const float (&f)[8]) { u32x4 w; w.x = cvt_pk_bf16(f[0], f[1]); w.y = cvt_pk_bf16(f[2], f[3]); w.z = cvt_pk_bf16(f[4], f[5]); w.w = cvt_pk_bf16(f[6], f[7]); return w; }
__device__ __forceinline__ void store8(bf16* p, const float (&f)[8]) { *(u32x4*)p = pack8(f); }
__device__ __forceinline__ float sigmoidf_(float x) { return __builtin_amdgcn_rcpf(1.f + __expf(-x)); }
__device__ __forceinline__ float sigmoid_div(float x) { return 1.f / (1.f + __expf(-x)); }
__device__ __forceinline__ float wave_sum(float v) {
#pragma unroll
    for (int o = 1; o < 64; o <<= 1) v += __shfl_xor(v, o);
    return v;
}
__device__ __forceinline__ float reduce8(float x) {
    x += __builtin_bit_cast(float, __builtin_amdgcn_update_dpp(0, __builtin_bit_cast(int, x), 0xB1, 0xF, 0xF, true));
    x += __builtin_bit_cast(float, __builtin_amdgcn_update_dpp(0, __builtin_bit_cast(int, x), 0x4E, 0xF, 0xF, true));
    x += __builtin_bit_cast(float, __builtin_amdgcn_update_dpp(0, __builtin_bit_cast(int, x), 0x141, 0xF, 0xF, true));
    return x;
}

namespace pg8 {
constexpr int BM = 256, BK = 64, HALF = 128, HTB = HALF * BK * 2, STAGE_BYTES = 8 * HTB, NXCD = 8, WGM = 4;
__host__ __device__ __forceinline__ int lds_byte(int r, int c) { const int st = (r >> 4) * 2 + (c >> 5), rr = r & 15, cc = c & 31, ob = rr * 64 + cc * 2; return st * 1024 + (ob ^ (((ob >> 9) & 1) << 5)); }
__host__ __device__ __forceinline__ void stage_rc(int b, int& R, int& C) { const int st = b / 1024, sb = b % 1024, swz = sb ^ (((sb >> 9) & 1) << 5); R = (st >> 1) * 16 + swz / 64; C = (st & 1) * 32 + (swz % 64) / 2; }
__host__ __device__ __forceinline__ int perm32(int rho) { const int n = rho >> 4, i = rho & 15; return 8 * (i >> 2) + 4 * n + (i & 3); }
struct Unit { int pm, pn; };
struct Gemm { const bf16* A; const bf16* Bt; int M, N, K, lda, ldb; };
struct StaticOrder {
    int nM, nN, nwg, G, c;
    __host__ __device__ void init(int M, int N, int G_, int c_) { nM = M / BM; nN = N / BM; nwg = nM * nN; G = G_; c = c_; }
    __host__ __device__ bool next(int i, Unit& u) const {
        const long L = (long)i * G + c; if (L >= nwg) return false;
        int wgid = (int)L; { const int q = nwg / NXCD, r = nwg % NXCD, xcd = wgid % NXCD, off = wgid / NXCD; wgid = (xcd < r ? xcd * (q + 1) : r * (q + 1) + (xcd - r) * q) + off; }
        const int nig = WGM * nN, gid = wgid / nig, fm = gid * WGM, gsz = (nM - fm) < WGM ? (nM - fm) : WGM;
        u.pm = fm + ((wgid % nig) % gsz); u.pn = (wgid % nig) / gsz; return true;
    }
    __device__ __forceinline__ void a_ready(const Unit&) const {}
    __device__ __forceinline__ void done(const Unit&) const {}
};
template <int N0, int N1, int N2> struct SkewOrder {
    int nM, nN, nwg, G, c;
    __host__ __device__ void init(int M, int N, int G_, int c_) { nM = M / BM; nN = N / BM; nwg = nM * nN; G = G_; c = c_; }
    __host__ __device__ bool next(int i, Unit& u) const {
        long L;
        if (G == 256 && nwg == 128 * N0 + 64 * N1 + 64 * N2) {
            if (c < 128) { if (i >= N0) return false; L = i * 128 + c; }
            else if (c < 192) { if (i >= N1) return false; L = N0 * 128 + i * 64 + (c - 128); }
            else { if (i >= N2) return false; L = N0 * 128 + N1 * 64 + i * 64 + (c - 192); }
        } else { L = (long)i * G + c; if (L >= nwg) return false; }
        int wgid = (int)L; { const int q = nwg / NXCD, r = nwg % NXCD, xcd = wgid % NXCD, off = wgid / NXCD; wgid = (xcd < r ? xcd * (q + 1) : r * (q + 1) + (xcd - r) * q) + off; }
        const int nig = WGM * nN, gid = wgid / nig, fm = gid * WGM, gsz = (nM - fm) < WGM ? (nM - fm) : WGM;
        u.pm = fm + ((wgid % nig) % gsz); u.pn = (wgid % nig) / gsz; return true;
    }
    __device__ __forceinline__ void a_ready(const Unit&) const {}
    __device__ __forceinline__ void done(const Unit&) const {}
};
template <class F> struct EpiG {
    static constexpr bool PERM = true, AFTER_DRAIN = false;
    F f;
    __device__ __forceinline__ void operator()(const f32x4 (&acc)[2][2][4][2], const Unit& u, int wr, int wc, int fr, int fq) const {
        const int row0 = u.pm * BM + wr * 64 + fr, col0 = u.pn * BM + wc * 32 + 8 * fq;
#pragma unroll
        for (int ai = 0; ai < 2; ++ai)
#pragma unroll
            for (int m = 0; m < 4; ++m) {
                const int row = row0 + ai * HALF + m * 16;
#pragma unroll
                for (int bj = 0; bj < 2; ++bj) {
                    float v[8]; const f32x4 a0 = acc[ai][bj][m][0], a1 = acc[ai][bj][m][1];
                    v[0] = a0[0]; v[1] = a0[1]; v[2] = a0[2]; v[3] = a0[3]; v[4] = a1[0]; v[5] = a1[1]; v[6] = a1[2]; v[7] = a1[3];
                    f(row, col0 + bj * HALF, v);
                }
                asm volatile("" ::: "memory");
            }
    }
};

template <class Epi, class Sched, bool ALIGN_EPI = false, bool SP2 = false, bool PERMA = false>
__device__ __forceinline__ void gemm_phase(LAS unsigned char* lds, const Gemm g, const Sched& S, const Epi& E) {
    const int tid = threadIdx.x, wid = __builtin_amdgcn_readfirstlane(tid >> 6), lane = tid & 63, wr = wid >> 2, wc = wid & 3, fr = lane & 15, fq = lane >> 4;
    const int K = g.K, nt = K / BK;
    unsigned voffA[2], voffB[2];
#pragma unroll
    for (int i = 0; i < 2; ++i) { int R, C; stage_rc(tid * 16 + i * 8192, R, C); const int Rb = Epi::PERM ? ((R & ~31) + perm32(R & 31)) : R;
        const int Ra = PERMA ? ((R & 64) | ((R & 15) << 2) | ((R >> 4) & 3)) : R;
        voffA[i] = (unsigned)(Ra * g.lda + C) * 2u; voffB[i] = (unsigned)(Rb * g.ldb + C) * 2u; }
    const size_t kstep = (size_t)(BK * 2);
    const size_t hstepA = (size_t)HALF * g.lda * 2, hstepB = (size_t)HALF * g.ldb * 2;
    const size_t tstepA = 2 * hstepA, tstepB = 2 * hstepB;
    const unsigned ldsw = (unsigned)wid * 1024u;
    const int aoff = lds_byte(wr * 64 + fr, fq * 8), boff = lds_byte(wc * 32 + fr, fq * 8);
#define PG8_SA(b, h) (((b) * 2 + (h)) * HTB)
#define PG8_SB(b, h) ((4 + (b) * 2 + (h)) * HTB)
#define PG8_STAGE(bufoff, gbase, voff) do { _Pragma("unroll") for (int _i = 0; _i < 2; ++_i) \
        __builtin_amdgcn_global_load_lds((const unsigned*)((const char*)(gbase) + (voff)[_i]), (LAS unsigned*)(lds + (bufoff) + ldsw + _i * 8192), 16, 0, 0); } while (0)
#define PG8_LDA(dst, b, h) do { _Pragma("unroll") for (int m = 0; m < 4; ++m) _Pragma("unroll") for (int k = 0; k < 2; ++k) dst[m][k] = *(const LAS bf16x8*)(lds + PG8_SA(b, h) + aoff + m * 2048 + k * 1024); } while (0)
#define PG8_LDB(dst, b, h) do { _Pragma("unroll") for (int n = 0; n < 2; ++n) _Pragma("unroll") for (int k = 0; k < 2; ++k) dst[n][k] = *(const LAS bf16x8*)(lds + PG8_SB(b, h) + boff + n * 2048 + k * 1024); } while (0)
#define PG8_MMA(ai, bj, At, Bt) do { __builtin_amdgcn_s_setprio(1); _Pragma("unroll") for (int m = 0; m < 4; ++m) _Pragma("unroll") for (int n = 0; n < 2; ++n) _Pragma("unroll") for (int k = 0; k < 2; ++k) \
        acc[ai][bj][m][n] = __builtin_amdgcn_mfma_f32_16x16x32_bf16(Bt[n][k], At[m][k], acc[ai][bj][m][n], 0, 0, 0); __builtin_amdgcn_s_setprio(0); } while (0)
#define PG8_WAIT_V(n) asm volatile("s_waitcnt vmcnt(" #n ")" ::: "memory")
#define PG8_WAIT_L(n) asm volatile("s_waitcnt lgkmcnt(" #n ")" ::: "memory")
#define PG8_BAR __builtin_amdgcn_s_barrier()
#define PG8_SCHED __builtin_amdgcn_sched_barrier(0)
    Unit cur, nxt; int ui = 0;
    if (!S.next(0, cur)) return;
    f32x4 acc[2][2][4][2];
#pragma unroll
    for (int a = 0; a < 2; ++a)
#pragma unroll
        for (int b = 0; b < 2; ++b)
#pragma unroll
            for (int m = 0; m < 4; ++m)
#pragma unroll
                for (int n = 0; n < 2; ++n) acc[a][b][m][n] = (f32x4){0.f, 0.f, 0.f, 0.f};
    bf16x8 At[4][2], B0[2][2], B1[2][2];
    const char* cA = (const char*)g.A + (size_t)cur.pm * tstepA; const char* cB = (const char*)g.Bt + (size_t)cur.pn * tstepB;
    S.a_ready(cur);
    if constexpr (SP2) {
        PG8_STAGE(PG8_SB(0, 0), cB, voffB); PG8_STAGE(PG8_SB(0, 1), cB + hstepB, voffB); PG8_STAGE(PG8_SA(0, 0), cA, voffA); PG8_STAGE(PG8_SA(0, 1), cA + hstepA, voffA);
        if (wr == 1) PG8_BAR;
        PG8_WAIT_V(2); PG8_BAR;
        PG8_STAGE(PG8_SB(1, 0), cB + kstep, voffB); PG8_STAGE(PG8_SA(1, 0), cA + kstep, voffA); PG8_STAGE(PG8_SB(1, 1), cB + hstepB + kstep, voffB);
        PG8_WAIT_V(6); PG8_BAR;
    } else {
        PG8_STAGE(PG8_SB(0, 0), cB, voffB); PG8_STAGE(PG8_SA(0, 0), cA, voffA); PG8_STAGE(PG8_SB(0, 1), cB + hstepB, voffB); PG8_STAGE(PG8_SA(0, 1), cA + hstepA, voffA);
        if (wr == 1) PG8_BAR;
        PG8_WAIT_V(4); PG8_BAR;
        PG8_STAGE(PG8_SB(1, 0), cB + kstep, voffB); PG8_STAGE(PG8_SA(1, 0), cA + kstep, voffA); PG8_STAGE(PG8_SB(1, 1), cB + hstepB + kstep, voffB);
        PG8_WAIT_V(6); PG8_BAR;
    }
    for (;;) {
        const bool has_next = S.next(ui + 1, nxt);
        const char* nA = has_next ? (const char*)g.A + (size_t)nxt.pm * tstepA : cA; const char* nB = has_next ? (const char*)g.Bt + (size_t)nxt.pn * tstepB : cB;
#pragma unroll 1
        for (int t = 0; t < nt; t += 2) {
            const bool last = (t == nt - 2);
            const char* a1 = cA + (size_t)(t + 1) * kstep;
            const char* a2 = last ? nA : cA + (size_t)(t + 2) * kstep; const char* b2 = last ? nB : cB + (size_t)(t + 2) * kstep;
            const char* a3 = a2 + kstep; const char* b3 = b2 + kstep;
            if (last && has_next) S.a_ready(nxt);
            if constexpr (SP2) {
            PG8_LDB(B0, 0, 0); PG8_LDB(B1, 0, 1); PG8_SCHED; PG8_LDA(At, 0, 0); PG8_STAGE(PG8_SA(1, 1), a1 + hstepA, voffA);
            PG8_WAIT_V(8); PG8_WAIT_L(0); PG8_BAR; PG8_MMA(0, 0, At, B0); PG8_MMA(0, 1, At, B1); PG8_BAR; PG8_SCHED;
            PG8_LDA(At, 0, 1); PG8_STAGE(PG8_SB(0, 0), b2, voffB); PG8_STAGE(PG8_SB(0, 1), b2 + hstepB, voffB); PG8_STAGE(PG8_SA(0, 0), a2, voffA);
            PG8_WAIT_V(8); PG8_WAIT_L(0); PG8_BAR; PG8_MMA(1, 0, At, B0); PG8_MMA(1, 1, At, B1); PG8_BAR; PG8_SCHED;
            PG8_LDB(B0, 1, 0); PG8_LDB(B1, 1, 1); PG8_SCHED; PG8_LDA(At, 1, 0); PG8_STAGE(PG8_SA(0, 1), a2 + hstepA, voffA);
            PG8_WAIT_V(8); PG8_WAIT_L(0); PG8_BAR; PG8_MMA(0, 0, At, B0); PG8_MMA(0, 1, At, B1); PG8_BAR; PG8_SCHED;
            PG8_LDA(At, 1, 1); PG8_STAGE(PG8_SB(1, 0), b3, voffB); PG8_STAGE(PG8_SB(1, 1), b3 + hstepB, voffB); PG8_STAGE(PG8_SA(1, 0), a3, voffA);
            PG8_WAIT_V(8); PG8_WAIT_L(0); PG8_BAR; PG8_MMA(1, 0, At, B0); PG8_MMA(1, 1, At, B1); PG8_BAR; PG8_SCHED;
            } else {
            PG8_LDB(B0, 0, 0); PG8_SCHED; PG8_LDA(At, 0, 0); PG8_STAGE(PG8_SA(1, 1), a1 + hstepA, voffA);
            PG8_WAIT_L(8); PG8_BAR; PG8_WAIT_L(0); PG8_MMA(0, 0, At, B0); PG8_BAR; PG8_SCHED;
            PG8_LDB(B1, 0, 1); PG8_STAGE(PG8_SB(0, 0), b2, voffB);
            PG8_BAR; PG8_WAIT_L(0); PG8_MMA(0, 1, At, B1); PG8_BAR;
            PG8_LDA(At, 0, 1); PG8_STAGE(PG8_SA(0, 0), a2, voffA);
            PG8_BAR; PG8_WAIT_L(0); PG8_MMA(1, 0, At, B0); PG8_BAR; PG8_SCHED;
            PG8_STAGE(PG8_SB(0, 1), b2 + hstepB, voffB);
            PG8_WAIT_V(6); PG8_BAR; PG8_MMA(1, 1, At, B1); PG8_BAR;
            PG8_LDB(B0, 1, 0); PG8_SCHED; PG8_LDA(At, 1, 0); PG8_STAGE(PG8_SA(0, 1), a2 + hstepA, voffA);
            PG8_WAIT_L(8); PG8_BAR; PG8_WAIT_L(0); PG8_MMA(0, 0, At, B0); PG8_BAR; PG8_SCHED;
            PG8_LDB(B1, 1, 1); PG8_STAGE(PG8_SB(1, 0), b3, voffB);
            PG8_BAR; PG8_WAIT_L(0); PG8_MMA(0, 1, At, B1); PG8_BAR;
            PG8_LDA(At, 1, 1); PG8_STAGE(PG8_SA(1, 0), a3, voffA);
            PG8_BAR; PG8_WAIT_L(0); PG8_MMA(1, 0, At, B0); PG8_BAR; PG8_SCHED;
            PG8_STAGE(PG8_SB(1, 1), b3 + hstepB, voffB);
            PG8_WAIT_V(6); PG8_BAR; PG8_MMA(1, 1, At, B1); PG8_BAR;
            }
        }
        if constexpr (ALIGN_EPI) { if (wr == 0) PG8_BAR; }
        E(acc, cur, wr, wc, fr, fq); S.done(cur);
        if (!has_next) break;
#pragma unroll
        for (int a = 0; a < 2; ++a)
#pragma unroll
            for (int b = 0; b < 2; ++b)
#pragma unroll
                for (int m = 0; m < 4; ++m)
#pragma unroll
                    for (int n = 0; n < 2; ++n) acc[a][b][m][n] = (f32x4){0.f, 0.f, 0.f, 0.f};
        cur = nxt; cA = nA; cB = nB; ++ui;
        if constexpr (ALIGN_EPI) { if (wr == 1) PG8_BAR; }
    }
    PG8_WAIT_V(0);
    if constexpr (!ALIGN_EPI) { if (wr == 0) PG8_BAR; }
    PG8_BAR;
#undef PG8_SA
#undef PG8_SB
#undef PG8_STAGE
#undef PG8_LDA
#undef PG8_LDB
#undef PG8_MMA
#undef PG8_WAIT_V
#undef PG8_WAIT_L
#undef PG8_BAR
#undef PG8_SCHED
}
}
#define PG8_SP2 true
#define PG8_ALIGN true

struct FProj {
    bf16* mla; bf16* rw; bf16* gate;
    __device__ __forceinline__ void operator()(int row, int col, const float (&v)[8]) const {
        bf16* p;
        if (col < W_MLA) p = mla + (size_t)row * W_MLA + col;
        else if (col < W_MLA + W_RW) p = rw + (size_t)row * W_RW + (col - W_MLA);
        else p = gate + (size_t)row * W_GATE + (col - W_MLA - W_RW);
        store8(p, v);
    }
};
struct FStore {
    bf16* O; int ldc;
    __device__ __forceinline__ void operator()(int row, int col, const float (&v)[8]) const { store8(O + (size_t)row * ldc + col, v); }
};
struct FQ {
    bf16* Q; const float* rstd; const float* rc; const float* rs;
    __device__ __forceinline__ void operator()(int row, int col, const float (&v)[8]) const {
        const float s = rstd[row]; float o[8];
        const int c = col % 192;
        if (c >= 128) {
            const int j0 = ((c - 128) >> 3) * 4, pos = row & (SEQ - 1);
            const f32x4 cs = *(const f32x4*)(rc + pos * 32 + j0), sn = *(const f32x4*)(rs + pos * 32 + j0);
#pragma unroll
            for (int i = 0; i < 4; ++i) { const float x1 = v[i] * s, x2 = v[4 + i] * s; o[i] = x1 * cs[i] - x2 * sn[i]; o[4 + i] = x2 * cs[i] + x1 * sn[i]; }
        } else {
#pragma unroll
            for (int i = 0; i < 8; ++i) o[i] = v[i] * s;
        }
        store8(Q + (size_t)row * QW + col, o);
    }
};
struct FKV {
    bf16* KF; bf16* V; const float* rstd;
    __device__ __forceinline__ void operator()(int row, int col, const float (&v)[8]) const {
        const float s = rstd[row]; float o[8];
#pragma unroll
        for (int i = 0; i < 8; ++i) o[i] = v[i] * s;
        const int hh = col >> 8, w = col & 255;
        bf16* p = (w < 128) ? KF + (size_t)row * KFW + hh * 192 + w : V + (size_t)row * VW + hh * 128 + (w - 128);
        store8(p, o);
    }
};
struct FLora {
    bf16* O; const float* w0; const float* a0; int col0;
    __device__ __forceinline__ void operator()(int row, int colr, const float (&v)[8]) const {
        float o[8]; const int col = colr + col0;
        if (col < 4096) {
            const float* b = (col < 2048) ? w0 + col : a0 + (col - 2048);
            const f32x4 b0 = *(const f32x4*)b, b1 = *(const f32x4*)(b + 4);
#pragma unroll
            for (int i = 0; i < 4; ++i) { o[i] = sigmoidf_(v[i] + b0[i]); o[4 + i] = sigmoidf_(v[4 + i] + b1[i]); }
        } else {
#pragma unroll
            for (int i = 0; i < 8; ++i) o[i] = v[i];
        }
        store8(O + (size_t)row * LORA_N + col, o);
    }
};
struct FMergeA {
    bf16* MG; const bf16* gate;
    __device__ __forceinline__ void operator()(int row, int col, const float (&v)[8]) const {
        float gt[8], o[8]; load8(gate + (size_t)row * W_GATE + col, gt);
#pragma unroll
        for (int i = 0; i < 8; ++i) o[i] = sigmoidf_(gt[i]) * v[i];
        store8(MG + (size_t)row * DM + col, o);
    }
};
struct FMergeB {
    bf16* MG; const bf16* gate;
    __device__ __forceinline__ void operator()(int row, int col, const float (&v)[8]) const {
        float gt[8], o[8], m[8]; load8(gate + (size_t)row * W_GATE + DM + col, gt); load8(MG + (size_t)row * DM + col, m);
#pragma unroll
        for (int i = 0; i < 8; ++i) o[i] = m[i] + sigmoidf_(gt[i]) * v[i];
        store8(MG + (size_t)row * DM + col, o);
    }
};
struct FResid {
    const float* xin; float* out; const float* gt;
    __device__ __forceinline__ void operator()(int row, int col, const float (&v)[8]) const {
        const float* gp = gt + (size_t)(row >> 12) * NMOD + col;
        const f32x4 g0 = *(const f32x4*)gp, g1 = *(const f32x4*)(gp + 4);
        const float* xp = xin + (size_t)row * DM + col;
        const f32x4 x0 = *(const f32x4*)xp, x1 = *(const f32x4*)(xp + 4);
        f32x4 o0, o1;
#pragma unroll
        for (int i = 0; i < 4; ++i) { o0[i] = x0[i] + g0[i] * v[i]; o1[i] = x1[i] + g1[i] * v[4 + i]; }
        float* op = out + (size_t)row * DM + col;
        *(f32x4*)op = o0; *(f32x4*)(op + 4) = o1;
    }
};

__device__ __forceinline__ float dpp_shr1(float x) { return __builtin_bit_cast(float, __builtin_amdgcn_update_dpp(0, __builtin_bit_cast(int, x), 0x111, 0xF, 0xF, true)); }
__device__ __forceinline__ float dpp_shl1(float x) { return __builtin_bit_cast(float, __builtin_amdgcn_update_dpp(0, __builtin_bit_cast(int, x), 0x101, 0xF, 0xF, true)); }
struct EpiAct {
    static constexpr bool PERM = true, AFTER_DRAIN = false;
    bf16* ACT; bf16* EA; bf16* EB; const float* cw; const float* cb;
    __device__ __forceinline__ void operator()(const f32x4 (&acc)[2][2][4][2], const pg8::Unit& u, int wr, int wc, int fr, int fq) const {
        const int j0 = u.pn * 128 + wc * 32 + 8 * fq;
        float w0[8], w1[8], w2[8], bb[8];
#pragma unroll
        for (int h = 0; h < 2; ++h) { const f32x4 x0 = *(const f32x4*)(cw + j0 + 4 * h), x1 = *(const f32x4*)(cw + DFF + j0 + 4 * h), x2 = *(const f32x4*)(cw + 2 * DFF + j0 + 4 * h), x3 = *(const f32x4*)(cb + j0 + 4 * h);
#pragma unroll
            for (int i = 0; i < 4; ++i) { w0[4 * h + i] = x0[i]; w1[4 * h + i] = x1[i]; w2[4 * h + i] = x2[i]; bb[4 * h + i] = x3[i]; } }
#pragma unroll
        for (int ai = 0; ai < 2; ++ai) {
            float av[4][8], bv[4][8];
#pragma unroll
            for (int m = 0; m < 4; ++m)
#pragma unroll
                for (int i = 0; i < 4; ++i) { av[m][i] = acc[ai][0][m][0][i]; av[m][4 + i] = acc[ai][0][m][1][i]; bv[m][i] = acc[ai][1][m][0][i]; bv[m][4 + i] = acc[ai][1][m][1][i]; }
            float ap[8], an[8];
#pragma unroll
            for (int i = 0; i < 8; ++i) { ap[i] = dpp_shr1(av[3][i]); an[i] = dpp_shl1(av[0][i]); }
            const int blk = ai * 2 + wr; const size_t tok0 = (size_t)u.pm * 256 + blk * 64 + 4 * fr;
#pragma unroll
            for (int m = 0; m < 4; ++m) {
                float o[8];
#pragma unroll
                for (int i = 0; i < 8; ++i) { const float xm = (m == 0) ? ap[i] : av[m == 0 ? 0 : m - 1][i], xp = (m == 3) ? an[i] : av[m == 3 ? 3 : m + 1][i];
                    const float c = w0[i] * xm + w1[i] * av[m][i] + w2[i] * xp + bb[i]; o[i] = c * sigmoidf_(c) * bv[m][i]; }
                store8(ACT + (tok0 + m) * DFF + j0, o);
            }
            const size_t eb = ((size_t)u.pm * 4 + blk);
            if (fr == 0) { store8(EA + (eb * 4 + 0) * DFF + j0, av[0]); store8(EA + (eb * 4 + 1) * DFF + j0, av[1]); store8(EB + (eb * 2 + 0) * DFF + j0, bv[0]); }
            if (fr == 15) { store8(EA + (eb * 4 + 2) * DFF + j0, av[2]); store8(EA + (eb * 4 + 3) * DFF + j0, av[3]); store8(EB + (eb * 2 + 1) * DFF + j0, bv[3]); }
            asm volatile("" ::: "memory");
        }
    }
};

namespace att {
constexpr int DQK = 192, DV = 128, NW = 8, QBLK = 32, KVBLK = 64;
constexpr float SCALE = 0.07216878364870322f;
constexpr float THR = 8.f;
constexpr int LDQ = QW, LDK = KFW, LDV = VW, LDO = 1024;
constexpr int SHM_V = KVBLK * DV * 2, SHM_K = KVBLK * DQK * 2, SHM_ATTN = 2 * SHM_V + 2 * SHM_K + NW * 64 * 4;
#define KSWZ(row, colB) ((row) * 384 + ((colB) ^ (((row) & 7) << 4)))
#define SBAR() __builtin_amdgcn_sched_barrier(0)
__device__ __forceinline__ int crow(int r, int hi) { return (r & 3) + 8 * (r >> 2) + 4 * hi; }
__device__ __forceinline__ void partialSM(f32x16& p0, f32x16& p1, float& m_reg, float& mn, float& alpha) {
    constexpr float C = SCALE * 1.4426950408889634f;
    float pmax = p0[0];
#pragma unroll
    for (int r = 1; r < 16; ++r) pmax = fmaxf(pmax, p0[r]);
#pragma unroll
    for (int r = 0; r < 16; ++r) pmax = fmaxf(pmax, p1[r]);
    { auto rr = __builtin_amdgcn_permlane32_swap(__float_as_uint(pmax), __float_as_uint(pmax), false, false);
      pmax = fmaxf(__uint_as_float(rr[0]), __uint_as_float(rr[1])); }
    if (__builtin_expect(__all(pmax - m_reg <= THR / SCALE), 1)) { mn = m_reg; alpha = 1.f; }
    else { mn = fmaxf(m_reg, pmax); alpha = __builtin_amdgcn_exp2f((m_reg - mn) * C); m_reg = mn; }
    const float mnC = -mn * C;
#pragma unroll
    for (int r = 0; r < 16; ++r) p0[r] = fmaf(p0[r], C, mnC);
#pragma unroll
    for (int r = 0; r < 16; ++r) p1[r] = fmaf(p1[r], C, mnC);
#pragma unroll
    for (int r = 0; r < 16; ++r) p0[r] = __builtin_amdgcn_exp2f(p0[r]);
}
__device__ __forceinline__ void finishSM(f32x16& p0, f32x16& p1, float alpha, float& l_reg, bf16x8& pa0, bf16x8& pa1, bf16x8& pa2, bf16x8& pa3) {
#pragma unroll
    for (int r = 0; r < 16; ++r) p1[r] = __builtin_amdgcn_exp2f(p1[r]);
    float ps = 0;
#pragma unroll
    for (int r = 0; r < 16; ++r) ps += p0[r];
#pragma unroll
    for (int r = 0; r < 16; ++r) ps += p1[r];
    { auto rr = __builtin_amdgcn_permlane32_swap(__float_as_uint(ps), __float_as_uint(ps), false, false);
      ps = __uint_as_float(rr[0]) + __uint_as_float(rr[1]); }
    l_reg = l_reg * alpha + ps;
#define PK4(P, BASE, OUT) do { unsigned a0 = cvt_pk_bf16(P[BASE + 0], P[BASE + 1]), a1 = cvt_pk_bf16(P[BASE + 2], P[BASE + 3]);   \
    unsigned b0 = cvt_pk_bf16(P[BASE + 4], P[BASE + 5]), b1 = cvt_pk_bf16(P[BASE + 6], P[BASE + 7]);                              \
    auto r0 = __builtin_amdgcn_permlane32_swap(a0, b0, false, false); auto r1 = __builtin_amdgcn_permlane32_swap(a1, b1, false, false); \
    u32x4 w = {r0[0], r1[0], r0[1], r1[1]}; OUT = __builtin_bit_cast(bf16x8, w); } while (0)
    PK4(p0, 0, pa0); PK4(p0, 8, pa1); PK4(p1, 0, pa2); PK4(p1, 8, pa3);
#undef PK4
}
__device__ __forceinline__ void qkt(f32x16& p0, f32x16& p1, const LAS char* Ks, const bf16x8* qr, int r32, int hi) {
    p0 = f32x16{}; p1 = f32x16{};
#pragma unroll
    for (int d0 = 0; d0 < 12; ++d0) { const int cb = (d0 * 16 + hi * 8) * 2;
        const bf16x8 b0 = *(const LAS bf16x8*)(Ks + KSWZ(r32, cb));
        const bf16x8 b1 = *(const LAS bf16x8*)(Ks + KSWZ(32 + r32, cb));
        p0 = __builtin_amdgcn_mfma_f32_32x32x16_bf16(b0, qr[d0], p0, 0, 0, 0);
        p1 = __builtin_amdgcn_mfma_f32_32x32x16_bf16(b1, qr[d0], p1, 0, 0, 0); }
}
__device__ __forceinline__ int v_st(int k, int c) { const int kk = (k & ~0xC) | ((k & 4) << 1) | ((k & 8) >> 1); return ((kk >> 3) * 4 + (c >> 5)) * 512 + ((kk & 7) * 32 + (c & 31)) * 2; }
__device__ __forceinline__ int v_rd_base(int lane) { return ((lane & 3) << 3) | (((lane >> 2) & 3) << 6) | (((lane >> 4) & 1) << 5) | (((lane >> 5) & 1) << 8); }
constexpr int v_rd_off(int d0, int ks, int half) { return d0 * 512 + ks * 4096 + half * 2048; }
template <int OFF> __device__ __forceinline__ s16x4 tr_read(int vb) {
    s16x4 r; asm volatile("ds_read_b64_tr_b16 %0, %1 offset:%2" : "=&v"(r) : "v"(vb), "i"(OFF) : "memory"); return r;
}
template <int D0> __device__ __forceinline__ void pv_one(f32x16& od, int vb, bf16x8 pa0, bf16x8 pa1, bf16x8 pa2, bf16x8 pa3) {
    const s16x4 l0 = tr_read<v_rd_off(D0, 0, 0)>(vb), h0 = tr_read<v_rd_off(D0, 0, 1)>(vb), l1 = tr_read<v_rd_off(D0, 1, 0)>(vb), h1 = tr_read<v_rd_off(D0, 1, 1)>(vb);
    const s16x4 l2 = tr_read<v_rd_off(D0, 2, 0)>(vb), h2 = tr_read<v_rd_off(D0, 2, 1)>(vb), l3 = tr_read<v_rd_off(D0, 3, 0)>(vb), h3 = tr_read<v_rd_off(D0, 3, 1)>(vb);
    asm volatile("s_waitcnt lgkmcnt(0)" ::: "memory"); SBAR();
#define PK(L, H) (bf16x8){L[0], L[1], L[2], L[3], H[0], H[1], H[2], H[3]}
    od = __builtin_amdgcn_mfma_f32_32x32x16_bf16(pa0, PK(l0, h0), od, 0, 0, 0);
    od = __builtin_amdgcn_mfma_f32_32x32x16_bf16(pa1, PK(l1, h1), od, 0, 0, 0);
    od = __builtin_amdgcn_mfma_f32_32x32x16_bf16(pa2, PK(l2, h2), od, 0, 0, 0);
    od = __builtin_amdgcn_mfma_f32_32x32x16_bf16(pa3, PK(l3, h3), od, 0, 0, 0);
#undef PK
}
__device__ __forceinline__ void pv_d0(f32x16* o, int vb, bf16x8 pa0, bf16x8 pa1, bf16x8 pa2, bf16x8 pa3) {
    pv_one<0>(o[0], vb, pa0, pa1, pa2, pa3); pv_one<1>(o[1], vb, pa0, pa1, pa2, pa3); pv_one<2>(o[2], vb, pa0, pa1, pa2, pa3); pv_one<3>(o[3], vb, pa0, pa1, pa2, pa3);
}
__device__ __forceinline__ void attn_unit(const bf16* __restrict__ Qb, const bf16* __restrict__ Kh, const bf16* __restrict__ Vh, bf16* __restrict__ Ob, int seq, LAS char* lds) {
    const int tid = threadIdx.x, wid = tid >> 6, lane = tid & 63, r32 = lane & 31, hi = lane >> 5;
    LAS char* V_lds = lds; LAS char* K_lds = lds + 2 * SHM_V;
    LAS float* ws = (LAS float*)(lds + 2 * SHM_V + 2 * SHM_K) + wid * 64; LAS float* li_l = ws; LAS float* al_l = ws + 32;
    float m_reg = -1e30f, l_reg = 0; f32x16 o[4] = {}; bf16x8 qr[12];
    const bf16* Qw = Qb + (long)(wid * QBLK + r32) * LDQ + hi * 8;
#pragma unroll
    for (int d0 = 0; d0 < 12; ++d0) qr[d0] = *(const bf16x8*)(Qw + d0 * 16);
    const int sr = tid >> 4, sc = (tid & 15) * 8, vst0 = v_st(sr, sc), vst1 = v_st(32 + sr, sc);
    const int krow0 = tid >> 3, kch0 = tid & 7;
    const int vb0 = (int)(unsigned)(uintptr_t)V_lds + v_rd_base(lane);
    bf16x8 vs0, vs1, ks0, ks1, ks2;
#define SLOAD(k0) do { vs0 = *(const bf16x8*)(&Vh[(long)((k0) + sr) * LDV + sc]); vs1 = *(const bf16x8*)(&Vh[(long)((k0) + 32 + sr) * LDV + sc]); \
    { const bf16* kp_ = &Kh[(long)((k0) + krow0) * LDK + kch0 * 8]; ks0 = *(const bf16x8*)kp_; ks1 = *(const bf16x8*)(kp_ + 64); ks2 = *(const bf16x8*)(kp_ + 128); } } while (0)
#define SWRITE(b) do { *(LAS bf16x8*)(V_lds + (b) * SHM_V + vst0) = vs0; *(LAS bf16x8*)(V_lds + (b) * SHM_V + vst1) = vs1; \
    *(LAS bf16x8*)(K_lds + (b) * SHM_K + KSWZ(krow0, kch0 * 16)) = ks0; *(LAS bf16x8*)(K_lds + (b) * SHM_K + KSWZ(krow0, (kch0 + 8) * 16)) = ks1; \
    *(LAS bf16x8*)(K_lds + (b) * SHM_K + KSWZ(krow0, (kch0 + 16) * 16)) = ks2; } while (0)
#define RESC(a) do { if (__any((a) < 1.f)) { if (hi == 0) al_l[r32] = (a); asm volatile("s_waitcnt lgkmcnt(0)" ::: "memory"); \
    _Pragma("unroll") for (int d = 0; d < 4; ++d) _Pragma("unroll") for (int r = 0; r < 16; ++r) o[d][r] *= al_l[crow(r, hi)]; } } while (0)
    f32x16 p0, p1; float mn, al; bf16x8 pa0, pa1, pa2, pa3; const int NT = seq / KVBLK;
    SLOAD(0); VM_WAIT(); SWRITE(0); __syncthreads();
    for (int j = 0; j < NT; ++j) {
        const int b = j & 1;
        if (j + 1 < NT) SLOAD((j + 1) * KVBLK);
        SBAR(); qkt(p0, p1, K_lds + b * SHM_K, qr, r32, hi);
        partialSM(p0, p1, m_reg, mn, al);
        finishSM(p0, p1, al, l_reg, pa0, pa1, pa2, pa3); SBAR();
        RESC(al);
        pv_d0(o, vb0 + b * SHM_V, pa0, pa1, pa2, pa3);
        if (j + 1 < NT) { VM_WAIT(); SWRITE(b ^ 1); }
        __syncthreads();
    }
    if (hi == 0) li_l[r32] = l_reg; asm volatile("s_waitcnt lgkmcnt(0)" ::: "memory");
    float rli[16];
#pragma unroll
    for (int r = 0; r < 16; ++r) rli[r] = __builtin_amdgcn_rcpf(li_l[crow(r, hi)]);
    LAS char* ost = lds + wid * (QBLK * 272);
#pragma unroll
    for (int r = 0; r < 16; ++r) { const int orow = crow(r, hi);
#pragma unroll
        for (int d0 = 0; d0 < 4; ++d0) *(LAS bf16*)(ost + orow * 272 + (d0 * 32 + r32) * 2) = (bf16)(cvt_pk_bf16(o[d0][r] * rli[r], 0.f) & 0xffffu); }
    asm volatile("s_waitcnt lgkmcnt(0)" ::: "memory");
    bf16* Ow = Ob + (long)(wid * QBLK) * LDO;
#pragma unroll
    for (int i = 0; i < 8; ++i) { const int id = lane + 64 * i, orow = id >> 4, ch = id & 15;
        *(u32x4*)(Ow + (long)orow * LDO + ch * 8) = *(const LAS u32x4*)(ost + orow * 272 + ch * 16); }
    __syncthreads();
#undef SLOAD
#undef SWRITE
#undef RESC
}
}

#define XB_TMO      128
#define XB_XCNT(j)  (256  + 64 * (j))
#define XB_XSUB(j)  (1280 + 64 * (j))
#define XB_XGEN(j)  (2304 + 64 * (j))
#define XB_TOP      3328
#define XB_TOPGEN   3392
#define XCD_BAR_WORDS 3456
#define XB_SPIN_CAP (1u << 22)
__device__ __forceinline__ unsigned xb_ld(unsigned* p)              { return __hip_atomic_load(p, __ATOMIC_RELAXED, __HIP_MEMORY_SCOPE_AGENT); }
__device__ __forceinline__ unsigned xb_add(unsigned* p, unsigned v) { return __hip_atomic_fetch_add(p, v, __ATOMIC_RELAXED, __HIP_MEMORY_SCOPE_AGENT); }
__device__ __forceinline__ unsigned xb_xcc_id() { return (unsigned)__builtin_amdgcn_s_getreg((3 << 11) | 20) & 0xFu; }
#define XB_SPIN(cond, bar) do { unsigned _sp = 0; while (cond) { __builtin_amdgcn_s_sleep(1); \
    if ((++_sp & 255u) == 0u) { if (xb_ld(&(bar)[XB_TMO])) break; if (_sp > XB_SPIN_CAP) { atomicAdd(&(bar)[XB_TMO], 1u); break; } } } } while (0)
struct XcdBarrier { unsigned* bar; unsigned x; volatile LAS unsigned* st; };
__device__ __forceinline__ XcdBarrier xcd_barrier_post(unsigned* bar, volatile LAS unsigned* st) {
    XcdBarrier b; b.bar = bar; b.x = xb_xcc_id(); b.st = st;
    if (threadIdx.x == 0) (void)xb_add(&bar[XB_XCNT(b.x)], 1u);
    return b;
}
__device__ __forceinline__ void xcd_barrier_complete(unsigned* bar, unsigned x, unsigned& nloc, unsigned& nx) {
    const unsigned G = gridDim.x * gridDim.y * gridDim.z;
    unsigned sum, cnt, mine, sp = 0u;
    for (;;) {
        sum = 0u; cnt = 0u; mine = 0u;
#pragma unroll
        for (unsigned j = 0; j < 16; ++j) { const unsigned c = xb_ld(&bar[XB_XCNT(j)]); sum += c; cnt += (c > 0u) ? 1u : 0u; mine = (j == x) ? c : mine; }
        if (sum == G) break;
        __builtin_amdgcn_s_sleep(1);
        if ((++sp & 255u) == 0u) { if (xb_ld(&bar[XB_TMO])) break; if (sp > XB_SPIN_CAP) { atomicAdd(&bar[XB_TMO], 1u); break; } }
    }
    nloc = mine > 0u ? mine : 1u; nx = cnt > 0u ? cnt : 1u;
}
__device__ __forceinline__ void xcd_barrier(const XcdBarrier& b) {
    asm volatile("s_waitcnt vmcnt(0)" ::: "memory");
    __syncthreads();
    if (threadIdx.x == 0) {
        unsigned* bar = b.bar;
        __builtin_amdgcn_s_waitcnt(0);
        unsigned nloc = b.st[0], nx = b.st[1];
        if (nloc == 0u) { xcd_barrier_complete(bar, b.x, nloc, nx); b.st[0] = nloc; b.st[1] = nx; }
        const unsigned old = xb_add(&bar[XB_XSUB(b.x)], 1u);
        const unsigned gen = old / nloc;
        if (old + 1u == (gen + 1u) * nloc) {
            __builtin_amdgcn_fence(__ATOMIC_RELEASE, "agent");
            asm volatile("s_waitcnt vmcnt(0)" ::: "memory");
            const unsigned og = xb_add(&bar[XB_TOP], 1u);
            const unsigned tg = og / nx;
            if (og + 1u == (tg + 1u) * nx) xb_add(&bar[XB_TOPGEN], 1u);
            else XB_SPIN(xb_ld(&bar[XB_TOPGEN]) == tg, bar);
            __builtin_amdgcn_fence(__ATOMIC_ACQUIRE, "agent");
            xb_add(&bar[XB_XGEN(b.x)], 1u);
            asm volatile("s_waitcnt vmcnt(0)" ::: "memory");
        } else {
            XB_SPIN(xb_ld(&bar[XB_XGEN(b.x)]) == gen, bar);
            __builtin_amdgcn_fence(__ATOMIC_ACQUIRE, "agent");
            asm volatile("s_waitcnt vmcnt(0)" ::: "memory");
        }
    }
    __syncthreads();
}

struct Args {
    const float* in[32];
    float* out; unsigned char* ws;
    int lo, hi, pad0, pad1;
};
enum { I_XP = 0, I_XS, I_CP, I_CS, I_ADAW, I_ADAB, I_NMIXG, I_WIN, I_QNG, I_WUQ, I_KVNG, I_WUKV, I_WOATT, I_MU, I_W0, I_WDEC, I_A0, I_WICLR, I_WGATE,
       I_KK, I_KA, I_RK, I_GNG, I_GNB, I_WORWKV, I_WOUT, I_NFFNG, I_WUP, I_CONVW, I_CONVB, I_WDOWN, I_FNG };

constexpr int ARGTAB_OFF = MISC_OFF + 256;
struct Ctx { LAS unsigned char* lds; int tid, lane, wave, gw, ngw; };
struct PT {
    LAS unsigned char* lds; int toff;
    __device__ __forceinline__ explicit PT(const Ctx& C) { lds = C.lds; int t = ARGTAB_OFF; asm volatile("" : "+s"(t)); toff = t; }
    __device__ __forceinline__ unsigned long long raw(int i) const { const LAS unsigned* p = (const LAS unsigned*)(lds + toff) + 2 * i;
        const unsigned lo = __builtin_amdgcn_readfirstlane(p[0]), hi = __builtin_amdgcn_readfirstlane(p[1]); return ((unsigned long long)hi << 32) | lo; }
    __device__ __forceinline__ const float* in(int i) const { return (const float*)raw(i); }
    __device__ __forceinline__ float* out() const { return (float*)raw(32); }
    __device__ __forceinline__ unsigned char* ws() const { return (unsigned char*)raw(33); }
};

__device__ __forceinline__ void phase_mod(const Ctx& C) {
    const PT a(C);
    float* mod = (float*)(a.ws() + WS_MOD);
    LAS float* sil = (LAS float*)C.lds;
    for (int u = blockIdx.x; u < 192; u += gridDim.x) {
        const int cu = u % 96, kh = u / 96, l = cu / 48, n0 = (cu % 48) * 256;
        for (int i = C.tid; i < 1024 * 12; i += 512) { const int kk = i / 12, s = i % 12;
            const float c = (s < 8) ? a.in(I_CP)[s * DM + kh * 1024 + kk] : a.in(I_CS)[(s - 8) * DM + kh * 1024 + kk];
            sil[i] = c / (1.f + __expf(-c)); }
        __syncthreads();
        f32x4 acc[12];
#pragma unroll
        for (int s = 0; s < 12; ++s) acc[s] = (f32x4){0.f, 0.f, 0.f, 0.f};
        const int kb = C.wave * 128;
        const float* wp = a.in(I_ADAW) + ((size_t)l * DM + kh * 1024 + kb) * NMOD + n0 + C.lane * 4;
        for (int kk = 0; kk < 128; kk += 4) {
            f32x4 wv[4];
#pragma unroll
            for (int i = 0; i < 4; ++i) wv[i] = *(const f32x4*)(wp + (size_t)(kk + i) * NMOD);
#pragma unroll
            for (int i = 0; i < 4; ++i) {
                const LAS f32x4* sp = (const LAS f32x4*)(sil + (kb + kk + i) * 12);
                const f32x4 s0 = sp[0], s1 = sp[1], s2 = sp[2];
                acc[0] += wv[i] * s0[0]; acc[1] += wv[i] * s0[1]; acc[2] += wv[i] * s0[2]; acc[3] += wv[i] * s0[3];
                acc[4] += wv[i] * s1[0]; acc[5] += wv[i] * s1[1]; acc[6] += wv[i] * s1[2]; acc[7] += wv[i] * s1[3];
                acc[8] += wv[i] * s2[0]; acc[9] += wv[i] * s2[1]; acc[10] += wv[i] * s2[2]; acc[11] += wv[i] * s2[3];
            }
        }
        __syncthreads();
        LAS f32x4* part = (LAS f32x4*)C.lds;
#pragma unroll
        for (int s = 0; s < 12; ++s) part[(C.wave * 12 + s) * 64 + C.lane] = acc[s];
        __syncthreads();
        for (int i = C.tid; i < 12 * 64; i += 512) {
            f32x4 t = part[i];
#pragma unroll
            for (int w = 1; w < 8; ++w) t += part[w * 12 * 64 + i];
            const int s_ = i >> 6, ln = i & 63;
            if (kh == 0) t += *(const f32x4*)(a.in(I_ADAB) + (size_t)l * NMOD + n0 + ln * 4);
            float* mp = mod + ((size_t)l * 12 + s_) * NMOD + n0 + ln * 4;
#pragma unroll
            for (int j = 0; j < 4; ++j) __hip_atomic_fetch_add(mp + j, t[j], __ATOMIC_RELAXED, __HIP_MEMORY_SCOPE_AGENT);
        }
        __syncthreads();
    }
    float* rc = (float*)(a.ws() + WS_ROPE); float* rs = rc + SEQ * 32;
    for (int i = blockIdx.x * 512 + C.tid; i < SEQ * 32; i += gridDim.x * 512) {
        const int pos = i >> 5, j = i & 31;
        const double inv = 1.0 / pow(10000.0, (double)j / 32.0), ang = (double)pos * inv;
        rc[i] = (float)cos(ang); rs[i] = (float)sin(ang);
    }
}

constexpr f32x4 ZERO4 = {0.f, 0.f, 0.f, 0.f};
template <class Get> __device__ __forceinline__ void tr_tile(const Get& get, bf16* WT, int ldt, int n0, int k0, LAS float* T, int tid) {
    const int n4 = (tid & 63) * 4, kq = tid >> 6;
    f32x4 v[8];
#pragma unroll
    for (int i = 0; i < 8; ++i) v[i] = get.get4(n0 + n4, k0 + kq + 8 * i);
#pragma unroll
    for (int i = 0; i < 8; ++i) *(LAS f32x4*)(T + (kq + 8 * i) * 260 + n4) = v[i];
    __syncthreads();
    const int n = tid >> 1, kh = (tid & 1) * 32;
#pragma unroll
    for (int j = 0; j < 4; ++j) { const LAS float* t = T + (kh + 8 * j) * 260 + n;
        u32x4 o; o.x = cvt_pk_bf16(t[0], t[260]); o.y = cvt_pk_bf16(t[2 * 260], t[3 * 260]); o.z = cvt_pk_bf16(t[4 * 260], t[5 * 260]); o.w = cvt_pk_bf16(t[6 * 260], t[7 * 260]);
        *(u32x4*)(WT + (size_t)(n0 + n) * ldt + k0 + kh + 8 * j) = o; }
    __syncthreads();
}
struct GetPlain { const float* W; int ldw; __device__ __forceinline__ f32x4 get4(int n, int k) const { return *(const f32x4*)(W + (size_t)k * ldw + n); } };
struct GetWin { const float* W; __device__ __forceinline__ f32x4 get4(int n, int k) const {
    int s;
    if (n < 832) s = n; else if (n < W_MLA) s = -1; else if (n < W_MLA + RWIN) s = 832 + (n - W_MLA); else if (n < W_MLA + W_RW) s = -1; else s = 4320 + (n - W_MLA - W_RW);
    return s < 0 ? ZERO4 : *(const f32x4*)(W + (size_t)k * DIN + s); } };
struct GetUq { const float* W; const float* g; __device__ __forceinline__ f32x4 get4(int n, int k) const {
    const int hh = n / 192, c = n % 192; int s;
    if (c < 128) s = hh * 192 + c; else { const int p = c - 128, grp = p >> 3, w = p & 7; s = hh * 192 + 128 + (w >> 2) * 32 + grp * 4; }
    return *(const f32x4*)(W + (size_t)k * QW + s) * g[k]; } };
struct GetUp { const float* W; __device__ __forceinline__ f32x4 get4(int n, int k) const {
    const int t = n >> 8, w = n & 255; const int sc = (w < 128) ? t * 128 + w : DFF + t * 128 + (w - 128); return *(const f32x4*)(W + (size_t)k * (2 * DFF) + sc); } };
struct GetUkv { const float* W; const float* g; __device__ __forceinline__ f32x4 get4(int n, int k) const { return *(const f32x4*)(W + (size_t)k * 2048 + n) * g[k]; } };
struct GetLora { const float* wdec; const float* wiclr; const float* wgate;
    __device__ __forceinline__ f32x4 get4(int n, int k) const {
        if (n < 2048) { const int d = n >> 10, c = n & 1023, kk = k - d * 64; return (kk >= 0 && kk < 64) ? *(const f32x4*)(wdec + ((size_t)d * 64 + kk) * 1024 + c) : ZERO4; }
        if (n < 4096) { const int d = (n - 2048) >> 10, c = n & 1023, kk = k - 128 - d * 64; return (kk >= 0 && kk < 64) ? *(const f32x4*)(wiclr + ((size_t)d * 64 + kk) * 1024 + c) : ZERO4; }
        const int c = n - 4096; return (k < 160) ? *(const f32x4*)(wgate + (size_t)k * 1024 + c) : ZERO4; } };

__device__ __forceinline__ void phase_convert(const Ctx& C, int l) {
    const PT a(C);
    LAS float* T = (LAS float*)C.lds;
    bf16* wb = (bf16*)(a.ws() + WS_W);
    constexpr int I0 = (NPROJ / 256) * (DM / 64), I1 = (QW / 256) * (512 / 64), I2 = (2048 / 256) * (256 / 64), I3 = (DM / 256) * (1024 / 64), I4 = I3,
                  I5 = (DM / 256) * (DM / 64), I6 = (2 * DFF / 256) * (DM / 64), I7 = (DM / 256) * (DFF / 64), I8 = (LORA_N / 256) * (LORA_KB / 64);
    constexpr int NIT = I0 + I1 + I2 + I3 + I4 + I5 + I6 + I7 + I8;
    for (int it = blockIdx.x; it < NIT; it += gridDim.x) {
        int r = it;
#define ITEM(CNT, GET, OFF, KD) if (r < (CNT)) { const int nblk_k = (KD) / 64; const int nb = r / nblk_k, kb = r % nblk_k; tr_tile(GET, (bf16*)((char*)wb + (OFF)), (KD), nb * 256, kb * 64, T, C.tid); continue; } r -= (CNT);
        ITEM(I0, (GetWin{a.in(I_WIN) + (size_t)l * DM * DIN}), WO_IN, DM)
        ITEM(I1, (GetUq{a.in(I_WUQ) + (size_t)l * 512 * QW, a.in(I_QNG) + l * 512}), WO_UQ, 512)
        ITEM(I2, (GetUkv{a.in(I_WUKV) + (size_t)l * 256 * 2048, a.in(I_KVNG) + l * 256}), WO_UKV, 256)
        ITEM(I3, (GetPlain{a.in(I_WOATT) + (size_t)l * 1024 * DM, DM}), WO_OATT, 1024)
        ITEM(I4, (GetPlain{a.in(I_WORWKV) + (size_t)l * 1024 * DM, DM}), WO_ORWKV, 1024)
        ITEM(I5, (GetPlain{a.in(I_WOUT) + (size_t)l * DM * DM, DM}), WO_OUT, DM)
        ITEM(I6, (GetUp{a.in(I_WUP) + (size_t)l * DM * 2 * DFF}), WO_UP, DM)
        ITEM(I7, (GetPlain{a.in(I_WDOWN) + (size_t)l * DFF * DM, DM}), WO_DOWN, DFF)
        ITEM(I8, (GetLora{a.in(I_WDEC) + (size_t)l * 2 * 64 * 1024, a.in(I_WICLR) + (size_t)l * 2 * 64 * 1024, a.in(I_WGATE) + (size_t)l * 160 * 1024}), WO_LORA, LORA_KB)
#undef ITEM
    }
}

__device__ __forceinline__ void phase_modnorm(const Ctx& C, int gw, int ngw, const float* xsrc, bf16* H, const float* g, const float* modb, int ksh, int ksc) {
    const int per = GROWS / ngw, r0 = gw * per;
    const float* mb = modb + (size_t)(r0 >> 12) * NMOD;
    f32x4 gm[8], sh[8];
#pragma unroll
    for (int j = 0; j < 8; ++j) { const int c = 256 * j + 4 * C.lane; const f32x4 gg = *(const f32x4*)(g + c), sc = *(const f32x4*)(mb + ksc * DM + c); sh[j] = *(const f32x4*)(mb + ksh * DM + c);
#pragma unroll
        for (int i = 0; i < 4; ++i) gm[j][i] = gg[i] * (1.f + sc[i]); }
    for (int row = r0; row < r0 + per; row += 2) {
        f32x4 v[2][8];
#pragma unroll
        for (int k = 0; k < 2; ++k)
#pragma unroll
            for (int j = 0; j < 8; ++j) v[k][j] = *(const f32x4*)(xsrc + (size_t)(row + k) * DM + 256 * j + 4 * C.lane);
#pragma unroll
        for (int k = 0; k < 2; ++k) {
            float ss = 0.f;
#pragma unroll
            for (int j = 0; j < 8; ++j) ss += (v[k][j][0] * v[k][j][0] + v[k][j][1] * v[k][j][1]) + (v[k][j][2] * v[k][j][2] + v[k][j][3] * v[k][j][3]);
            const float rstd = rsqrtf(wave_sum(ss) * (1.f / DM) + 1e-6f);
#pragma unroll
            for (int j = 0; j < 8; ++j) { const int c = 256 * j + 4 * C.lane;
                f32x4 y;
#pragma unroll
                for (int i = 0; i < 4; ++i) y[i] = v[k][j][i] * rstd * gm[j][i] + sh[j][i];
                u32x2 w; w.x = cvt_pk_bf16(y[0], y[1]); w.y = cvt_pk_bf16(y[2], y[3]);
                *(u32x2*)(H + (size_t)(row + k) * DM + c) = w; }
        }
    }
}
__device__ __forceinline__ void phase_final(const Ctx& C, int gw, int ngw, int row_lo, int row_hi, float* out, const float* g) {
    f32x4 gv[8];
#pragma unroll
    for (int j = 0; j < 8; ++j) gv[j] = *(const f32x4*)(g + 256 * j + 4 * C.lane);
#pragma unroll 2
    for (int row = row_lo + gw; row < row_hi; row += ngw) {
        float* xr = out + (size_t)row * DM;
        f32x4 v[8]; float ss = 0.f;
#pragma unroll
        for (int j = 0; j < 8; ++j) { v[j] = *(const f32x4*)(xr + 256 * j + 4 * C.lane); ss += (v[j][0] * v[j][0] + v[j][1] * v[j][1]) + (v[j][2] * v[j][2] + v[j][3] * v[j][3]); }
        const float rstd = rsqrtf(wave_sum(ss) * (1.f / DM) + 1e-6f);
#pragma unroll
        for (int j = 0; j < 8; ++j) { const int c = 256 * j + 4 * C.lane;
            f32x4 y;
#pragma unroll
            for (int i = 0; i < 4; ++i) y[i] = v[j][i] * rstd * gv[j][i];
            *(f32x4*)(xr + c) = y; }
    }
}
__device__ __forceinline__ void phase_prep(const Ctx& C, int l) {
    const PT a(C);
    const bf16* PRW = (const bf16*)(a.ws() + A_PRW); const bf16* PMLA = (const bf16*)(a.ws() + A_PMLA);
    bf16* AL = (bf16*)(a.ws() + A_ALORA); bf16* KF = (bf16*)(a.ws() + A_KF);
    float* rstd_q = (float*)(a.ws() + WS_RSTD); float* rstd_kv = rstd_q + GROWS;
    const float* rc = (const float*)(a.ws() + WS_ROPE); const float* rs = rc + SEQ * 32;
    const float* mu0 = a.in(I_MU) + (size_t)l * 2 * RWIN; const float* mu1 = mu0 + RWIN;
    const int lane = C.lane;
    constexpr int RB = 8, NU = GROWS / RB;
    for (int u = C.gw; u < NU; u += C.ngw) {
        const int r0 = u * RB, t0 = r0 & (SEQ - 1), c0 = (384 + lane) * 8;
        const bool act = lane < 52;
        float m0[8], m1[8];
#pragma unroll
        for (int i = 0; i < 8; ++i) { m0[i] = 0.f; m1[i] = 0.f; }
        if (act) {
#pragma unroll
            for (int h = 0; h < 2; ++h) { const f32x4 x0 = *(const f32x4*)(mu0 + c0 + 4 * h), x1 = *(const f32x4*)(mu1 + c0 + 4 * h);
#pragma unroll
                for (int i = 0; i < 4; ++i) { m0[4 * h + i] = x0[i]; m1[4 * h + i] = x1[i]; } }
        }
        const bf16* xr = PRW + (size_t)r0 * W_RW + c0;
        u32x4 rwn[RB + 2];
        rwn[0] = (u32x4){0u, 0u, 0u, 0u}; rwn[RB + 1] = (u32x4){0u, 0u, 0u, 0u};
        if (t0 > 0) rwn[0] = *(const u32x4*)(xr - W_RW);
#pragma unroll
        for (int r = 0; r < RB; ++r) rwn[r + 1] = *(const u32x4*)(xr + (size_t)r * W_RW);
        if (t0 + RB < SEQ) rwn[RB + 1] = *(const u32x4*)(xr + (size_t)RB * W_RW);
#pragma unroll
        for (int r = 0; r < RB; ++r) {
            const int row = r0 + r;
            float xp[8], x[8], xn[8], p[8], o[8];
            unpack8(rwn[r], xp); unpack8(rwn[r + 1], x); unpack8(rwn[r + 2], xn);
#pragma unroll
            for (int i = 0; i < 8; ++i) p[i] = x[i] + m0[i] * (xp[i] - x[i]) + m1[i] * (xn[i] - x[i]);
            if (lane < 16) {
#pragma unroll
                for (int i = 0; i < 8; ++i) o[i] = tanhf(p[i]);
                store8(AL + (size_t)row * LORA_K + lane * 8, o);
            } else if (lane < 32) { store8(AL + (size_t)row * LORA_K + 128 + (lane - 16) * 8, p); }
            else if (lane < 52) {
#pragma unroll
                for (int i = 0; i < 8; ++i) o[i] = sigmoidf_(p[i]);
                store8(AL + (size_t)row * LORA_K + 256 + (lane - 32) * 8, o);
            } else {
#pragma unroll
                for (int i = 0; i < 8; ++i) o[i] = 0.f;
                store8(AL + (size_t)row * LORA_K + 416 + (lane - 52) * 8, o);
            }
        }
    }
    for (int row0 = C.gw * 4; row0 < GROWS; row0 += C.ngw * 4) {
        u32x4 qv[4], kv4[4]; u32x2 w1[4], w2[4];
#pragma unroll
        for (int j = 0; j < 4; ++j) { const bf16* mr = PMLA + (size_t)(row0 + j) * W_MLA;
            qv[j] = *(const u32x4*)(mr + lane * 8); kv4[j] = *(const u32x4*)(mr + 512 + (lane & 31) * 8);
            w1[j] = *(const u32x2*)(mr + 768 + 4 * (lane & 7)); w2[j] = *(const u32x2*)(mr + 800 + 4 * (lane & 7)); }
#pragma unroll
        for (int j = 0; j < 4; ++j) {
            const int row = row0 + j, t = row & (SEQ - 1);
            { float q[8]; unpack8(qv[j], q); float ss = 0.f;
#pragma unroll
              for (int i = 0; i < 8; ++i) ss += q[i] * q[i];
              ss = wave_sum(ss); if (lane == 0) rstd_q[row] = rsqrtf(ss * (1.f / 512.f) + 1e-6f); }
            { float q[8]; unpack8(kv4[j], q); float ss = 0.f;
#pragma unroll
              for (int i = 0; i < 8; ++i) ss += q[i] * q[i];
              ss = wave_sum(lane < 32 ? ss : 0.f); if (lane == 0) rstd_kv[row] = rsqrtf(ss * (1.f / 256.f) + 1e-6f); }
            if (lane < 8) {
                const float x1[4] = {bf_lo(w1[j].x), bf_hi(w1[j].x), bf_lo(w1[j].y), bf_hi(w1[j].y)}, x2[4] = {bf_lo(w2[j].x), bf_hi(w2[j].x), bf_lo(w2[j].y), bf_hi(w2[j].y)};
                const f32x4 cs = *(const f32x4*)(rc + t * 32 + 4 * lane), sn = *(const f32x4*)(rs + t * 32 + 4 * lane);
                float o[8];
#pragma unroll
                for (int i = 0; i < 4; ++i) { o[i] = x1[i] * cs[i] - x2[i] * sn[i]; o[4 + i] = x2[i] * cs[i] + x1[i] * sn[i]; }
                const u32x4 pk = pack8(o);
#pragma unroll
                for (int hh = 0; hh < 8; ++hh) *(u32x4*)(KF + (size_t)row * KFW + hh * 192 + 128 + 8 * lane) = pk;
            }
        }
    }
}
__device__ __forceinline__ void phase_rwkv_post(const Ctx& C, int l) {
    const PT a(C);
    const bf16* OF = (const bf16*)(a.ws() + A_OF); const bf16* OB = (const bf16*)(a.ws() + A_OB); const bf16* PRW = (const bf16*)(a.ws() + A_PRW);
    const float* mu0 = a.in(I_MU) + (size_t)l * 2 * RWIN + 2048; const float* mu1 = mu0 + RWIN;
    const bf16* LO = (const bf16*)(a.ws() + A_LORAOUT); bf16* RO = (bf16*)(a.ws() + A_RWKVO);
    const float* bonus = (const float*)(a.ws() + WS_BONUS);
    const float* gng = a.in(I_GNG) + l * 1024; const float* gnb = a.in(I_GNB) + l * 1024;
    const int lane = C.lane;
    f32x4 maK[2], mbK[2], naK[2], nbK[2], g0K[2], g1K[2], b0K[2], b1K[2];
#pragma unroll
    for (int it = 0; it < 2; ++it) { const int c0 = (it * 64 + lane) * 8;
        maK[it] = *(const f32x4*)(mu0 + c0); mbK[it] = *(const f32x4*)(mu0 + c0 + 4); naK[it] = *(const f32x4*)(mu1 + c0); nbK[it] = *(const f32x4*)(mu1 + c0 + 4);
        g0K[it] = *(const f32x4*)(gng + c0); g1K[it] = *(const f32x4*)(gng + c0 + 4); b0K[it] = *(const f32x4*)(gnb + c0); b1K[it] = *(const f32x4*)(gnb + c0 + 4); }
    for (int row = C.gw; row < GROWS; row += C.ngw) {
        const int t = row & (SEQ - 1);
        u32x4 ofv[2], obv[2], xv[2], xpv[2], xnv[2], ggv[2]; float bnv[2];
#pragma unroll
        for (int it = 0; it < 2; ++it) {
            const int c0 = (it * 64 + lane) * 8, hh = c0 >> 6; const bf16* vr = PRW + (size_t)row * W_RW + 2048 + c0;
            ofv[it] = *(const u32x4*)(OF + (size_t)row * 1024 + c0); obv[it] = *(const u32x4*)(OB + (size_t)row * 1024 + c0);
            xv[it] = *(const u32x4*)vr; xpv[it] = *(const u32x4*)(t > 0 ? vr - W_RW : vr); xnv[it] = *(const u32x4*)(t < SEQ - 1 ? vr + W_RW : vr);
            ggv[it] = *(const u32x4*)(LO + (size_t)row * LORA_N + 4096 + c0);
            bnv[it] = bonus[(size_t)row * 16 + hh] + bonus[(size_t)(GROWS + row) * 16 + hh]; }
#pragma unroll
        for (int it = 0; it < 2; ++it) {
            const int c0 = (it * 64 + lane) * 8;
            float of[8], ob[8], o[8], vv[8], gg[8];
            unpack8(ofv[it], of); unpack8(obv[it], ob);
            { float x[8], xp[8], xn[8]; unpack8(xv[it], x); unpack8(xpv[it], xp); unpack8(xnv[it], xn);
              const f32x4 ma = maK[it], mb = mbK[it], na = naK[it], nb = nbK[it];
              const float zp = t > 0 ? 1.f : 0.f, zn = t < SEQ - 1 ? 1.f : 0.f;
#pragma unroll
              for (int i = 0; i < 4; ++i) { vv[i] = x[i] + ma[i] * (xp[i] * zp - x[i]) + na[i] * (xn[i] * zn - x[i]); vv[4 + i] = x[4 + i] + mb[i] * (xp[4 + i] * zp - x[4 + i]) + nb[i] * (xn[4 + i] * zn - x[4 + i]); } }
            unpack8(ggv[it], gg);
            float s = 0.f;
#pragma unroll
            for (int i = 0; i < 8; ++i) { o[i] = of[i] + ob[i]; s += o[i]; }
            const float mean = reduce8(s) * (1.f / 64.f);
            float q = 0.f;
#pragma unroll
            for (int i = 0; i < 8; ++i) { o[i] -= mean; q += o[i] * o[i]; }
            const float rstd = rsqrtf(reduce8(q) * (1.f / 64.f) + 64e-5f);
            const float bn = bnv[it];
            const f32x4 g0 = g0K[it], g1 = g1K[it], b0 = b0K[it], b1 = b1K[it];
            float y[8];
#pragma unroll
            for (int i = 0; i < 4; ++i) { y[i] = (o[i] * rstd * g0[i] + b0[i] + bn * vv[i]) * gg[i]; y[4 + i] = (o[4 + i] * rstd * g1[i] + b1[i] + bn * vv[4 + i]) * gg[4 + i]; }
            store8(RO + (size_t)row * 1024 + c0, y);
        }
    }
}
__device__ __forceinline__ void phase_act_fix(const Ctx& C, int l) {
    const PT a(C);
    const bf16* EA = (const bf16*)(a.ws() + A_EA); const bf16* EB = (const bf16*)(a.ws() + A_EB); bf16* ACT = (bf16*)(a.ws() + A_ACT);
    const float* cw = a.in(I_CONVW) + (size_t)l * 3 * DFF; const float* cb = a.in(I_CONVB) + (size_t)l * DFF;
    constexpr int NT = GROWS / 256, NR = NT * 8;
    for (int u = C.gw; u < NR; u += C.ngw) {
        const int tile = u >> 3, blk = (u >> 1) & 3, e = u & 1;
        const size_t eb = (size_t)tile * 4 + blk, tok = (size_t)tile * 256 + blk * 64 + (e ? 63 : 0);
        const bf16* ac = EA + (eb * 4 + (e ? 3 : 0)) * DFF; const bf16* bc = EB + (eb * 2 + e) * DFF;
        const bf16* apv; const bf16* anx; float zp = 1.f, zn = 1.f;
        if (e == 0) { anx = EA + (eb * 4 + 1) * DFF;
            if (blk > 0) apv = EA + ((eb - 1) * 4 + 3) * DFF; else if ((tile & 15) != 0) apv = EA + ((eb - 1) * 4 + 3) * DFF; else { apv = ac; zp = 0.f; } }
        else { apv = EA + (eb * 4 + 2) * DFF;
            if (blk < 3) anx = EA + ((eb + 1) * 4 + 0) * DFF; else if ((tile & 15) != 15) anx = EA + ((eb + 1) * 4 + 0) * DFF; else { anx = ac; zn = 0.f; } }
#pragma unroll 1
        for (int it = 0; it < 11; ++it) {
            const int c0 = (it * 64 + C.lane) * 8;
            float x[8], xp[8], xn[8], b[8], o[8];
            load8(ac + c0, x); load8(apv + c0, xp); load8(anx + c0, xn); load8(bc + c0, b);
#pragma unroll
            for (int h = 0; h < 2; ++h) {
                const f32x4 w0 = *(const f32x4*)(cw + c0 + 4 * h), w1 = *(const f32x4*)(cw + DFF + c0 + 4 * h), w2 = *(const f32x4*)(cw + 2 * DFF + c0 + 4 * h), bb = *(const f32x4*)(cb + c0 + 4 * h);
#pragma unroll
                for (int i = 0; i < 4; ++i) { const int j = 4 * h + i; const float cc = xp[j] * zp * w0[i] + x[j] * w1[i] + xn[j] * zn * w2[i] + bb[i]; o[j] = cc * sigmoidf_(cc) * b[j]; }
            }
            store8(ACT + tok * DFF + c0, o);
        }
    }
}

constexpr int SCAN_T = 32, SCAN_STEP_F = 384, SCAN_BUF_F = SCAN_T * SCAN_STEP_F;
static_assert((2 * SCAN_BUF_F + 2 * SCAN_T * 64) * 4 + 2 * 2 * SCAN_T * 64 * 2 <= RING_BYTES, "scan LDS");
__device__ __forceinline__ void scan_chain(const Ctx& C, int l, int ch) {
    const PT a(C);
    const bf16* PRW = (const bf16*)(a.ws() + A_PRW); const bf16* AL = (const bf16*)(a.ws() + A_ALORA);
    float* bonus = (float*)(a.ws() + WS_BONUS);
    LAS float* buf = (LAS float*)C.lds;
    LAS float* obuf = buf + 2 * SCAN_BUF_F;
    LAS bf16* xs = (LAS bf16*)(obuf + 2 * SCAN_T * 64);
    const int tid = C.tid, lane = C.lane;
    const int d = ch & 1, hh = (ch >> 1) & 15, sq = ch >> 5;
    bf16* OD = (bf16*)(a.ws() + (d ? A_OB : A_OF));
    const bool loader = tid >= 256;
    const int lid = tid - 256, lj = lid >> 3, lg = lid & 7, chn = hh * 64 + lg * 8;
    float ka[8], rk[8], kkw[8], m0r[8], m1r[8], m0k[8], m1k[8], m0v[8], m1v[8];
    u32x4 g_r, g_rp, g_rn, g_k, g_kp, g_kn, g_v, g_vp, g_vn;
    const int mtx = (C.wave >> 1) & 1, nb = C.wave & 1, r32 = lane & 31, hi = lane >> 5;
    bf16x8 Bf[4]; float lbias = 0.f;
    if (loader) {
        const float* Wm = (mtx ? a.in(I_WICLR) : a.in(I_WDEC)) + (size_t)(l * 2 + d) * 64 * 1024 + hh * 64 + nb * 32 + r32;
#pragma unroll
        for (int ks = 0; ks < 4; ++ks) { float t_[8];
#pragma unroll
            for (int j = 0; j < 8; ++j) t_[j] = Wm[(size_t)(ks * 16 + hi * 8 + j) * 1024];
            Bf[ks] = __builtin_bit_cast(bf16x8, pack8(t_)); }
        lbias = (mtx ? a.in(I_A0) : a.in(I_W0))[l * 2048 + d * 1024 + hh * 64 + nb * 32 + r32];
    }
    if (loader) {
        const float* mu0 = a.in(I_MU) + (size_t)l * 2 * RWIN; const float* mu1 = mu0 + RWIN;
#define LD8F(dst, p) do { const f32x4 x0_ = *(const f32x4*)(p), x1_ = *(const f32x4*)((p) + 4); _Pragma("unroll") for (int i = 0; i < 4; ++i) { dst[i] = x0_[i]; dst[4 + i] = x1_[i]; } } while (0)
        LD8F(ka, a.in(I_KA) + l * 1024 + chn); LD8F(rk, a.in(I_RK) + ((size_t)(l * 2 + d) * 16 + hh) * 64 + lg * 8); LD8F(kkw, a.in(I_KK) + l * 1024 + chn);
        LD8F(m0r, mu0 + chn); LD8F(m1r, mu1 + chn); LD8F(m0k, mu0 + 1024 + chn); LD8F(m1k, mu1 + 1024 + chn); LD8F(m0v, mu0 + 2048 + chn); LD8F(m1v, mu1 + 2048 + chn);
#undef LD8F
    }
#define SC_TOK(step) (d ? (SEQ - 1 - (step)) : (step))
#define SC_ISSUE(cn) do { const int tok_ = SC_TOK((cn) * SCAN_T + lj), row_ = sq * SEQ + tok_; const bf16* rp_ = PRW + (size_t)row_ * W_RW + chn; \
        const int op_ = tok_ > 0 ? -W_RW : 0, on_ = tok_ < SEQ - 1 ? W_RW : 0; \
        g_r = *(const u32x4*)rp_; g_rp = *(const u32x4*)(rp_ + op_); g_rn = *(const u32x4*)(rp_ + on_); g_k = *(const u32x4*)(rp_ + 1024); g_kp = *(const u32x4*)(rp_ + 1024 + op_); g_kn = *(const u32x4*)(rp_ + 1024 + on_); \
        g_v = *(const u32x4*)(rp_ + 2048); g_vp = *(const u32x4*)(rp_ + 2048 + op_); g_vn = *(const u32x4*)(rp_ + 2048 + on_); } while (0)
#define ST8(p, x) do { *(LAS f32x4*)(p) = (f32x4){x[0], x[1], x[2], x[3]}; *(LAS f32x4*)((p) + 4) = (f32x4){x[4], x[5], x[6], x[7]}; } while (0)
#define SC_MIX(dst, gc, gp, gn, m0, m1) do { float x_[8], xp_[8], xn_[8]; unpack8(gc, x_); unpack8(gp, xp_); unpack8(gn, xn_); \
        _Pragma("unroll") for (int i = 0; i < 8; ++i) dst[i] = x_[i] + m0[i] * (xp_[i] * zp_ - x_[i]) + m1[i] * (xn_[i] * zn_ - x_[i]); } while (0)
#define SC_WRITE(cn) do { float r_[8], k_[8], v_[8], kk_[8], w_[8], a_[8]; unpack8(*(const LAS u32x4*)(xs + (((cn) & 1) * 2 + 0) * 2048 + lj * 64 + lg * 8), w_); unpack8(*(const LAS u32x4*)(xs + (((cn) & 1) * 2 + 1) * 2048 + lj * 64 + lg * 8), a_); \
        { const int tok_ = SC_TOK((cn) * SCAN_T + lj); const float zp_ = tok_ > 0 ? 1.f : 0.f, zn_ = tok_ < SEQ - 1 ? 1.f : 0.f; \
          SC_MIX(r_, g_r, g_rp, g_rn, m0r, m1r); SC_MIX(k_, g_k, g_kp, g_kn, m0k, m1k); SC_MIX(v_, g_v, g_vp, g_vn, m0v, m1v); \
          float ss_ = 0.f; _Pragma("unroll") for (int i = 0; i < 8; ++i) { kk_[i] = k_[i] * kkw[i]; ss_ += kk_[i] * kk_[i]; } \
          ss_ = reduce8(ss_); const float inv_ = 1.f / fmaxf(sqrtf(ss_), 1e-12f); _Pragma("unroll") for (int i = 0; i < 8; ++i) kk_[i] *= inv_; } \
        LAS float* bp_ = buf + ((cn) & 1) * SCAN_BUF_F + lj * SCAN_STEP_F + lg * 8; float bs_ = 0.f; \
        float G_[8], kt_[8], at_[8], bt_[8], rt_[8]; \
        _Pragma("unroll") for (int i = 0; i < 8; ++i) { G_[i] = __builtin_amdgcn_exp2f(-0.8750387749f * w_[i]); const float kd_ = k_[i] * (1.f + (a_[i] - 1.f) * ka[i]); bs_ += r_[i] * kd_ * rk[i]; bt_[i] = kd_; at_[i] = kk_[i] * a_[i]; } \
        _Pragma("unroll") for (int off_ = 8; off_ < 64; off_ <<= 1) { _Pragma("unroll") for (int i = 0; i < 8; ++i) { const float y_ = __shfl_up(G_[i], off_); if (lane >= off_) G_[i] *= y_; } } \
        _Pragma("unroll") for (int i = 0; i < 8; ++i) { float gp_ = __shfl_up(G_[i], 8); if (lane < 8) gp_ = 1.f; const float rg_ = 1.f / G_[i]; kt_[i] = kk_[i] * gp_; at_[i] *= rg_; bt_[i] *= rg_; rt_[i] = r_[i] * G_[i]; } \
        ST8(bp_, G_); ST8(bp_ + 64, kt_); ST8(bp_ + 128, at_); ST8(bp_ + 192, bt_); ST8(bp_ + 256, rt_); ST8(bp_ + 320, v_); \
        bs_ = reduce8(bs_); if (lg == 0) { const int row_ = sq * SEQ + SC_TOK((cn) * SCAN_T + lj); bonus[((size_t)d * GROWS + row_) * 16 + hh] = bs_; } } while (0)
#define SC_LORA(cn) do { const bf16* ap_ = AL + (size_t)(sq * SEQ + SC_TOK((cn) * SCAN_T + r32)) * LORA_K + mtx * 128 + d * 64 + hi * 8; f32x16 acc_ = {}; \
        _Pragma("unroll") for (int ks = 0; ks < 4; ++ks) acc_ = __builtin_amdgcn_mfma_f32_32x32x16_bf16(*(const bf16x8*)(ap_ + ks * 16), Bf[ks], acc_, 0, 0, 0); \
        LAS bf16* xp_ = xs + (((cn) & 1) * 2 + mtx) * 2048 + nb * 32 + r32; \
        _Pragma("unroll") for (int r = 0; r < 16; ++r) xp_[att::crow(r, hi) * 64] = (bf16)(cvt_pk_bf16(sigmoidf_(acc_[r] + lbias), 0.f) & 0xffffu); } while (0)
#define SC_OUT(cn) do { const LAS float* op_ = obuf + ((cn) & 1) * (SCAN_T * 64) + lj * 64 + lg * 8; const f32x4 o0_ = *(const LAS f32x4*)op_, o1_ = *(const LAS f32x4*)(op_ + 4); \
        const int row_ = sq * SEQ + SC_TOK((cn) * SCAN_T + lj); u32x4 w_; w_.x = cvt_pk_bf16(o0_[0], o0_[1]); w_.y = cvt_pk_bf16(o0_[2], o0_[3]); w_.z = cvt_pk_bf16(o1_[0], o1_[1]); w_.w = cvt_pk_bf16(o1_[2], o1_[3]); \
        *(u32x4*)(OD + (size_t)row_ * 1024 + hh * 64 + lg * 8) = w_; } while (0)
    constexpr int NCH = SEQ / SCAN_T;
    const int rloc = (C.wave & 3) * 8 + (lane >> 3), cg = lane & 7;
    f32x2 s01 = {0.f, 0.f}, s23 = {0.f, 0.f}, s45 = {0.f, 0.f}, s67 = {0.f, 0.f};
    f32x2 t01 = {0.f, 0.f}, t23 = {0.f, 0.f}, t45 = {0.f, 0.f}, t67 = {0.f, 0.f};
    if (loader) SC_LORA(0);
    __syncthreads();
    if (loader) { SC_ISSUE(0); SC_WRITE(0); SC_LORA(1); }
    __syncthreads();
#pragma unroll 1
    for (int cn = 0; cn < NCH; ++cn) {
        if (loader) {
            if (cn + 1 < NCH) SC_ISSUE(cn + 1);
            if (cn + 2 < NCH) SC_LORA(cn + 2);
            if (cn > 0) SC_OUT(cn - 1);
            if (cn + 1 < NCH) SC_WRITE(cn + 1);
        } else {
            const unsigned ba = (unsigned)(uintptr_t)(buf + (cn & 1) * SCAN_BUF_F + cg * 8);
            const unsigned va = (unsigned)(uintptr_t)(buf + (cn & 1) * SCAN_BUF_F + 320 + rloc);
            LAS float* op = obuf + (cn & 1) * (SCAN_T * 64) + rloc;
#define DSR128(dst, addr, off) asm volatile("ds_read_b128 %0, %1 offset:%2" : "=v"(dst) : "v"(addr), "n"(off))
#define DSR32(dst, addr, off) asm volatile("ds_read_b32 %0, %1 offset:%2" : "=v"(dst) : "v"(addr), "n"(off))
#define SC_LDE(j) do { DSR128(Ek0, ba, (j) * 1536 + 256); DSR128(Ek1, ba, (j) * 1536 + 272); DSR128(Ed0, ba, (j) * 1536 + 768); DSR128(Ed1, ba, (j) * 1536 + 784); DSR32(Evv, va, (j) * 1536); DSR32(Evu, va, (j) * 1536 + 128); } while (0)
#define SC_LDL(j) do { DSR128(La0, ba, (j) * 1536 + 512); DSR128(La1, ba, (j) * 1536 + 528); DSR128(Lr0, ba, (j) * 1536 + 1024); DSR128(Lr1, ba, (j) * 1536 + 1040); \
        if ((((j) & 7) == 7)) { DSR128(Lg0, ba, (j) * 1536); DSR128(Lg1, ba, (j) * 1536 + 16); } } while (0)
#define LO2(v) __builtin_shufflevector(v, v, 0, 1)
#define HI2(v) __builtin_shufflevector(v, v, 2, 3)
#define SC_STEP(j) do { \
        if ((((j) & 7) == 7)) asm volatile("s_waitcnt lgkmcnt(6)" : "+v"(Ek0), "+v"(Ek1), "+v"(Ed0), "+v"(Ed1), "+v"(Evv), "+v"(Evu)); \
        else asm volatile("s_waitcnt lgkmcnt(4)" : "+v"(Ek0), "+v"(Ek1), "+v"(Ed0), "+v"(Ed1), "+v"(Evv), "+v"(Evu)); \
        if ((j) > 0) { const float q_ = reduce8(cqs_); const float qv_ = reduce8(cqt_); op[((j) - 1) * 64] = q_; op[((j) - 1) * 64 + 32] = qv_; }     \
        f32x2 pp_ = s01 * LO2(Ek0); f32x2 pu_ = t01 * LO2(Ek0); pp_ = s23 * HI2(Ek0) + pp_; pu_ = t23 * HI2(Ek0) + pu_; pp_ = s45 * LO2(Ek1) + pp_; pu_ = t45 * LO2(Ek1) + pu_; pp_ = s67 * HI2(Ek1) + pp_; pu_ = t67 * HI2(Ek1) + pu_; \
        float p_ = reduce8(pp_[0] + pp_[1]); float pq_ = reduce8(pu_[0] + pu_[1]); const f32x2 v2_ = {Evv, Evv}, u2_ = {Evu, Evu}; \
        s01 = v2_ * LO2(Ed0) + s01; s23 = v2_ * HI2(Ed0) + s23; s45 = v2_ * LO2(Ed1) + s45; s67 = v2_ * HI2(Ed1) + s67; \
        t01 = u2_ * LO2(Ed0) + t01; t23 = u2_ * HI2(Ed0) + t23; t45 = u2_ * LO2(Ed1) + t45; t67 = u2_ * HI2(Ed1) + t67; \
        asm volatile("" : "+v"(s01), "+v"(s23), "+v"(s45), "+v"(s67), "+v"(t01), "+v"(t23), "+v"(t45), "+v"(t67), "+v"(p_), "+v"(pq_));     \
        SC_LDE((j) + 1); \
        if ((((j) & 7) == 7)) asm volatile("s_waitcnt lgkmcnt(6)" : "+v"(La0), "+v"(La1), "+v"(Lr0), "+v"(Lr1), "+v"(Lg0), "+v"(Lg1)); \
        else asm volatile("s_waitcnt lgkmcnt(6)" : "+v"(La0), "+v"(La1), "+v"(Lr0), "+v"(Lr1)); \
        { const f32x2 p2_ = {p_, p_}, q2_ = {pq_, pq_}; \
        s01 = s01 - p2_ * LO2(La0); s23 = s23 - p2_ * HI2(La0); s45 = s45 - p2_ * LO2(La1); s67 = s67 - p2_ * HI2(La1); \
        t01 = t01 - q2_ * LO2(La0); t23 = t23 - q2_ * HI2(La0); t45 = t45 - q2_ * LO2(La1); t67 = t67 - q2_ * HI2(La1); } \
        f32x2 qq_ = s01 * LO2(Lr0); f32x2 qu_ = t01 * LO2(Lr0); qq_ = s23 * HI2(Lr0) + qq_; qu_ = t23 * HI2(Lr0) + qu_; qq_ = s45 * LO2(Lr1) + qq_; qu_ = t45 * LO2(Lr1) + qu_; qq_ = s67 * HI2(Lr1) + qq_; qu_ = t67 * HI2(Lr1) + qu_; \
        if ((((j) & 7) == 7)) { s01 *= LO2(Lg0); s23 *= HI2(Lg0); s45 *= LO2(Lg1); s67 *= HI2(Lg1); t01 *= LO2(Lg0); t23 *= HI2(Lg0); t45 *= LO2(Lg1); t67 *= HI2(Lg1); }     \
        asm volatile("" : "+v"(qq_), "+v"(qu_), "+v"(s01), "+v"(s23), "+v"(s45), "+v"(s67), "+v"(t01), "+v"(t23), "+v"(t45), "+v"(t67));     \
        SC_LDL((j) + 1); \
        cqs_ = qq_[0] + qq_[1]; cqt_ = qu_[0] + qu_[1]; } while (0)
            f32x4 Ek0, Ek1, Ed0, Ed1, La0, La1, Lr0, Lr1, Lg0, Lg1; float Evv, Evu; float cqs_ = 0.f, cqt_ = 0.f;
            SC_LDE(0); SC_LDL(0);
#pragma unroll
            for (int j = 0; j < SCAN_T; ++j) SC_STEP(j);
            { const float q_ = reduce8(cqs_); const float qv_ = reduce8(cqt_); op[(SCAN_T - 1) * 64] = q_; op[(SCAN_T - 1) * 64 + 32] = qv_; }
            asm volatile("s_waitcnt lgkmcnt(0)" : "+v"(Ek0), "+v"(Ek1), "+v"(Ed0), "+v"(Ed1), "+v"(Evv), "+v"(Evu), "+v"(La0), "+v"(La1), "+v"(Lr0), "+v"(Lr1), "+v"(Lg0), "+v"(Lg1));
#undef DSR128
#undef DSR32
#undef SC_LDE
#undef SC_LDL
#undef SC_STEP
#undef LO2
#undef HI2
        }
        __syncthreads();
    }
    if (loader) SC_OUT(NCH - 1);
    __syncthreads();
#undef SC_TOK
#undef SC_ISSUE
#undef SC_LORA
#undef SC_MIX
#undef SC_WRITE
#undef SC_OUT
#undef ST8
}

constexpr int NT_STEPS = 12;
constexpr int N_STEPS = 1 + NLAYER * (1 + NGRP * NT_STEPS) + 1;
#ifndef NL_BUILD
#define NL_BUILD NLAYER
#endif
#ifndef NG_BUILD
#define NG_BUILD NGRP
#endif

#define IN_STEP(k) (lo <= (sbase + (k)) && (sbase + (k)) < hi)
#define END_STEP(k) do { if (sbase + (k) + 1 < hi) { const PT pb_(C); XcdBarrier bar_; bar_.bar = (unsigned*)(pb_.ws() + WS_CTL) + CW_BAR; bar_.x = xb_xcc_id(); bar_.st = (volatile LAS unsigned*)(C.lds + MISC_OFF) + 8; xcd_barrier(bar_); } } while (0)
#define STEP_PTRS const PT a(C); unsigned char* const ws = a.ws(); (void)ws; \
    const float* const mod = (const float*)(ws + WS_MOD); bf16* const wb = (bf16*)(ws + WS_W); (void)wb; \
    const float* const xsrc = (L == 0) ? ((GI < 2) ? a.in(I_XP) + grow0 * DM : a.in(I_XS) + (grow0 - 32768) * DM) : a.out() + grow0 * DM; (void)xsrc; \
    float* const xout = a.out() + grow0 * DM; (void)xout; \
    const float* const modb = mod + ((size_t)L * 12 + GI * 4) * NMOD; (void)modb;

template <int L, int GI>
__device__ __forceinline__ void group_program(const Ctx& C, const int lo, const int hi) {
    constexpr int sbase = 1 + L * (1 + NGRP * NT_STEPS) + 1 + GI * NT_STEPS;
    constexpr size_t grow0 = (size_t)GI * GROWS;
    const int gdim = gridDim.x, bidx = blockIdx.x;
    if (EN(2) && IN_STEP(0)) { if constexpr (L == 0 && GI == 0) { REPEAT(2) { STEP_PTRS; phase_modnorm(C, C.gw, C.ngw, xsrc, (bf16*)(ws + A_H), a.in(I_NMIXG) + L * DM, modb, 0, 1); } END_STEP(0); } }
    if (EN(3) && IN_STEP(1)) { REPEAT(3) { STEP_PTRS;
        pg8::Gemm gm{(const bf16*)(ws + A_H), (const bf16*)((char*)wb + WO_IN), GROWS, NPROJ - 256, DM, DM, DM}; pg8::StaticOrder S; S.init(GROWS, NPROJ - 256, gdim, bidx);
        pg8::EpiG<FProj> E{FProj{(bf16*)(ws + A_PMLA), (bf16*)(ws + A_PRW), (bf16*)(ws + A_PGATE)}};
        pg8::gemm_phase<pg8::EpiG<FProj>, pg8::StaticOrder, PG8_ALIGN, PG8_SP2>(C.lds, gm, S, E); }
        END_STEP(1); }
    if (EN(4) && IN_STEP(2)) { REPEAT(4) { phase_prep(C, L); } END_STEP(2); }
    if (EN(5) && IN_STEP(3)) { REPEAT(5) {
        { STEP_PTRS; pg8::Gemm gm{(const bf16*)(ws + A_ALORA) + 256, (const bf16*)((char*)wb + WO_LORA) + (size_t)4096 * LORA_KB, GROWS, 1024, LORA_KB, LORA_K, LORA_KB}; pg8::StaticOrder S; S.init(GROWS, 1024, gdim, bidx);
          pg8::EpiG<FLora> E{FLora{(bf16*)(ws + A_LORAOUT), a.in(I_W0) + L * 2048, a.in(I_A0) + L * 2048, 4096}};
          pg8::gemm_phase<pg8::EpiG<FLora>, pg8::StaticOrder, PG8_ALIGN, PG8_SP2>(C.lds, gm, S, E); }
        { STEP_PTRS; pg8::Gemm gm{(const bf16*)(ws + A_PMLA), (const bf16*)((char*)wb + WO_UQ), GROWS, QW, 512, W_MLA, 512}; pg8::SkewOrder<2, 0, 2> S; S.init(GROWS, QW, gdim, bidx);
          pg8::EpiG<FQ> E{FQ{(bf16*)(ws + A_Q), (const float*)(ws + WS_RSTD), (const float*)(ws + WS_ROPE), (const float*)(ws + WS_ROPE) + SEQ * 32}};
          pg8::gemm_phase<pg8::EpiG<FQ>, pg8::SkewOrder<2, 0, 2>, PG8_ALIGN, PG8_SP2>(C.lds, gm, S, E); }
        { STEP_PTRS; pg8::Gemm gm{(const bf16*)(ws + A_PMLA) + 512, (const bf16*)((char*)wb + WO_UKV), GROWS, 2048, 256, W_MLA, 256}; pg8::SkewOrder<3, 0, 2> S; S.init(GROWS, 2048, gdim, bidx);
          pg8::EpiG<FKV> E{FKV{(bf16*)(ws + A_KF), (bf16*)(ws + A_V), (const float*)(ws + WS_RSTD) + GROWS}};
          pg8::gemm_phase<pg8::EpiG<FKV>, pg8::SkewOrder<3, 0, 2>, PG8_ALIGN, PG8_SP2>(C.lds, gm, S, E); }
        { STEP_PTRS; pg8::Gemm gm{(const bf16*)(ws + A_H), (const bf16*)((char*)wb + WO_IN) + (size_t)(NPROJ - 256) * DM, GROWS, 256, DM, DM, DM}; pg8::SkewOrder<0, 1, 0> S; S.init(GROWS, 256, gdim, bidx);
          pg8::EpiG<FStore> E{FStore{(bf16*)(ws + A_PGATE) + (W_GATE - 256), W_GATE}};
          pg8::gemm_phase<pg8::EpiG<FStore>, pg8::SkewOrder<0, 1, 0>, PG8_ALIGN, PG8_SP2>(C.lds, gm, S, E); } }
        END_STEP(3); }
    if (EN(6) && IN_STEP(4)) { { STEP_PTRS;
        const bool split = (gdim == 256);
        const int xcd = bidx & 7, bi = (bidx >> 3) & 15;
        for (int rp_ = 0; rp_ < (((PROBE_MASK >> 6) & 1) ? 2 : 1); ++rp_)
        for (int pr = bidx; pr < 128; pr += gdim) scan_chain(C, L, pr);
        const int r0 = 0, nr = split ? (bidx < 128 ? 0 : 4) : (512 - bidx + gdim - 1) / gdim;
        for (int k = 0; k < nr * (((PROBE_MASK >> 7) & 1) ? 2 : 1); ++k) {
            const int kk = k % (nr > 0 ? nr : 1);
            int pi, qb;
            if (split) { pi = xcd + 8 * (r0 + kk); qb = bi; } else { const int u = bidx + kk * gdim; pi = u >> 4; qb = u & 15; }
            const int hh = pi & 7, sq = pi >> 3;
            const bf16* Qb = (const bf16*)(ws + A_Q) + ((size_t)sq * SEQ + qb * 256) * QW + hh * 192;
            const bf16* Kh = (const bf16*)(ws + A_KF) + (size_t)sq * SEQ * KFW + hh * 192;
            const bf16* Vh = (const bf16*)(ws + A_V) + (size_t)sq * SEQ * VW + hh * 128;
            bf16* Ob = (bf16*)(ws + A_ATTO) + ((size_t)sq * SEQ + qb * 256) * 1024 + hh * 128;
            att::attn_unit(Qb, Kh, Vh, Ob, SEQ, (LAS char*)C.lds);
        }
        constexpr int NL_ = (GI == NGRP - 1) ? L + 1 : L, NG_ = (GI == NGRP - 1) ? 0 : GI + 1;
        if constexpr (NL_ < NLAYER) {
            constexpr size_t ngrow0 = (size_t)NG_ * GROWS;
            const float* nx = (NL_ == 0) ? ((NG_ < 2) ? a.in(I_XP) + ngrow0 * DM : a.in(I_XS) + (ngrow0 - 32768) * DM) : a.out() + ngrow0 * DM;
            const float* nmodb = mod + ((size_t)NL_ * 12 + NG_ * 4) * NMOD;
            if (split) { if (bidx >= 128) phase_modnorm(C, (bidx - 128) * NWAVES + C.wave, 128 * NWAVES, nx, (bf16*)(ws + A_H), a.in(I_NMIXG) + NL_ * DM, nmodb, 0, 1); }
            else phase_modnorm(C, C.gw, C.ngw, nx, (bf16*)(ws + A_H), a.in(I_NMIXG) + NL_ * DM, nmodb, 0, 1);
        }
        if constexpr (L == NLAYER - 1 && GI >= 1) {
            if (split) { if (bidx >= 128) phase_final(C, (bidx - 128) * NWAVES + C.wave, 128 * NWAVES, (GI - 1) * GROWS, GI * GROWS, a.out(), a.in(I_FNG)); }
            else phase_final(C, C.gw, C.ngw, (GI - 1) * GROWS, GI * GROWS, a.out(), a.in(I_FNG));
        } }
        END_STEP(4); }
    if (EN(7) && IN_STEP(5)) { REPEAT(15) { phase_rwkv_post(C, L); } END_STEP(5); }
    if (EN(8) && IN_STEP(6)) { REPEAT(8) {
        { STEP_PTRS; pg8::Gemm gm{(const bf16*)(ws + A_ATTO), (const bf16*)((char*)wb + WO_OATT), GROWS, DM, 1024, 1024, 1024}; pg8::StaticOrder S; S.init(GROWS, DM, gdim, bidx);
          pg8::EpiG<FMergeA> E{FMergeA{(bf16*)(ws + A_MERGED), (const bf16*)(ws + A_PGATE)}};
          pg8::gemm_phase<pg8::EpiG<FMergeA>, pg8::StaticOrder, PG8_ALIGN, PG8_SP2>(C.lds, gm, S, E); }
        VM_WAIT(); __syncthreads();
        { STEP_PTRS; pg8::Gemm gm{(const bf16*)(ws + A_RWKVO), (const bf16*)((char*)wb + WO_ORWKV), GROWS, DM, 1024, 1024, 1024}; pg8::StaticOrder S; S.init(GROWS, DM, gdim, bidx);
          pg8::EpiG<FMergeB> E{FMergeB{(bf16*)(ws + A_MERGED), (const bf16*)(ws + A_PGATE)}};
          pg8::gemm_phase<pg8::EpiG<FMergeB>, pg8::StaticOrder, PG8_ALIGN, PG8_SP2>(C.lds, gm, S, E); }
          VM_WAIT(); __syncthreads(); }
        END_STEP(6); }
    if (EN(9) && IN_STEP(7)) { _Pragma("unroll") for (int rep_ = 0; rep_ < ((((PROBE_MASK >> 9) & 1) && L == 0) ? 2 : 1); ++rep_) { STEP_PTRS;
        pg8::Gemm gm{(const bf16*)(ws + A_MERGED), (const bf16*)((char*)wb + WO_OUT), GROWS, DM, DM, DM, DM}; pg8::StaticOrder S; S.init(GROWS, DM, gdim, bidx);
        pg8::EpiG<FResid> E{FResid{xsrc, xout, modb + 2 * DM}};
        pg8::gemm_phase<pg8::EpiG<FResid>, pg8::StaticOrder, false, PG8_SP2>(C.lds, gm, S, E); }
        END_STEP(7); }
    if (EN(10) && IN_STEP(8)) { REPEAT(10) { STEP_PTRS; phase_modnorm(C, C.gw, C.ngw, xout, (bf16*)(ws + A_H2), a.in(I_NFFNG) + L * DM, modb, 3, 4); } END_STEP(8); }
    if (EN(11) && IN_STEP(9)) { { STEP_PTRS;
        pg8::Gemm gm{(const bf16*)(ws + A_H2), (const bf16*)((char*)wb + WO_UP), GROWS, 2 * DFF, DM, DM, DM}; pg8::StaticOrder S; S.init(GROWS, 2 * DFF, gdim, bidx);
        EpiAct E{(bf16*)(ws + A_ACT), (bf16*)(ws + A_EA), (bf16*)(ws + A_EB), a.in(I_CONVW) + (size_t)L * 3 * DFF, a.in(I_CONVB) + (size_t)L * DFF};
        pg8::gemm_phase<EpiAct, pg8::StaticOrder, PG8_ALIGN, PG8_SP2, true>(C.lds, gm, S, E); }
        END_STEP(9); }
    if (EN(12) && IN_STEP(10)) { phase_act_fix(C, L); END_STEP(10); }
    if (EN(13) && IN_STEP(11)) { { STEP_PTRS;
        pg8::Gemm gm{(const bf16*)(ws + A_ACT), (const bf16*)((char*)wb + WO_DOWN), GROWS, DM, DFF, DFF, DFF}; pg8::StaticOrder S; S.init(GROWS, DM, gdim, bidx);
        pg8::EpiG<FResid> E{FResid{xout, xout, modb + 5 * DM}};
        pg8::gemm_phase<pg8::EpiG<FResid>, pg8::StaticOrder, false, PG8_SP2>(C.lds, gm, S, E); }
        if constexpr (GI == NGRP - 1) END_STEP(11);
    }
}
template <int L>
__device__ __forceinline__ void layer_program(const Ctx& C, const int lo, const int hi) {
    constexpr int sbase = 1 + L * (1 + NGRP * NT_STEPS);
    if (EN(1) && IN_STEP(0)) { if constexpr (L > 0) { phase_convert(C, L); END_STEP(0); } }
    group_program<L, 0>(C, lo, hi);
    if constexpr (NG_BUILD > 1) group_program<L, 1>(C, lo, hi);
    if constexpr (NG_BUILD > 2) group_program<L, 2>(C, lo, hi);
}

__global__ void __launch_bounds__(NWAVES * 64, 2) mk_fwd(Args a) {
    extern __shared__ __attribute__((aligned(16))) unsigned char lds_raw[];
    Ctx C;
    C.lds = (LAS unsigned char*)lds_raw;
    C.tid = threadIdx.x; C.lane = C.tid & 63; C.wave = __builtin_amdgcn_readfirstlane(C.tid >> 6);
    C.gw = blockIdx.x * NWAVES + C.wave; C.ngw = gridDim.x * NWAVES;
    for (int u = C.tid; u < (LDS_BYTES - LDSCTL_OFF) / 4; u += NWAVES * 64) ((LAS unsigned*)(C.lds + LDSCTL_OFF))[u] = 0u;
    __syncthreads();
    if (C.tid == 0) {
        LAS unsigned long long* t = (LAS unsigned long long*)(C.lds + ARGTAB_OFF);
#pragma unroll
        for (int i = 0; i < 32; ++i) t[i] = (unsigned long long)a.in[i];
        t[32] = (unsigned long long)a.out; t[33] = (unsigned long long)a.ws;
    }
    __syncthreads();
    const int lo = a.lo, hi = a.hi;
    if (hi - lo > 1) (void)xcd_barrier_post((unsigned*)(a.ws + WS_CTL) + CW_BAR, (volatile LAS unsigned*)(C.lds + MISC_OFF) + 8);
    { constexpr int sbase = 0; if (EN(0) && IN_STEP(0)) { phase_mod(C); __syncthreads(); phase_convert(C, 0); END_STEP(0); } }
    layer_program<0>(C, lo, hi);
    if constexpr (NL_BUILD > 1) layer_program<1>(C, lo, hi);
    { constexpr int sbase = N_STEPS - 1; if (EN(14) && IN_STEP(0)) { const PT p(C); phase_final(C, C.gw, C.ngw, (NGRP - 1) * GROWS, MALL, p.out(), p.in(I_FNG)); } }
}
#undef IN_STEP
#undef END_STEP

extern "C" void kernel_launch(void* const* d_in, const int* in_sizes, int n_in, void* d_out, int out_size, void* d_ws, size_t ws_size, hipStream_t stream) {
    static int grid = 0;
    if (grid == 0) {
        if (n_in != 32 || out_size != MALL * DM || ws_size < WS_NEED) { fprintf(stderr, "kernel_launch: unexpected shapes: n_in %d out %d ws %zu (need %zu)\n", n_in, out_size, ws_size, (size_t)WS_NEED); grid = -1; return; }
        int dev = 0, cus = 0, per_cu = 0;
        if (hipGetDevice(&dev) != hipSuccess || hipDeviceGetAttribute(&cus, hipDeviceAttributeMultiprocessorCount, dev) != hipSuccess) { grid = -1; return; }
        if (hipFuncSetAttribute((const void*)mk_fwd, hipFuncAttributeMaxDynamicSharedMemorySize, LDS_BYTES) != hipSuccess) { fprintf(stderr, "kernel_launch: hipFuncSetAttribute failed\n"); grid = -1; return; }
        if (hipOccupancyMaxActiveBlocksPerMultiprocessor(&per_cu, (const void*)mk_fwd, NWAVES * 64, LDS_BYTES) != hipSuccess || per_cu < 1) fprintf(stderr, "kernel_launch: occupancy query reports %d\n", per_cu);
        (void)hipGetLastError();
        grid = cus;
    }
    if (grid < 0) return;
    if (hipMemsetAsync((char*)d_ws + WS_CTL, 0, CTL_ZERO_BYTES, stream) != hipSuccess) return;
    Args a{};
    for (int i = 0; i < 32; ++i) a.in[i] = (const float*)d_in[i];
    a.out = (float*)d_out; a.ws = (unsigned char*)d_ws;
#if MK_MODE == 1
    a.lo = 0; a.hi = N_STEPS;
    hipLaunchKernelGGL(mk_fwd, dim3(grid), dim3(NWAVES * 64), LDS_BYTES, stream, a);
#else
    for (int s = 0; s < N_STEPS; ++s) { a.lo = s; a.hi = s + 1; hipLaunchKernelGGL(mk_fwd, dim3(grid), dim3(NWAVES * 64), LDS_BYTES, stream, a); }
#endif
}
```

```cpp
#include <hip/hip_runtime.h>
#include <cstdio>
#include <cstdint>

#ifndef MK_MODE
#define MK_MODE 1
#endif

#ifndef ONLY
#define ONLY -1
#endif
#ifndef PROBE_MASK
#define PROBE_MASK 0
#endif
#define REPEAT(k) _Pragma("unroll") for (int rep_ = 0; rep_ < (((PROBE_MASK >> (k)) & 1) ? 2 : 1); ++rep_)
#define EN(k) (ONLY < 0 || ONLY == (k))
#define LAS __attribute__((address_space(3)))
#define GAS __attribute__((address_space(1)))
typedef unsigned short bf16;
typedef short bf16x8 __attribute__((ext_vector_type(8)));
typedef short s16x4 __attribute__((ext_vector_type(4)));
typedef float f32x4 __attribute__((ext_vector_type(4)));
typedef float f32x2 __attribute__((ext_vector_type(2)));
typedef float f32x16 __attribute__((ext_vector_type(16)));
typedef unsigned u32x4 __attribute__((ext_vector_type(4)));
typedef unsigned u32x2 __attribute__((ext_vector_type(2)));
typedef GAS unsigned gu32;

constexpr int DM = 2048, NSEQ = 12, SEQ = 4096, MALL = NSEQ * SEQ;
constexpr int NLAYER = 2;
constexpr int GROWS = 16384, NGRP = MALL / GROWS;
constexpr int DIN = 8416, W_MLA = 832, W_RW = 3520, W_GATE = 4096, NPROJ = W_MLA + W_RW + W_GATE;
constexpr int RWIN = 3488;
constexpr int DFF = 5632;
constexpr int NMOD = 6 * DM;
constexpr int QW = 1536, KFW = 1536, VW = 1024;
constexpr int LORA_K = 512, LORA_N = 5120, LORA_KB = 256;
constexpr int NWAVES = 8;

constexpr size_t MiB = 1u << 20;
constexpr size_t WS_CTL = 0, CTL_ZERO_BYTES = 3 * MiB;
constexpr size_t WS_MOD = 1 * MiB;
constexpr size_t WS_ROPE = 3 * MiB;
constexpr size_t WS_RSTD = 4 * MiB;
constexpr size_t WS_BONUS = 5 * MiB;
constexpr size_t WS_W = 8 * MiB;
constexpr size_t WO_IN = 0, WO_UQ = WO_IN + (size_t)NPROJ * DM * 2, WO_UKV = WO_UQ + (size_t)QW * 512 * 2, WO_OATT = WO_UKV + (size_t)2048 * 256 * 2,
                 WO_ORWKV = WO_OATT + (size_t)DM * 1024 * 2, WO_OUT = WO_ORWKV + (size_t)DM * 1024 * 2, WO_UP = WO_OUT + (size_t)DM * DM * 2,
                 WO_DOWN = WO_UP + (size_t)2 * DFF * DM * 2, WO_LORA = WO_DOWN + (size_t)DM * DFF * 2, WO_END = WO_LORA + (size_t)LORA_N * LORA_K * 2;
static_assert(WO_END <= 124 * MiB, "weights");
constexpr size_t WS_A = 132 * MiB;
constexpr size_t A_H = WS_A;
constexpr size_t A_PMLA = WS_A + 64 * MiB;
constexpr size_t A_PGATE = A_PMLA + 32 * MiB;
constexpr size_t A_PRW = A_PGATE + 128 * MiB;
constexpr size_t A_RKVKK = A_PRW + 112 * MiB;
constexpr size_t A_OF = A_RKVKK;
constexpr size_t A_OB = A_RKVKK + 32 * MiB;
constexpr size_t A_RWKVO = A_RKVKK + 64 * MiB;
constexpr size_t A_ALORA = A_RKVKK + 96 * MiB;
constexpr size_t A_MERGED = A_RKVKK;
constexpr size_t A_LORAOUT = A_RKVKK + 128 * MiB;
constexpr size_t A_Q = A_LORAOUT + 160 * MiB;
constexpr size_t A_KF = A_Q + 48 * MiB;
constexpr size_t A_V = A_KF + 48 * MiB;
constexpr size_t A_ATTO = A_V + 32 * MiB;
constexpr size_t A_TM_END = A_ATTO + 32 * MiB;
constexpr size_t A_MID = WS_A + 64 * MiB;
constexpr size_t A_EA = A_MID;
constexpr size_t A_EB = A_MID + 16 * MiB;
constexpr size_t A_ACT = A_MID + 352 * MiB;
constexpr size_t A_H2 = A_ACT + 176 * MiB;
constexpr size_t A_FF_END = A_H2 + 64 * MiB;
constexpr size_t WS_NEED = (A_TM_END > A_FF_END ? A_TM_END : A_FF_END);
static_assert(WS_NEED <= 1000 * MiB, "workspace map");

constexpr int CW_BAR = 4096;

constexpr int RING_BYTES = 131072, LDSCTL_OFF = RING_BYTES, MISC_OFF = LDSCTL_OFF + 320, LDS_BYTES = 147456;

#define LDS_WAIT() asm volatile("s_waitcnt lgkmcnt(0)" ::: "memory")
#define VM_WAIT() asm volatile("s_waitcnt vmcnt(0)" ::: "memory")
typedef __bf16 bf16x2_t __attribute__((ext_vector_type(2)));
__device__ __forceinline__ unsigned cvt_pk_bf16(float lo, float hi) { const f32x2 v = {lo, hi}; const bf16x2_t b = __builtin_convertvector(v, bf16x2_t); return __builtin_bit_cast(unsigned, b); }
__device__ __forceinline__ float bf_lo(unsigned w) { return __uint_as_float(w << 16); }
__device__ __forceinline__ float bf_hi(unsigned w) { return __uint_as_float(w & 0xffff0000u); }
__device__ __forceinline__ void unpack8(const u32x4 w, float (&f)[8]) { f[0] = bf_lo(w.x); f[1] = bf_hi(w.x); f[2] = bf_lo(w.y); f[3] = bf_hi(w.y); f[4] = bf_lo(w.z); f[5] = bf_hi(w.z); f[6] = bf_lo(w.w); f[7] = bf_hi(w.w); }
__device__ __forceinline__ void load8(const bf16* p, float (&f)[8]) { unpack8(*(const u32x4*)p, f); }
__device__ __forceinline__ u32x4 pack8(const float (&f)[8]) { u32x4 w; w.x = cvt_pk_bf16(f[0], f[1]); w.y = cvt_pk_bf16(f[2], f[3]); w.z = cvt_pk_bf16(f[4], f[5]); w.w = cvt_pk_bf16(f[6], f[7]); return w; }
__device__ __forceinline__ void store8(bf16* p, const float (&f)[8]) { *(u32x4*)p = pack8(f); }
__device__ __forceinline__ float sigmoidf_(float x) { return __builtin_amdgcn_rcpf(1.f + __expf(-x)); }
__device__ __forceinline__ float sigmoid_div(float x) { return 1.f / (1.f + __expf(-x)); }
__device__ __forceinline__ float wave_sum(float v) {
#pragma unroll
    for (int o = 1; o < 64; o <<= 1) v += __shfl_xor(v, o);
    return v;
}
__device__ __forceinline__ float reduce8(float x) {
    x += __builtin_bit_cast(float, __builtin_amdgcn_update_dpp(0, __builtin_bit_cast(int, x), 0xB1, 0xF, 0xF, true));
    x += __builtin_bit_cast(float, __builtin_amdgcn_update_dpp(0, __builtin_bit_cast(int, x), 0x4E, 0xF, 0xF, true));
    x += __builtin_bit_cast(float, __builtin_amdgcn_update_dpp(0, __builtin_bit_cast(int, x), 0x141, 0xF, 0xF, true));
    return x;
}

namespace pg8 {
constexpr int BM = 256, BK = 64, HALF = 128, HTB = HALF * BK * 2, STAGE_BYTES = 8 * HTB, NXCD = 8, WGM = 4;
__host__ __device__ __forceinline__ int lds_byte(int r, int c) { const int st = (r >> 4) * 2 + (c >> 5), rr = r & 15, cc = c & 31, ob = rr * 64 + cc * 2; return st * 1024 + (ob ^ (((ob >> 9) & 1) << 5)); }
__host__ __device__ __forceinline__ void stage_rc(int b, int& R, int& C) { const int st = b / 1024, sb = b % 1024, swz = sb ^ (((sb >> 9) & 1) << 5); R = (st >> 1) * 16 + swz / 64; C = (st & 1) * 32 + (swz % 64) / 2; }
__host__ __device__ __forceinline__ int perm32(int rho) { const int n = rho >> 4, i = rho & 15; return 8 * (i >> 2) + 4 * n + (i & 3); }
struct Unit { int pm, pn; };
struct Gemm { const bf16* A; const bf16* Bt; int M, N, K, lda, ldb; };
struct StaticOrder {
    int nM, nN, nwg, G, c;
    __host__ __device__ void init(int M, int N, int G_, int c_) { nM = M / BM; nN = N / BM; nwg = nM * nN; G = G_; c = c_; }
    __host__ __device__ bool next(int i, Unit& u) const {
        const long L = (long)i * G + c; if (L >= nwg) return false;
        int wgid = (int)L; { const int q = nwg / NXCD, r = nwg % NXCD, xcd = wgid % NXCD, off = wgid / NXCD; wgid = (xcd < r ? xcd * (q + 1) : r * (q + 1) + (xcd - r) * q) + off; }
        const int nig = WGM * nN, gid = wgid / nig, fm = gid * WGM, gsz = (nM - fm) < WGM ? (nM - fm) : WGM;
        u.pm = fm + ((wgid % nig) % gsz); u.pn = (wgid % nig) / gsz; return true;
    }
    __device__ __forceinline__ void a_ready(const Unit&) const {}
    __device__ __forceinline__ void done(const Unit&) const {}
};
template <int N0, int N1, int N2> struct SkewOrder {
    int nM, nN, nwg, G, c;
    __host__ __device__ void init(int M, int N, int G_, int c_) { nM = M / BM; nN = N / BM; nwg = nM * nN; G = G_; c = c_; }
    __host__ __device__ bool next(int i, Unit& u) const {
        long L;
        if (G == 256 && nwg == 128 * N0 + 64 * N1 + 64 * N2) {
            if (c < 128) { if (i >= N0) return false; L = i * 128 + c; }
            else if (c < 192) { if (i >= N1) return false; L = N0 * 128 + i * 64 + (c - 128); }
            else { if (i >= N2) return false; L = N0 * 128 + N1 * 64 + i * 64 + (c - 192); }
        } else { L = (long)i * G + c; if (L >= nwg) return false; }
        int wgid = (int)L; { const int q = nwg / NXCD, r = nwg % NXCD, xcd = wgid % NXCD, off = wgid / NXCD; wgid = (xcd < r ? xcd * (q + 1) : r * (q + 1) + (xcd - r) * q) + off; }
        const int nig = WGM * nN, gid = wgid / nig, fm = gid * WGM, gsz = (nM - fm) < WGM ? (nM - fm) : WGM;
        u.pm = fm + ((wgid % nig) % gsz); u.pn = (wgid % nig) / gsz; return true;
    }
    __device__ __forceinline__ void a_ready(const Unit&) const {}
    __device__ __forceinline__ void done(const Unit&) const {}
};
template <class F> struct EpiG {
    static constexpr bool PERM = true, AFTER_DRAIN = false;
    F f;
    __device__ __forceinline__ void operator()(const f32x4 (&acc)[2][2][4][2], const Unit& u, int wr, int wc, int fr, int fq) const {
        const int row0 = u.pm * BM + wr * 64 + fr, col0 = u.pn * BM + wc * 32 + 8 * fq;
#pragma unroll
        for (int ai = 0; ai < 2; ++ai)
#pragma unroll
            for (int m = 0; m < 4; ++m) {
                const int row = row0 + ai * HALF + m * 16;
#pragma unroll
                for (int bj = 0; bj < 2; ++bj) {
                    float v[8]; const f32x4 a0 = acc[ai][bj][m][0], a1 = acc[ai][bj][m][1];
                    v[0] = a0[0]; v[1] = a0[1]; v[2] = a0[2]; v[3] = a0[3]; v[4] = a1[0]; v[5] = a1[1]; v[6] = a1[2]; v[7] = a1[3];
                    f(row, col0 + bj * HALF, v);
                }
                asm volatile("" ::: "memory");
            }
    }
};

template <class Epi, class Sched, bool ALIGN_EPI = false, bool SP2 = false, bool PERMA = false>
__device__ __forceinline__ void gemm_phase(LAS unsigned char* lds, const Gemm g, const Sched& S, const Epi& E) {
    const int tid = threadIdx.x, wid = __builtin_amdgcn_readfirstlane(tid >> 6), lane = tid & 63, wr = wid >> 2, wc = wid & 3, fr = lane & 15, fq = lane >> 4;
    const int K = g.K, nt = K / BK;
    unsigned voffA[2], voffB[2];
#pragma unroll
    for (int i = 0; i < 2; ++i) { int R, C; stage_rc(tid * 16 + i * 8192, R, C); const int Rb = Epi::PERM ? ((R & ~31) + perm32(R & 31)) : R;
        const int Ra = PERMA ? ((R & 64) | ((R & 15) << 2) | ((R >> 4) & 3)) : R;
        voffA[i] = (unsigned)(Ra * g.lda + C) * 2u; voffB[i] = (unsigned)(Rb * g.ldb + C) * 2u; }
    const size_t kstep = (size_t)(BK * 2);
    const size_t hstepA = (size_t)HALF * g.lda * 2, hstepB = (size_t)HALF * g.ldb * 2;
    const size_t tstepA = 2 * hstepA, tstepB = 2 * hstepB;
    const unsigned ldsw = (unsigned)wid * 1024u;
    const int aoff = lds_byte(wr * 64 + fr, fq * 8), boff = lds_byte(wc * 32 + fr, fq * 8);
#define PG8_SA(b, h) (((b) * 2 + (h)) * HTB)
#define PG8_SB(b, h) ((4 + (b) * 2 + (h)) * HTB)
#define PG8_STAGE(bufoff, gbase, voff) do { _Pragma("unroll") for (int _i = 0; _i < 2; ++_i) \
        __builtin_amdgcn_global_load_lds((const unsigned*)((const char*)(gbase) + (voff)[_i]), (LAS unsigned*)(lds + (bufoff) + ldsw + _i * 8192), 16, 0, 0); } while (0)
#define PG8_LDA(dst, b, h) do { _Pragma("unroll") for (int m = 0; m < 4; ++m) _Pragma("unroll") for (int k = 0; k < 2; ++k) dst[m][k] = *(const LAS bf16x8*)(lds + PG8_SA(b, h) + aoff + m * 2048 + k * 1024); } while (0)
#define PG8_LDB(dst, b, h) do { _Pragma("unroll") for (int n = 0; n < 2; ++n) _Pragma("unroll") for (int k = 0; k < 2; ++k) dst[n][k] = *(const LAS bf16x8*)(lds + PG8_SB(b, h) + boff + n * 2048 + k * 1024); } while (0)
#define PG8_MMA(ai, bj, At, Bt) do { __builtin_amdgcn_s_setprio(1); _Pragma("unroll") for (int m = 0; m < 4; ++m) _Pragma("unroll") for (int n = 0; n < 2; ++n) _Pragma("unroll") for (int k = 0; k < 2; ++k) \
        acc[ai][bj][m][n] = __builtin_amdgcn_mfma_f32_16x16x32_bf16(Bt[n][k], At[m][k], acc[ai][bj][m][n], 0, 0, 0); __builtin_amdgcn_s_setprio(0); } while (0)
#define PG8_WAIT_V(n) asm volatile("s_waitcnt vmcnt(" #n ")" ::: "memory")
#define PG8_WAIT_L(n) asm volatile("s_waitcnt lgkmcnt(" #n ")" ::: "memory")
#define PG8_BAR __builtin_amdgcn_s_barrier()
#define PG8_SCHED __builtin_amdgcn_sched_barrier(0)
    Unit cur, nxt; int ui = 0;
    if (!S.next(0, cur)) return;
    f32x4 acc[2][2][4][2];
#pragma unroll
    for (int a = 0; a < 2; ++a)
#pragma unroll
        for (int b = 0; b < 2; ++b)
#pragma unroll
            for (int m = 0; m < 4; ++m)
#pragma unroll
                for (int n = 0; n < 2; ++n) acc[a][b][m][n] = (f32x4){0.f, 0.f, 0.f, 0.f};
    bf16x8 At[4][2], B0[2][2], B1[2][2];
    const char* cA = (const char*)g.A + (size_t)cur.pm * tstepA; const char* cB = (const char*)g.Bt + (size_t)cur.pn * tstepB;
    S.a_ready(cur);
    if constexpr (SP2) {
        PG8_STAGE(PG8_SB(0, 0), cB, voffB); PG8_STAGE(PG8_SB(0, 1), cB + hstepB, voffB); PG8_STAGE(PG8_SA(0, 0), cA, voffA); PG8_STAGE(PG8_SA(0, 1), cA + hstepA, voffA);
        if (wr == 1) PG8_BAR;
        PG8_WAIT_V(2); PG8_BAR;
        PG8_STAGE(PG8_SB(1, 0), cB + kstep, voffB); PG8_STAGE(PG8_SA(1, 0), cA + kstep, voffA); PG8_STAGE(PG8_SB(1, 1), cB + hstepB + kstep, voffB);
        PG8_WAIT_V(6); PG8_BAR;
    } else {
        PG8_STAGE(PG8_SB(0, 0), cB, voffB); PG8_STAGE(PG8_SA(0, 0), cA, voffA); PG8_STAGE(PG8_SB(0, 1), cB + hstepB, voffB); PG8_STAGE(PG8_SA(0, 1), cA + hstepA, voffA);
        if (wr == 1) PG8_BAR;
        PG8_WAIT_V(4); PG8_BAR;
        PG8_STAGE(PG8_SB(1, 0), cB + kstep, voffB); PG8_STAGE(PG8_SA(1, 0), cA + kstep, voffA); PG8_STAGE(PG8_SB(1, 1), cB + hstepB + kstep, voffB);
        PG8_WAIT_V(6); PG8_BAR;
    }
    for (;;) {
        const bool has_next = S.next(ui + 1, nxt);
        const char* nA = has_next ? (const char*)g.A + (size_t)nxt.pm * tstepA : cA; const char* nB = has_next ? (const char*)g.Bt + (size_t)nxt.pn * tstepB : cB;
#pragma unroll 1
        for (int t = 0; t < nt; t += 2) {
            const bool last = (t == nt - 2);
            const char* a1 = cA + (size_t)(t + 1) * kstep;
            const char* a2 = last ? nA : cA + (size_t)(t + 2) * kstep; const char* b2 = last ? nB : cB + (size_t)(t + 2) * kstep;
            const char* a3 = a2 + kstep; const char* b3 = b2 + kstep;
            if (last && has_next) S.a_ready(nxt);
            if constexpr (SP2) {
            PG8_LDB(B0, 0, 0); PG8_LDB(B1, 0, 1); PG8_SCHED; PG8_LDA(At, 0, 0); PG8_STAGE(PG8_SA(1, 1), a1 + hstepA, voffA);
            PG8_WAIT_V(8); PG8_WAIT_L(0); PG8_BAR; PG8_MMA(0, 0, At, B0); PG8_MMA(0, 1, At, B1); PG8_BAR; PG8_SCHED;
            PG8_LDA(At, 0, 1); PG8_STAGE(PG8_SB(0, 0), b2, voffB); PG8_STAGE(PG8_SB(0, 1), b2 + hstepB, voffB); PG8_STAGE(PG8_SA(0, 0), a2, voffA);
            PG8_WAIT_V(8); PG8_WAIT_L(0); PG8_BAR; PG8_MMA(1, 0, At, B0); PG8_MMA(1, 1, At, B1); PG8_BAR; PG8_SCHED;
            PG8_LDB(B0, 1, 0); PG8_LDB(B1, 1, 1); PG8_SCHED; PG8_LDA(At, 1, 0); PG8_STAGE(PG8_SA(0, 1), a2 + hstepA, voffA);
            PG8_WAIT_V(8); PG8_WAIT_L(0); PG8_BAR; PG8_MMA(0, 0, At, B0); PG8_MMA(0, 1, At, B1); PG8_BAR; PG8_SCHED;
            PG8_LDA(At, 1, 1); PG8_STAGE(PG8_SB(1, 0), b3, voffB); PG8_STAGE(PG8_SB(1, 1), b3 + hstepB, voffB); PG8_STAGE(PG8_SA(1, 0), a3, voffA);
            PG8_WAIT_V(8); PG8_WAIT_L(0); PG8_BAR; PG8_MMA(1, 0, At, B0); PG8_MMA(1, 1, At, B1); PG8_BAR; PG8_SCHED;
            } else {
            PG8_LDB(B0, 0, 0); PG8_SCHED; PG8_LDA(At, 0, 0); PG8_STAGE(PG8_SA(1, 1), a1 + hstepA, voffA);
            PG8_WAIT_L(8); PG8_BAR; PG8_WAIT_L(0); PG8_MMA(0, 0, At, B0); PG8_BAR; PG8_SCHED;
            PG8_LDB(B1, 0, 1); PG8_STAGE(PG8_SB(0, 0), b2, voffB);
            PG8_BAR; PG8_WAIT_L(0); PG8_MMA(0, 1, At, B1); PG8_BAR;
            PG8_LDA(At, 0, 1); PG8_STAGE(PG8_SA(0, 0), a2, voffA);
            PG8_BAR; PG8_WAIT_L(0); PG8_MMA(1, 0, At, B0); PG8_BAR; PG8_SCHED;
            PG8_STAGE(PG8_SB(0, 1), b2 + hstepB, voffB);
            PG8_WAIT_V(6); PG8_BAR; PG8_MMA(1, 1, At, B1); PG8_BAR;
            PG8_LDB(B0, 1, 0); PG8_SCHED; PG8_LDA(At, 1, 0); PG8_STAGE(PG8_SA(0, 1), a2 + hstepA, voffA);
            PG8_WAIT_L(8); PG8_BAR; PG8_WAIT_L(0); PG8_MMA(0, 0, At, B0); PG8_BAR; PG8_SCHED;
            PG8_LDB(B1, 1, 1); PG8_STAGE(PG8_SB(1, 0), b3, voffB);
            PG8_BAR; PG8_WAIT_L(0); PG8_MMA(0, 1, At, B1); PG8_BAR;
            PG8_LDA(At, 1, 1); PG8_STAGE(PG8_SA(1, 0), a3, voffA);
            PG8_BAR; PG8_WAIT_L(0); PG8_MMA(1, 0, At, B0); PG8_BAR; PG8_SCHED;
            PG8_STAGE(PG8_SB(1, 1), b3 + hstepB, voffB);
            PG8_WAIT_V(6); PG8_BAR; PG8_MMA(1, 1, At, B1); PG8_BAR;
            }
        }
        if constexpr (ALIGN_EPI) { if (wr == 0) PG8_BAR; }
        E(acc, cur, wr, wc, fr, fq); S.done(cur);
        if (!has_next) break;
#pragma unroll
        for (int a = 0; a < 2; ++a)
#pragma unroll
            for (int b = 0; b < 2; ++b)
#pragma unroll
                for (int m = 0; m < 4; ++m)
#pragma unroll
                    for (int n = 0; n < 2; ++n) acc[a][b][m][n] = (f32x4){0.f, 0.f, 0.f, 0.f};
        cur = nxt; cA = nA; cB = nB; ++ui;
        if constexpr (ALIGN_EPI) { if (wr == 1) PG8_BAR; }
    }
    PG8_WAIT_V(0);
    if constexpr (!ALIGN_EPI) { if (wr == 0) PG8_BAR; }
    PG8_BAR;
#undef PG8_SA
#undef PG8_SB
#undef PG8_STAGE
#undef PG8_LDA
#undef PG8_LDB
#undef PG8_MMA
#undef PG8_WAIT_V
#undef PG8_WAIT_L
#undef PG8_BAR
#undef PG8_SCHED
}
}
#define PG8_SP2 true
#define PG8_ALIGN true

struct FProj {
    bf16* mla; bf16* rw; bf16* gate;
    __device__ __forceinline__ void operator()(int row, int col, const float (&v)[8]) const {
        bf16* p;
        if (col < W_MLA) p = mla + (size_t)row * W_MLA + col;
        else if (col < W_MLA + W_RW) p = rw + (size_t)row * W_RW + (col - W_MLA);
        else p = gate + (size_t)row * W_GATE + (col - W_MLA - W_RW);
        store8(p, v);
    }
};
struct FStore {
    bf16* O; int ldc;
    __device__ __forceinline__ void operator()(int row, int col, const float (&v)[8]) const { store8(O + (size_t)row * ldc + col, v); }
};
struct FQ {
    bf16* Q; const float* rstd; const float* rc; const float* rs;
    __device__ __forceinline__ void operator()(int row, int col, const float (&v)[8]) const {
        const float s = rstd[row]; float o[8];
        const int c = col % 192;
        if (c >= 128) {
            const int j0 = ((c - 128) >> 3) * 4, pos = row & (SEQ - 1);
            const f32x4 cs = *(const f32x4*)(rc + pos * 32 + j0), sn = *(const f32x4*)(rs + pos * 32 + j0);
#pragma unroll
            for (int i = 0; i < 4; ++i) { const float x1 = v[i] * s, x2 = v[4 + i] * s; o[i] = x1 * cs[i] - x2 * sn[i]; o[4 + i] = x2 * cs[i] + x1 * sn[i]; }
        } else {
#pragma unroll
            for (int i = 0; i < 8; ++i) o[i] = v[i] * s;
        }
        store8(Q + (size_t)row * QW + col, o);
    }
};
struct FKV {
    bf16* KF; bf16* V; const float* rstd;
    __device__ __forceinline__ void operator()(int row, int col, const float (&v)[8]) const {
        const float s = rstd[row]; float o[8];
#pragma unroll
        for (int i = 0; i < 8; ++i) o[i] = v[i] * s;
        const int hh = col >> 8, w = col & 255;
        bf16* p = (w < 128) ? KF + (size_t)row * KFW + hh * 192 + w : V + (size_t)row * VW + hh * 128 + (w - 128);
        store8(p, o);
    }
};
struct FLora {
    bf16* O; const float* w0; const float* a0; int col0;
    __device__ __forceinline__ void operator()(int row, int colr, const float (&v)[8]) const {
        float o[8]; const int col = colr + col0;
        if (col < 4096) {
            const float* b = (col < 2048) ? w0 + col : a0 + (col - 2048);
            const f32x4 b0 = *(const f32x4*)b, b1 = *(const f32x4*)(b + 4);
#pragma unroll
            for (int i = 0; i < 4; ++i) { o[i] = sigmoidf_(v[i] + b0[i]); o[4 + i] = sigmoidf_(v[4 + i] + b1[i]); }
        } else {
#pragma unroll
            for (int i = 0; i < 8; ++i) o[i] = v[i];
        }
        store8(O + (size_t)row * LORA_N + col, o);
    }
};
struct FMergeA {
    bf16* MG; const bf16* gate;
    __device__ __forceinline__ void operator()(int row, int col, const float (&v)[8]) const {
        float gt[8], o[8]; load8(gate + (size_t)row * W_GATE + col, gt);
#pragma unroll
        for (int i = 0; i < 8; ++i) o[i] = sigmoidf_(gt[i]) * v[i];
        store8(MG + (size_t)row * DM + col, o);
    }
};
struct FMergeB {
    bf16* MG; const bf16* gate;
    __device__ __forceinline__ void operator()(int row, int col, const float (&v)[8]) const {
        float gt[8], o[8], m[8]; load8(gate + (size_t)row * W_GATE + DM + col, gt); load8(MG + (size_t)row * DM + col, m);
#pragma unroll
        for (int i = 0; i < 8; ++i) o[i] = m[i] + sigmoidf_(gt[i]) * v[i];
        store8(MG + (size_t)row * DM + col, o);
    }
};
struct FResid {
    const float* xin; float* out; const float* gt;
    __device__ __forceinline__ void operator()(int row, int col, const float (&v)[8]) const {
        const float* gp = gt + (size_t)(row >> 12) * NMOD + col;
        const f32x4 g0 = *(const f32x4*)gp, g1 = *(const f32x4*)(gp + 4);
        const float* xp = xin + (size_t)row * DM + col;
        const f32x4 x0 = *(const f32x4*)xp, x1 = *(const f32x4*)(xp + 4);
        f32x4 o0, o1;
#pragma unroll
        for (int i = 0; i < 4; ++i) { o0[i] = x0[i] + g0[i] * v[i]; o1[i] = x1[i] + g1[i] * v[4 + i]; }
        float* op = out + (size_t)row * DM + col;
        *(f32x4*)op = o0; *(f32x4*)(op + 4) = o1;
    }
};

__device__ __forceinline__ float dpp_shr1(float x) { return __builtin_bit_cast(float, __builtin_amdgcn_update_dpp(0, __builtin_bit_cast(int, x), 0x111, 0xF, 0xF, true)); }
__device__ __forceinline__ float dpp_shl1(float x) { return __builtin_bit_cast(float, __builtin_amdgcn_update_dpp(0, __builtin_bit_cast(int, x), 0x101, 0xF, 0xF, true)); }
struct EpiAct {
    static constexpr bool PERM = true, AFTER_DRAIN = false;
    bf16* ACT; bf16* EA; bf16* EB; const float* cw; const float* cb;
    __device__ __forceinline__ void operator()(const f32x4 (&acc)[2][2][4][2], const pg8::Unit& u, int wr, int wc, int fr, int fq) const {
        const int j0 = u.pn * 128 + wc * 32 + 8 * fq;
        float w0[8], w1[8], w2[8], bb[8];
#pragma unroll
        for (int h = 0; h < 2; ++h) { const f32x4 x0 = *(const f32x4*)(cw + j0 + 4 * h), x1 = *(const f32x4*)(cw + DFF + j0 + 4 * h), x2 = *(const f32x4*)(cw + 2 * DFF + j0 + 4 * h), x3 = *(const f32x4*)(cb + j0 + 4 * h);
#pragma unroll
            for (int i = 0; i < 4; ++i) { w0[4 * h + i] = x0[i]; w1[4 * h + i] = x1[i]; w2[4 * h + i] = x2[i]; bb[4 * h + i] = x3[i]; } }
#pragma unroll
        for (int ai = 0; ai < 2; ++ai) {
            float av[4][8], bv[4][8];
#pragma unroll
            for (int m = 0; m < 4; ++m)
#pragma unroll
                for (int i = 0; i < 4; ++i) { av[m][i] = acc[ai][0][m][0][i]; av[m][4 + i] = acc[ai][0][m][1][i]; bv[m][i] = acc[ai][1][m][0][i]; bv[m][4 + i] = acc[ai][1][m][1][i]; }
            float ap[8], an[8];
#pragma unroll
            for (int i = 0; i < 8; ++i) { ap[i] = dpp_shr1(av[3][i]); an[i] = dpp_shl1(av[0][i]); }
            const int blk = ai * 2 + wr; const size_t tok0 = (size_t)u.pm * 256 + blk * 64 + 4 * fr;
#pragma unroll
            for (int m = 0; m < 4; ++m) {
                float o[8];
#pragma unroll
                for (int i = 0; i < 8; ++i) { const float xm = (m == 0) ? ap[i] : av[m == 0 ? 0 : m - 1][i], xp = (m == 3) ? an[i] : av[m == 3 ? 3 : m + 1][i];
                    const float c = w0[i] * xm + w1[i] * av[m][i] + w2[i] * xp + bb[i]; o[i] = c * sigmoidf_(c) * bv[m][i]; }
                store8(ACT + (tok0 + m) * DFF + j0, o);
            }
            const size_t eb = ((size_t)u.pm * 4 + blk);
            if (fr == 0) { store8(EA + (eb * 4 + 0) * DFF + j0, av[0]); store8(EA + (eb * 4 + 1) * DFF + j0, av[1]); store8(EB + (eb * 2 + 0) * DFF + j0, bv[0]); }
            if (fr == 15) { store8(EA + (eb * 4 + 2) * DFF + j0, av[2]); store8(EA + (eb * 4 + 3) * DFF + j0, av[3]); store8(EB + (eb * 2 + 1) * DFF + j0, bv[3]); }
            asm volatile("" ::: "memory");
        }
    }
};

namespace att {
constexpr int DQK = 192, DV = 128, NW = 8, QBLK = 32, KVBLK = 64;
constexpr float SCALE = 0.07216878364870322f;
constexpr float THR = 8.f;
constexpr int LDQ = QW, LDK = KFW, LDV = VW, LDO = 1024;
constexpr int SHM_V = KVBLK * DV * 2, SHM_K = KVBLK * DQK * 2, SHM_ATTN = 2 * SHM_V + 2 * SHM_K + NW * 64 * 4;
#define KSWZ(row, colB) ((row) * 384 + ((colB) ^ (((row) & 7) << 4)))
#define SBAR() __builtin_amdgcn_sched_barrier(0)
__device__ __forceinline__ int crow(int r, int hi) { return (r & 3) + 8 * (r >> 2) + 4 * hi; }
__device__ __forceinline__ void partialSM(f32x16& p0, f32x16& p1, float& m_reg, float& mn, float& alpha) {
    constexpr float C = SCALE * 1.4426950408889634f;
    float pmax = p0[0];
#pragma unroll
    for (int r = 1; r < 16; ++r) pmax = fmaxf(pmax, p0[r]);
#pragma unroll
    for (int r = 0; r < 16; ++r) pmax = fmaxf(pmax, p1[r]);
    { auto rr = __builtin_amdgcn_permlane32_swap(__float_as_uint(pmax), __float_as_uint(pmax), false, false);
      pmax = fmaxf(__uint_as_float(rr[0]), __uint_as_float(rr[1])); }
    if (__builtin_expect(__all(pmax - m_reg <= THR / SCALE), 1)) { mn = m_reg; alpha = 1.f; }
    else { mn = fmaxf(m_reg, pmax); alpha = __builtin_amdgcn_exp2f((m_reg - mn) * C); m_reg = mn; }
    const float mnC = -mn * C;
#pragma unroll
    for (int r = 0; r < 16; ++r) p0[r] = fmaf(p0[r], C, mnC);
#pragma unroll
    for (int r = 0; r < 16; ++r) p1[r] = fmaf(p1[r], C, mnC);
#pragma unroll
    for (int r = 0; r < 16; ++r) p0[r] = __builtin_amdgcn_exp2f(p0[r]);
}
__device__ __forceinline__ void finishSM(f32x16& p0, f32x16& p1, float alpha, float& l_reg, bf16x8& pa0, bf16x8& pa1, bf16x8& pa2, bf16x8& pa3) {
#pragma unroll
    for (int r = 0; r < 16; ++r) p1[r] = __builtin_amdgcn_exp2f(p1[r]);
    float ps = 0;
#pragma unroll
    for (int r = 0; r < 16; ++r) ps += p0[r];
#pragma unroll
    for (int r = 0; r < 16; ++r) ps += p1[r];
    { auto rr = __builtin_amdgcn_permlane32_swap(__float_as_uint(ps), __float_as_uint(ps), false, false);
      ps = __uint_as_float(rr[0]) + __uint_as_float(rr[1]); }
    l_reg = l_reg * alpha + ps;
#define PK4(P, BASE, OUT) do { unsigned a0 = cvt_pk_bf16(P[BASE + 0], P[BASE + 1]), a1 = cvt_pk_bf16(P[BASE + 2], P[BASE + 3]);   \
    unsigned b0 = cvt_pk_bf16(P[BASE + 4], P[BASE + 5]), b1 = cvt_pk_bf16(P[BASE + 6], P[BASE + 7]);                              \
    auto r0 = __builtin_amdgcn_permlane32_swap(a0, b0, false, false); auto r1 = __builtin_amdgcn_permlane32_swap(a1, b1, false, false); \
    u32x4 w = {r0[0], r1[0], r0[1], r1[1]}; OUT = __builtin_bit_cast(bf16x8, w); } while (0)
    PK4(p0, 0, pa0); PK4(p0, 8, pa1); PK4(p1, 0, pa2); PK4(p1, 8, pa3);
#undef PK4
}
__device__ __forceinline__ void qkt(f32x16& p0, f32x16& p1, const LAS char* Ks, const bf16x8* qr, int r32, int hi) {
    p0 = f32x16{}; p1 = f32x16{};
#pragma unroll
    for (int d0 = 0; d0 < 12; ++d0) { const int cb = (d0 * 16 + hi * 8) * 2;
        const bf16x8 b0 = *(const LAS bf16x8*)(Ks + KSWZ(r32, cb));
        const bf16x8 b1 = *(const LAS bf16x8*)(Ks + KSWZ(32 + r32, cb));
        p0 = __builtin_amdgcn_mfma_f32_32x32x16_bf16(b0, qr[d0], p0, 0, 0, 0);
        p1 = __builtin_amdgcn_mfma_f32_32x32x16_bf16(b1, qr[d0], p1, 0, 0, 0); }
}
__device__ __forceinline__ int v_st(int k, int c) { const int kk = (k & ~0xC) | ((k & 4) << 1) | ((k & 8) >> 1); return ((kk >> 3) * 4 + (c >> 5)) * 512 + ((kk & 7) * 32 + (c & 31)) * 2; }
__device__ __forceinline__ int v_rd_base(int lane) { return ((lane & 3) << 3) | (((lane >> 2) & 3) << 6) | (((lane >> 4) & 1) << 5) | (((lane >> 5) & 1) << 8); }
constexpr int v_rd_off(int d0, int ks, int half) { return d0 * 512 + ks * 4096 + half * 2048; }
template <int OFF> __device__ __forceinline__ s16x4 tr_read(int vb) {
    s16x4 r; asm volatile("ds_read_b64_tr_b16 %0, %1 offset:%2" : "=&v"(r) : "v"(vb), "i"(OFF) : "memory"); return r;
}
template <int D0> __device__ __forceinline__ void pv_one(f32x16& od, int vb, bf16x8 pa0, bf16x8 pa1, bf16x8 pa2, bf16x8 pa3) {
    const s16x4 l0 = tr_read<v_rd_off(D0, 0, 0)>(vb), h0 = tr_read<v_rd_off(D0, 0, 1)>(vb), l1 = tr_read<v_rd_off(D0, 1, 0)>(vb), h1 = tr_read<v_rd_off(D0, 1, 1)>(vb);
    const s16x4 l2 = tr_read<v_rd_off(D0, 2, 0)>(vb), h2 = tr_read<v_rd_off(D0, 2, 1)>(vb), l3 = tr_read<v_rd_off(D0, 3, 0)>(vb), h3 = tr_read<v_rd_off(D0, 3, 1)>(vb);
    asm volatile("s_waitcnt lgkmcnt(0)" ::: "memory"); SBAR();
#define PK(L, H) (bf16x8){L[0], L[1], L[2], L[3], H[0], H[1], H[2], H[3]}
    od = __builtin_amdgcn_mfma_f32_32x32x16_bf16(pa0, PK(l0, h0), od, 0, 0, 0);
    od = __builtin_amdgcn_mfma_f32_32x32x16_bf16(pa1, PK(l1, h1), od, 0, 0, 0);
    od = __builtin_amdgcn_mfma_f32_32x32x16_bf16(pa2, PK(l2, h2), od, 0, 0, 0);
    od = __builtin_amdgcn_mfma_f32_32x32x16_bf16(pa3, PK(l3, h3), od, 0, 0, 0);
#undef PK
}
__device__ __forceinline__ void pv_d0(f32x16* o, int vb, bf16x8 pa0, bf16x8 pa1, bf16x8 pa2, bf16x8 pa3) {
    pv_one<0>(o[0], vb, pa0, pa1, pa2, pa3); pv_one<1>(o[1], vb, pa0, pa1, pa2, pa3); pv_one<2>(o[2], vb, pa0, pa1, pa2, pa3); pv_one<3>(o[3], vb, pa0, pa1, pa2, pa3);
}
__device__ __forceinline__ void attn_unit(const bf16* __restrict__ Qb, const bf16* __restrict__ Kh, const bf16* __restrict__ Vh, bf16* __restrict__ Ob, int seq, LAS char* lds) {
    const int tid = threadIdx.x, wid = tid >> 6, lane = tid & 63, r32 = lane & 31, hi = lane >> 5;
    LAS char* V_lds = lds; LAS char* K_lds = lds + 2 * SHM_V;
    LAS float* ws = (LAS float*)(lds + 2 * SHM_V + 2 * SHM_K) + wid * 64; LAS float* li_l = ws; LAS float* al_l = ws + 32;
    float m_reg = -1e30f, l_reg = 0; f32x16 o[4] = {}; bf16x8 qr[12];
    const bf16* Qw = Qb + (long)(wid * QBLK + r32) * LDQ + hi * 8;
#pragma unroll
    for (int d0 = 0; d0 < 12; ++d0) qr[d0] = *(const bf16x8*)(Qw + d0 * 16);
    const int sr = tid >> 4, sc = (tid & 15) * 8, vst0 = v_st(sr, sc), vst1 = v_st(32 + sr, sc);
    const int krow0 = tid >> 3, kch0 = tid & 7;
    const int vb0 = (int)(unsigned)(uintptr_t)V_lds + v_rd_base(lane);
    bf16x8 vs0, vs1, ks0, ks1, ks2;
#define SLOAD(k0) do { vs0 = *(const bf16x8*)(&Vh[(long)((k0) + sr) * LDV + sc]); vs1 = *(const bf16x8*)(&Vh[(long)((k0) + 32 + sr) * LDV + sc]); \
    { const bf16* kp_ = &Kh[(long)((k0) + krow0) * LDK + kch0 * 8]; ks0 = *(const bf16x8*)kp_; ks1 = *(const bf16x8*)(kp_ + 64); ks2 = *(const bf16x8*)(kp_ + 128); } } while (0)
#define SWRITE(b) do { *(LAS bf16x8*)(V_lds + (b) * SHM_V + vst0) = vs0; *(LAS bf16x8*)(V_lds + (b) * SHM_V + vst1) = vs1; \
    *(LAS bf16x8*)(K_lds + (b) * SHM_K + KSWZ(krow0, kch0 * 16)) = ks0; *(LAS bf16x8*)(K_lds + (b) * SHM_K + KSWZ(krow0, (kch0 + 8) * 16)) = ks1; \
    *(LAS bf16x8*)(K_lds + (b) * SHM_K + KSWZ(krow0, (kch0 + 16) * 16)) = ks2; } while (0)
#define RESC(a) do { if (__any((a) < 1.f)) { if (hi == 0) al_l[r32] = (a); asm volatile("s_waitcnt lgkmcnt(0)" ::: "memory"); \
    _Pragma("unroll") for (int d = 0; d < 4; ++d) _Pragma("unroll") for (int r = 0; r < 16; ++r) o[d][r] *= al_l[crow(r, hi)]; } } while (0)
    f32x16 p0, p1; float mn, al; bf16x8 pa0, pa1, pa2, pa3; const int NT = seq / KVBLK;
    SLOAD(0); VM_WAIT(); SWRITE(0); __syncthreads();
    for (int j = 0; j < NT; ++j) {
        const int b = j & 1;
        if (j + 1 < NT) SLOAD((j + 1) * KVBLK);
        SBAR(); qkt(p0, p1, K_lds + b * SHM_K, qr, r32, hi);
        partialSM(p0, p1, m_reg, mn, al);
        finishSM(p0, p1, al, l_reg, pa0, pa1, pa2, pa3); SBAR();
        RESC(al);
        pv_d0(o, vb0 + b * SHM_V, pa0, pa1, pa2, pa3);
        if (j + 1 < NT) { VM_WAIT(); SWRITE(b ^ 1); }
        __syncthreads();
    }
    if (hi == 0) li_l[r32] = l_reg; asm volatile("s_waitcnt lgkmcnt(0)" ::: "memory");
    float rli[16];
#pragma unroll
    for (int r = 0; r < 16; ++r) rli[r] = __builtin_amdgcn_rcpf(li_l[crow(r, hi)]);
    LAS char* ost = lds + wid * (QBLK * 272);
#pragma unroll
    for (int r = 0; r < 16; ++r) { const int orow = crow(r, hi);
#pragma unroll
        for (int d0 = 0; d0 < 4; ++d0) *(LAS bf16*)(ost + orow * 272 + (d0 * 32 + r32) * 2) = (bf16)(cvt_pk_bf16(o[d0][r] * rli[r], 0.f) & 0xffffu); }
    asm volatile("s_waitcnt lgkmcnt(0)" ::: "memory");
    bf16* Ow = Ob + (long)(wid * QBLK) * LDO;
#pragma unroll
    for (int i = 0; i < 8; ++i) { const int id = lane + 64 * i, orow = id >> 4, ch = id & 15;
        *(u32x4*)(Ow + (long)orow * LDO + ch * 8) = *(const LAS u32x4*)(ost + orow * 272 + ch * 16); }
    __syncthreads();
#undef SLOAD
#undef SWRITE
#undef RESC
}
}

#define XB_TMO      128
#define XB_XCNT(j)  (256  + 64 * (j))
#define XB_XSUB(j)  (1280 + 64 * (j))
#define XB_XGEN(j)  (2304 + 64 * (j))
#define XB_TOP      3328
#define XB_TOPGEN   3392
#define XCD_BAR_WORDS 3456
#define XB_SPIN_CAP (1u << 22)
__device__ __forceinline__ unsigned xb_ld(unsigned* p)              { return __hip_atomic_load(p, __ATOMIC_RELAXED, __HIP_MEMORY_SCOPE_AGENT); }
__device__ __forceinline__ unsigned xb_add(unsigned* p, unsigned v) { return __hip_atomic_fetch_add(p, v, __ATOMIC_RELAXED, __HIP_MEMORY_SCOPE_AGENT); }
__device__ __forceinline__ unsigned xb_xcc_id() { return (unsigned)__builtin_amdgcn_s_getreg((3 << 11) | 20) & 0xFu; }
#define XB_SPIN(cond, bar) do { unsigned _sp = 0; while (cond) { __builtin_amdgcn_s_sleep(1); \
    if ((++_sp & 255u) == 0u) { if (xb_ld(&(bar)[XB_TMO])) break; if (_sp > XB_SPIN_CAP) { atomicAdd(&(bar)[XB_TMO], 1u); break; } } } } while (0)
struct XcdBarrier { unsigned* bar; unsigned x; volatile LAS unsigned* st; };
__device__ __forceinline__ XcdBarrier xcd_barrier_post(unsigned* bar, volatile LAS unsigned* st) {
    XcdBarrier b; b.bar = bar; b.x = xb_xcc_id(); b.st = st;
    if (threadIdx.x == 0) (void)xb_add(&bar[XB_XCNT(b.x)], 1u);
    return b;
}
__device__ __forceinline__ void xcd_barrier_complete(unsigned* bar, unsigned x, unsigned& nloc, unsigned& nx) {
    const unsigned G = gridDim.x * gridDim.y * gridDim.z;
    unsigned sum, cnt, mine, sp = 0u;
    for (;;) {
        sum = 0u; cnt = 0u; mine = 0u;
#pragma unroll
        for (unsigned j = 0; j < 16; ++j) { const unsigned c = xb_ld(&bar[XB_XCNT(j)]); sum += c; cnt += (c > 0u) ? 1u : 0u; mine = (j == x) ? c : mine; }
        if (sum == G) break;
        __builtin_amdgcn_s_sleep(1);
        if ((++sp & 255u) == 0u) { if (xb_ld(&bar[XB_TMO])) break; if (sp > XB_SPIN_CAP) { atomicAdd(&bar[XB_TMO], 1u); break; } }
    }
    nloc = mine > 0u ? mine : 1u; nx = cnt > 0u ? cnt : 1u;
}
__device__ __forceinline__ void xcd_barrier(const XcdBarrier& b) {
    asm volatile("s_waitcnt vmcnt(0)" ::: "memory");
    __syncthreads();
    if (threadIdx.x == 0) {
        unsigned* bar = b.bar;
        __builtin_amdgcn_s_waitcnt(0);
        unsigned nloc = b.st[0], nx = b.st[1];
        if (nloc == 0u) { xcd_barrier_complete(bar, b.x, nloc, nx); b.st[0] = nloc; b.st[1] = nx; }
        const unsigned old = xb_add(&bar[XB_XSUB(b.x)], 1u);
        const unsigned gen = old / nloc;
        if (old + 1u == (gen + 1u) * nloc) {
            __builtin_amdgcn_fence(__ATOMIC_RELEASE, "agent");
            asm volatile("s_waitcnt vmcnt(0)" ::: "memory");
            const unsigned og = xb_add(&bar[XB_TOP], 1u);
            const unsigned tg = og / nx;
            if (og + 1u == (tg + 1u) * nx) xb_add(&bar[XB_TOPGEN], 1u);
            else XB_SPIN(xb_ld(&bar[XB_TOPGEN]) == tg, bar);
            __builtin_amdgcn_fence(__ATOMIC_ACQUIRE, "agent");
            xb_add(&bar[XB_XGEN(b.x)], 1u);
            asm volatile("s_waitcnt vmcnt(0)" ::: "memory");
        } else {
            XB_SPIN(xb_ld(&bar[XB_XGEN(b.x)]) == gen, bar);
            __builtin_amdgcn_fence(__ATOMIC_ACQUIRE, "agent");
            asm volatile("s_waitcnt vmcnt(0)" ::: "memory");
        }
    }
    __syncthreads();
}

struct Args {
    const float* in[32];
    float* out; unsigned char* ws;
    int lo, hi, pad0, pad1;
};
enum { I_XP = 0, I_XS, I_CP, I_CS, I_ADAW, I_ADAB, I_NMIXG, I_WIN, I_QNG, I_WUQ, I_KVNG, I_WUKV, I_WOATT, I_MU, I_W0, I_WDEC, I_A0, I_WICLR, I_WGATE,
       I_KK, I_KA, I_RK, I_GNG, I_GNB, I_WORWKV, I_WOUT, I_NFFNG, I_WUP, I_CONVW, I_CONVB, I_WDOWN, I_FNG };

constexpr int ARGTAB_OFF = MISC_OFF + 256;
struct Ctx { LAS unsigned char* lds; int tid, lane, wave, gw, ngw; };
struct PT {
    LAS unsigned char* lds; int toff;
    __device__ __forceinline__ explicit PT(const Ctx& C) { lds = C.lds; int t = ARGTAB_OFF; asm volatile("" : "+s"(t)); toff = t; }
    __device__ __forceinline__ unsigned long long raw(int i) const { const LAS unsigned* p = (const LAS unsigned*)(lds + toff) + 2 * i;
        const unsigned lo = __builtin_amdgcn_readfirstlane(p[0]), hi = __builtin_amdgcn_readfirstlane(p[1]); return ((unsigned long long)hi << 32) | lo; }
    __device__ __forceinline__ const float* in(int i) const { return (const float*)raw(i); }
    __device__ __forceinline__ float* out() const { return (float*)raw(32); }
    __device__ __forceinline__ unsigned char* ws() const { return (unsigned char*)raw(33); }
};

__device__ __forceinline__ void phase_mod(const Ctx& C) {
    const PT a(C);
    float* mod = (float*)(a.ws() + WS_MOD);
    LAS float* sil = (LAS float*)C.lds;
    for (int u = blockIdx.x; u < 192; u += gridDim.x) {
        const int cu = u % 96, kh = u / 96, l = cu / 48, n0 = (cu % 48) * 256;
        for (int i = C.tid; i < 1024 * 12; i += 512) { const int kk = i / 12, s = i % 12;
            const float c = (s < 8) ? a.in(I_CP)[s * DM + kh * 1024 + kk] : a.in(I_CS)[(s - 8) * DM + kh * 1024 + kk];
            sil[i] = c / (1.f + __expf(-c)); }
        __syncthreads();
        f32x4 acc[12];
#pragma unroll
        for (int s = 0; s < 12; ++s) acc[s] = (f32x4){0.f, 0.f, 0.f, 0.f};
        const int kb = C.wave * 128;
        const float* wp = a.in(I_ADAW) + ((size_t)l * DM + kh * 1024 + kb) * NMOD + n0 + C.lane * 4;
        for (int kk = 0; kk < 128; kk += 4) {
            f32x4 wv[4];
#pragma unroll
            for (int i = 0; i < 4; ++i) wv[i] = *(const f32x4*)(wp + (size_t)(kk + i) * NMOD);
#pragma unroll
            for (int i = 0; i < 4; ++i) {
                const LAS f32x4* sp = (const LAS f32x4*)(sil + (kb + kk + i) * 12);
                const f32x4 s0 = sp[0], s1 = sp[1], s2 = sp[2];
                acc[0] += wv[i] * s0[0]; acc[1] += wv[i] * s0[1]; acc[2] += wv[i] * s0[2]; acc[3] += wv[i] * s0[3];
                acc[4] += wv[i] * s1[0]; acc[5] += wv[i] * s1[1]; acc[6] += wv[i] * s1[2]; acc[7] += wv[i] * s1[3];
                acc[8] += wv[i] * s2[0]; acc[9] += wv[i] * s2[1]; acc[10] += wv[i] * s2[2]; acc[11] += wv[i] * s2[3];
            }
        }
        __syncthreads();
        LAS f32x4* part = (LAS f32x4*)C.lds;
#pragma unroll
        for (int s = 0; s < 12; ++s) part[(C.wave * 12 + s) * 64 + C.lane] = acc[s];
        __syncthreads();
        for (int i = C.tid; i < 12 * 64; i += 512) {
            f32x4 t = part[i];
#pragma unroll
            for (int w = 1; w < 8; ++w) t += part[w * 12 * 64 + i];
            const int s_ = i >> 6, ln = i & 63;
            if (kh == 0) t += *(const f32x4*)(a.in(I_ADAB) + (size_t)l * NMOD + n0 + ln * 4);
            float* mp = mod + ((size_t)l * 12 + s_) * NMOD + n0 + ln * 4;
#pragma unroll
            for (int j = 0; j < 4; ++j) __hip_atomic_fetch_add(mp + j, t[j], __ATOMIC_RELAXED, __HIP_MEMORY_SCOPE_AGENT);
        }
        __syncthreads();
    }
    float* rc = (float*)(a.ws() + WS_ROPE); float* rs = rc + SEQ * 32;
    for (int i = blockIdx.x * 512 + C.tid; i < SEQ * 32; i += gridDim.x * 512) {
        const int pos = i >> 5, j = i & 31;
        const double inv = 1.0 / pow(10000.0, (double)j / 32.0), ang = (double)pos * inv;
        rc[i] = (float)cos(ang); rs[i] = (float)sin(ang);
    }
}

constexpr f32x4 ZERO4 = {0.f, 0.f, 0.f, 0.f};
template <class Get> __device__ __forceinline__ void tr_tile(const Get& get, bf16* WT, int ldt, int n0, int k0, LAS float* T, int tid) {
    const int n4 = (tid & 63) * 4, kq = tid >> 6;
    f32x4 v[8];
#pragma unroll
    for (int i = 0; i < 8; ++i) v[i] = get.get4(n0 + n4, k0 + kq + 8 * i);
#pragma unroll
    for (int i = 0; i < 8; ++i) *(LAS f32x4*)(T + (kq + 8 * i) * 260 + n4) = v[i];
    __syncthreads();
    const int n = tid >> 1, kh = (tid & 1) * 32;
#pragma unroll
    for (int j = 0; j < 4; ++j) { const LAS float* t = T + (kh + 8 * j) * 260 + n;
        u32x4 o; o.x = cvt_pk_bf16(t[0], t[260]); o.y = cvt_pk_bf16(t[2 * 260], t[3 * 260]); o.z = cvt_pk_bf16(t[4 * 260], t[5 * 260]); o.w = cvt_pk_bf16(t[6 * 260], t[7 * 260]);
        *(u32x4*)(WT + (size_t)(n0 + n) * ldt + k0 + kh + 8 * j) = o; }
    __syncthreads();
}
struct GetPlain { const float* W; int ldw; __device__ __forceinline__ f32x4 get4(int n, int k) const { return *(const f32x4*)(W + (size_t)k * ldw + n); } };
struct GetWin { const float* W; __device__ __forceinline__ f32x4 get4(int n, int k) const {
    int s;
    if (n < 832) s = n; else if (n < W_MLA) s = -1; else if (n < W_MLA + RWIN) s = 832 + (n - W_MLA); else if (n < W_MLA + W_RW) s = -1; else s = 4320 + (n - W_MLA - W_RW);
    return s < 0 ? ZERO4 : *(const f32x4*)(W + (size_t)k * DIN + s); } };
struct GetUq { const float* W; const float* g; __device__ __forceinline__ f32x4 get4(int n, int k) const {
    const int hh = n / 192, c = n % 192; int s;
    if (c < 128) s = hh * 192 + c; else { const int p = c - 128, grp = p >> 3, w = p & 7; s = hh * 192 + 128 + (w >> 2) * 32 + grp * 4; }
    return *(const f32x4*)(W + (size_t)k * QW + s) * g[k]; } };
struct GetUp { const float* W; __device__ __forceinline__ f32x4 get4(int n, int k) const {
    const int t = n >> 8, w = n & 255; const int sc = (w < 128) ? t * 128 + w : DFF + t * 128 + (w - 128); return *(const f32x4*)(W + (size_t)k * (2 * DFF) + sc); } };
struct GetUkv { const float* W; const float* g; __device__ __forceinline__ f32x4 get4(int n, int k) const { return *(const f32x4*)(W + (size_t)k * 2048 + n) * g[k]; } };
struct GetLora { const float* wdec; const float* wiclr; const float* wgate;
    __device__ __forceinline__ f32x4 get4(int n, int k) const {
        if (n < 2048) { const int d = n >> 10, c = n & 1023, kk = k - d * 64; return (kk >= 0 && kk < 64) ? *(const f32x4*)(wdec + ((size_t)d * 64 + kk) * 1024 + c) : ZERO4; }
        if (n < 4096) { const int d = (n - 2048) >> 10, c = n & 1023, kk = k - 128 - d * 64; return (kk >= 0 && kk < 64) ? *(const f32x4*)(wiclr + ((size_t)d * 64 + kk) * 1024 + c) : ZERO4; }
        const int c = n - 4096; return (k < 160) ? *(const f32x4*)(wgate + (size_t)k * 1024 + c) : ZERO4; } };

__device__ __forceinline__ void phase_convert(const Ctx& C, int l) {
    const PT a(C);
    LAS float* T = (LAS float*)C.lds;
    bf16* wb = (bf16*)(a.ws() + WS_W);
    constexpr int I0 = (NPROJ / 256) * (DM / 64), I1 = (QW / 256) * (512 / 64), I2 = (2048 / 256) * (256 / 64), I3 = (DM / 256) * (1024 / 64), I4 = I3,
                  I5 = (DM / 256) * (DM / 64), I6 = (2 * DFF / 256) * (DM / 64), I7 = (DM / 256) * (DFF / 64), I8 = (LORA_N / 256) * (LORA_KB / 64);
    constexpr int NIT = I0 + I1 + I2 + I3 + I4 + I5 + I6 + I7 + I8;
    for (int it = blockIdx.x; it < NIT; it += gridDim.x) {
        int r = it;
#define ITEM(CNT, GET, OFF, KD) if (r < (CNT)) { const int nblk_k = (KD) / 64; const int nb = r / nblk_k, kb = r % nblk_k; tr_tile(GET, (bf16*)((char*)wb + (OFF)), (KD), nb * 256, kb * 64, T, C.tid); continue; } r -= (CNT);
        ITEM(I0, (GetWin{a.in(I_WIN) + (size_t)l * DM * DIN}), WO_IN, DM)
        ITEM(I1, (GetUq{a.in(I_WUQ) + (size_t)l * 512 * QW, a.in(I_QNG) + l * 512}), WO_UQ, 512)
        ITEM(I2, (GetUkv{a.in(I_WUKV) + (size_t)l * 256 * 2048, a.in(I_KVNG) + l * 256}), WO_UKV, 256)
        ITEM(I3, (GetPlain{a.in(I_WOATT) + (size_t)l * 1024 * DM, DM}), WO_OATT, 1024)
        ITEM(I4, (GetPlain{a.in(I_WORWKV) + (size_t)l * 1024 * DM, DM}), WO_ORWKV, 1024)
        ITEM(I5, (GetPlain{a.in(I_WOUT) + (size_t)l * DM * DM, DM}), WO_OUT, DM)
        ITEM(I6, (GetUp{a.in(I_WUP) + (size_t)l * DM * 2 * DFF}), WO_UP, DM)
        ITEM(I7, (GetPlain{a.in(I_WDOWN) + (size_t)l * DFF * DM, DM}), WO_DOWN, DFF)
        ITEM(I8, (GetLora{a.in(I_WDEC) + (size_t)l * 2 * 64 * 1024, a.in(I_WICLR) + (size_t)l * 2 * 64 * 1024, a.in(I_WGATE) + (size_t)l * 160 * 1024}), WO_LORA, LORA_KB)
#undef ITEM
    }
}

__device__ __forceinline__ void phase_modnorm(const Ctx& C, int gw, int ngw, const float* xsrc, bf16* H, const float* g, const float* modb, int ksh, int ksc) {
    const int per = GROWS / ngw, r0 = gw * per;
    const float* mb = modb + (size_t)(r0 >> 12) * NMOD;
    f32x4 gm[8], sh[8];
#pragma unroll
    for (int j = 0; j < 8; ++j) { const int c = 256 * j + 4 * C.lane; const f32x4 gg = *(const f32x4*)(g + c), sc = *(const f32x4*)(mb + ksc * DM + c); sh[j] = *(const f32x4*)(mb + ksh * DM + c);
#pragma unroll
        for (int i = 0; i < 4; ++i) gm[j][i] = gg[i] * (1.f + sc[i]); }
    for (int row = r0; row < r0 + per; row += 2) {
        f32x4 v[2][8];
#pragma unroll
        for (int k = 0; k < 2; ++k)
#pragma unroll
            for (int j = 0; j < 8; ++j) v[k][j] = *(const f32x4*)(xsrc + (size_t)(row + k) * DM + 256 * j + 4 * C.lane);
#pragma unroll
        for (int k = 0; k < 2; ++k) {
            float ss = 0.f;
#pragma unroll
            for (int j = 0; j < 8; ++j) ss += (v[k][j][0] * v[k][j][0] + v[k][j][1] * v[k][j][1]) + (v[k][j][2] * v[k][j][2] + v[k][j][3] * v[k][j][3]);
            const float rstd = rsqrtf(wave_sum(ss) * (1.f / DM) + 1e-6f);
#pragma unroll
            for (int j = 0; j < 8; ++j) { const int c = 256 * j + 4 * C.lane;
                f32x4 y;
#pragma unroll
                for (int i = 0; i < 4; ++i) y[i] = v[k][j][i] * rstd * gm[j][i] + sh[j][i];
                u32x2 w; w.x = cvt_pk_bf16(y[0], y[1]); w.y = cvt_pk_bf16(y[2], y[3]);
                *(u32x2*)(H + (size_t)(row + k) * DM + c) = w; }
        }
    }
}
__device__ __forceinline__ void phase_final(const Ctx& C, int gw, int ngw, int row_lo, int row_hi, float* out, const float* g) {
    f32x4 gv[8];
#pragma unroll
    for (int j = 0; j < 8; ++j) gv[j] = *(const f32x4*)(g + 256 * j + 4 * C.lane);
    for (int row = row_lo + gw; row < row_hi; row += 2 * ngw) {
        const int row2 = row + ngw; const bool two = row2 < row_hi;
        float* xr[2] = {out + (size_t)row * DM, out + (size_t)(two ? row2 : row) * DM};
        f32x4 v[2][8];
#pragma unroll
        for (int k = 0; k < 2; ++k)
#pragma unroll
            for (int j = 0; j < 8; ++j) v[k][j] = *(const f32x4*)(xr[k] + 256 * j + 4 * C.lane);
#pragma unroll
        for (int k = 0; k < 2; ++k) {
            if (k == 1 && !two) break;
            float ss = 0.f;
#pragma unroll
            for (int j = 0; j < 8; ++j) ss += (v[k][j][0] * v[k][j][0] + v[k][j][1] * v[k][j][1]) + (v[k][j][2] * v[k][j][2] + v[k][j][3] * v[k][j][3]);
            const float rstd = rsqrtf(wave_sum(ss) * (1.f / DM) + 1e-6f);
#pragma unroll
            for (int j = 0; j < 8; ++j) { const int c = 256 * j + 4 * C.lane;
                f32x4 y;
#pragma unroll
                for (int i = 0; i < 4; ++i) y[i] = v[k][j][i] * rstd * gv[j][i];
                *(f32x4*)(xr[k] + c) = y; }
        }
    }
}
__device__ __forceinline__ void phase_prep(const Ctx& C, int l) {
    const PT a(C);
    const bf16* PRW = (const bf16*)(a.ws() + A_PRW); const bf16* PMLA = (const bf16*)(a.ws() + A_PMLA);
    bf16* AL = (bf16*)(a.ws() + A_ALORA); bf16* KF = (bf16*)(a.ws() + A_KF);
    float* rstd_q = (float*)(a.ws() + WS_RSTD); float* rstd_kv = rstd_q + GROWS;
    const float* rc = (const float*)(a.ws() + WS_ROPE); const float* rs = rc + SEQ * 32;
    const float* mu0 = a.in(I_MU) + (size_t)l * 2 * RWIN; const float* mu1 = mu0 + RWIN;
    const int lane = C.lane;
    constexpr int RB = 8, NU = GROWS / RB;
    for (int u = C.gw; u < NU; u += C.ngw) {
        const int r0 = u * RB, t0 = r0 & (SEQ - 1), c0 = (384 + lane) * 8;
        const bool act = lane < 52;
        float m0[8], m1[8];
#pragma unroll
        for (int i = 0; i < 8; ++i) { m0[i] = 0.f; m1[i] = 0.f; }
        if (act) {
#pragma unroll
            for (int h = 0; h < 2; ++h) { const f32x4 x0 = *(const f32x4*)(mu0 + c0 + 4 * h), x1 = *(const f32x4*)(mu1 + c0 + 4 * h);
#pragma unroll
                for (int i = 0; i < 4; ++i) { m0[4 * h + i] = x0[i]; m1[4 * h + i] = x1[i]; } }
        }
        const bf16* xr = PRW + (size_t)r0 * W_RW + c0;
        u32x4 rwn[RB + 2];
        rwn[0] = (u32x4){0u, 0u, 0u, 0u}; rwn[RB + 1] = (u32x4){0u, 0u, 0u, 0u};
        if (t0 > 0) rwn[0] = *(const u32x4*)(xr - W_RW);
#pragma unroll
        for (int r = 0; r < RB; ++r) rwn[r + 1] = *(const u32x4*)(xr + (size_t)r * W_RW);
        if (t0 + RB < SEQ) rwn[RB + 1] = *(const u32x4*)(xr + (size_t)RB * W_RW);
#pragma unroll
        for (int r = 0; r < RB; ++r) {
            const int row = r0 + r;
            float xp[8], x[8], xn[8], p[8], o[8];
            unpack8(rwn[r], xp); unpack8(rwn[r + 1], x); unpack8(rwn[r + 2], xn);
#pragma unroll
            for (int i = 0; i < 8; ++i) p[i] = x[i] + m0[i] * (xp[i] - x[i]) + m1[i] * (xn[i] - x[i]);
            if (lane < 16) {
#pragma unroll
                for (int i = 0; i < 8; ++i) o[i] = tanhf(p[i]);
                store8(AL + (size_t)row * LORA_K + lane * 8, o);
            } else if (lane < 32) { store8(AL + (size_t)row * LORA_K + 128 + (lane - 16) * 8, p); }
            else if (lane < 52) {
#pragma unroll
                for (int i = 0; i < 8; ++i) o[i] = sigmoidf_(p[i]);
                store8(AL + (size_t)row * LORA_K + 256 + (lane - 32) * 8, o);
            } else {
#pragma unroll
                for (int i = 0; i < 8; ++i) o[i] = 0.f;
                store8(AL + (size_t)row * LORA_K + 416 + (lane - 52) * 8, o);
            }
        }
    }
    for (int row0 = C.gw * 4; row0 < GROWS; row0 += C.ngw * 4) {
        u32x4 qv[4], kv4[4]; u32x2 w1[4], w2[4];
#pragma unroll
        for (int j = 0; j < 4; ++j) { const bf16* mr = PMLA + (size_t)(row0 + j) * W_MLA;
            qv[j] = *(const u32x4*)(mr + lane * 8); kv4[j] = *(const u32x4*)(mr + 512 + (lane & 31) * 8);
            w1[j] = *(const u32x2*)(mr + 768 + 4 * (lane & 7)); w2[j] = *(const u32x2*)(mr + 800 + 4 * (lane & 7)); }
#pragma unroll
        for (int j = 0; j < 4; ++j) {
            const int row = row0 + j, t = row & (SEQ - 1);
            { float q[8]; unpack8(qv[j], q); float ss = 0.f;
#pragma unroll
              for (int i = 0; i < 8; ++i) ss += q[i] * q[i];
              ss = wave_sum(ss); if (lane == 0) rstd_q[row] = rsqrtf(ss * (1.f / 512.f) + 1e-6f); }
            { float q[8]; unpack8(kv4[j], q); float ss = 0.f;
#pragma unroll
              for (int i = 0; i < 8; ++i) ss += q[i] * q[i];
              ss = wave_sum(lane < 32 ? ss : 0.f); if (lane == 0) rstd_kv[row] = rsqrtf(ss * (1.f / 256.f) + 1e-6f); }
            if (lane < 8) {
                const float x1[4] = {bf_lo(w1[j].x), bf_hi(w1[j].x), bf_lo(w1[j].y), bf_hi(w1[j].y)}, x2[4] = {bf_lo(w2[j].x), bf_hi(w2[j].x), bf_lo(w2[j].y), bf_hi(w2[j].y)};
                const f32x4 cs = *(const f32x4*)(rc + t * 32 + 4 * lane), sn = *(const f32x4*)(rs + t * 32 + 4 * lane);
                float o[8];
#pragma unroll
                for (int i = 0; i < 4; ++i) { o[i] = x1[i] * cs[i] - x2[i] * sn[i]; o[4 + i] = x2[i] * cs[i] + x1[i] * sn[i]; }
                const u32x4 pk = pack8(o);
#pragma unroll
                for (int hh = 0; hh < 8; ++hh) *(u32x4*)(KF + (size_t)row * KFW + hh * 192 + 128 + 8 * lane) = pk;
            }
        }
    }
}
__device__ __forceinline__ void phase_rwkv_post(const Ctx& C, int l) {
    const PT a(C);
    const bf16* OF = (const bf16*)(a.ws() + A_OF); const bf16* OB = (const bf16*)(a.ws() + A_OB); const bf16* PRW = (const bf16*)(a.ws() + A_PRW);
    const float* mu0 = a.in(I_MU) + (size_t)l * 2 * RWIN + 2048; const float* mu1 = mu0 + RWIN;
    const bf16* LO = (const bf16*)(a.ws() + A_LORAOUT); bf16* RO = (bf16*)(a.ws() + A_RWKVO);
    const float* bonus = (const float*)(a.ws() + WS_BONUS);
    const float* gng = a.in(I_GNG) + l * 1024; const float* gnb = a.in(I_GNB) + l * 1024;
    const int lane = C.lane;
    f32x4 maK[2], mbK[2], naK[2], nbK[2], g0K[2], g1K[2], b0K[2], b1K[2];
#pragma unroll
    for (int it = 0; it < 2; ++it) { const int c0 = (it * 64 + lane) * 8;
        maK[it] = *(const f32x4*)(mu0 + c0); mbK[it] = *(const f32x4*)(mu0 + c0 + 4); naK[it] = *(const f32x4*)(mu1 + c0); nbK[it] = *(const f32x4*)(mu1 + c0 + 4);
        g0K[it] = *(const f32x4*)(gng + c0); g1K[it] = *(const f32x4*)(gng + c0 + 4); b0K[it] = *(const f32x4*)(gnb + c0); b1K[it] = *(const f32x4*)(gnb + c0 + 4); }
    for (int row = C.gw; row < GROWS; row += C.ngw) {
        const int t = row & (SEQ - 1);
        u32x4 ofv[2], obv[2], xv[2], xpv[2], xnv[2], ggv[2]; float bnv[2];
#pragma unroll
        for (int it = 0; it < 2; ++it) {
            const int c0 = (it * 64 + lane) * 8, hh = c0 >> 6; const bf16* vr = PRW + (size_t)row * W_RW + 2048 + c0;
            ofv[it] = *(const u32x4*)(OF + (size_t)row * 1024 + c0); obv[it] = *(const u32x4*)(OB + (size_t)row * 1024 + c0);
            xv[it] = *(const u32x4*)vr; xpv[it] = *(const u32x4*)(t > 0 ? vr - W_RW : vr); xnv[it] = *(const u32x4*)(t < SEQ - 1 ? vr + W_RW : vr);
            ggv[it] = *(const u32x4*)(LO + (size_t)row * LORA_N + 4096 + c0);
            bnv[it] = bonus[(size_t)row * 16 + hh] + bonus[(size_t)(GROWS + row) * 16 + hh]; }
#pragma unroll
        for (int it = 0; it < 2; ++it) {
            const int c0 = (it * 64 + lane) * 8;
            float of[8], ob[8], o[8], vv[8], gg[8];
            unpack8(ofv[it], of); unpack8(obv[it], ob);
            { float x[8], xp[8], xn[8]; unpack8(xv[it], x); unpack8(xpv[it], xp); unpack8(xnv[it], xn);
              const f32x4 ma = maK[it], mb = mbK[it], na = naK[it], nb = nbK[it];
              const float zp = t > 0 ? 1.f : 0.f, zn = t < SEQ - 1 ? 1.f : 0.f;
#pragma unroll
              for (int i = 0; i < 4; ++i) { vv[i] = x[i] + ma[i] * (xp[i] * zp - x[i]) + na[i] * (xn[i] * zn - x[i]); vv[4 + i] = x[4 + i] + mb[i] * (xp[4 + i] * zp - x[4 + i]) + nb[i] * (xn[4 + i] * zn - x[4 + i]); } }
            unpack8(ggv[it], gg);
            float s = 0.f;
#pragma unroll
            for (int i = 0; i < 8; ++i) { o[i] = of[i] + ob[i]; s += o[i]; }
            const float mean = reduce8(s) * (1.f / 64.f);
            float q = 0.f;
#pragma unroll
            for (int i = 0; i < 8; ++i) { o[i] -= mean; q += o[i] * o[i]; }
            const float rstd = rsqrtf(reduce8(q) * (1.f / 64.f) + 64e-5f);
            const float bn = bnv[it];
            const f32x4 g0 = g0K[it], g1 = g1K[it], b0 = b0K[it], b1 = b1K[it];
            float y[8];
#pragma unroll
            for (int i = 0; i < 4; ++i) { y[i] = (o[i] * rstd * g0[i] + b0[i] + bn * vv[i]) * gg[i]; y[4 + i] = (o[4 + i] * rstd * g1[i] + b1[i] + bn * vv[4 + i]) * gg[4 + i]; }
            store8(RO + (size_t)row * 1024 + c0, y);
        }
    }
}
__device__ __forceinline__ void phase_act_fix(const Ctx& C, int l) {
    const PT a(C);
    const bf16* EA = (const bf16*)(a.ws() + A_EA); const bf16* EB = (const bf16*)(a.ws() + A_EB); bf16* ACT = (bf16*)(a.ws() + A_ACT);
    const float* cw = a.in(I_CONVW) + (size_t)l * 3 * DFF; const float* cb = a.in(I_CONVB) + (size_t)l * DFF;
    constexpr int NT = GROWS / 256, NR = NT * 8;
    for (int u4 = C.gw; u4 < NR * 4; u4 += C.ngw) {
        const int u = u4 >> 2, part = u4 & 3;
        const int tile = u >> 3, blk = (u >> 1) & 3, e = u & 1;
        const size_t eb = (size_t)tile * 4 + blk, tok = (size_t)tile * 256 + blk * 64 + (e ? 63 : 0);
        const bf16* ac = EA + (eb * 4 + (e ? 3 : 0)) * DFF; const bf16* bc = EB + (eb * 2 + e) * DFF;
        const bf16* apv; const bf16* anx; float zp = 1.f, zn = 1.f;
        if (e == 0) { anx = EA + (eb * 4 + 1) * DFF;
            if (blk > 0) apv = EA + ((eb - 1) * 4 + 3) * DFF; else if ((tile & 15) != 0) apv = EA + ((eb - 1) * 4 + 3) * DFF; else { apv = ac; zp = 0.f; } }
        else { apv = EA + (eb * 4 + 2) * DFF;
            if (blk < 3) anx = EA + ((eb + 1) * 4 + 0) * DFF; else if ((tile & 15) != 15) anx = EA + ((eb + 1) * 4 + 0) * DFF; else { anx = ac; zn = 0.f; } }
#pragma unroll 1
        for (int it = part; it < 11; it += 4) {
            const int c0 = (it * 64 + C.lane) * 8;
            float x[8], xp[8], xn[8], b[8], o[8];
            load8(ac + c0, x); load8(apv + c0, xp); load8(anx + c0, xn); load8(bc + c0, b);
#pragma unroll
            for (int h = 0; h < 2; ++h) {
                const f32x4 w0 = *(const f32x4*)(cw + c0 + 4 * h), w1 = *(const f32x4*)(cw + DFF + c0 + 4 * h), w2 = *(const f32x4*)(cw + 2 * DFF + c0 + 4 * h), bb = *(const f32x4*)(cb + c0 + 4 * h);
#pragma unroll
                for (int i = 0; i < 4; ++i) { const int j = 4 * h + i; const float cc = xp[j] * zp * w0[i] + x[j] * w1[i] + xn[j] * zn * w2[i] + bb[i]; o[j] = cc * sigmoidf_(cc) * b[j]; }
            }
            store8(ACT + tok * DFF + c0, o);
        }
    }
}

constexpr int SCAN_T = 32, SCAN_STEP_F = 384, SCAN_BUF_F = SCAN_T * SCAN_STEP_F;
static_assert((2 * SCAN_BUF_F + 2 * SCAN_T * 64) * 4 + 2 * 2 * SCAN_T * 64 * 2 <= RING_BYTES, "scan LDS");
__device__ __forceinline__ void scan_chain(const Ctx& C, int l, int ch) {
    const PT a(C);
    const bf16* PRW = (const bf16*)(a.ws() + A_PRW); const bf16* AL = (const bf16*)(a.ws() + A_ALORA);
    float* bonus = (float*)(a.ws() + WS_BONUS);
    LAS float* buf = (LAS float*)C.lds;
    LAS float* obuf = buf + 2 * SCAN_BUF_F;
    LAS bf16* xs = (LAS bf16*)(obuf + 2 * SCAN_T * 64);
    const int tid = C.tid, lane = C.lane;
    const int d = ch & 1, hh = (ch >> 1) & 15, sq = ch >> 5;
    bf16* OD = (bf16*)(a.ws() + (d ? A_OB : A_OF));
    const bool loader = tid >= 256;
    const int lid = tid - 256, lj = lid >> 3, lg = lid & 7, chn = hh * 64 + lg * 8;
    float ka[8], rk[8], kkw[8], m0r[8], m1r[8], m0k[8], m1k[8], m0v[8], m1v[8];
    u32x4 g_r, g_rp, g_rn, g_k, g_kp, g_kn, g_v, g_vp, g_vn;
    const int mtx = (C.wave >> 1) & 1, nb = C.wave & 1, r32 = lane & 31, hi = lane >> 5;
    bf16x8 Bf[4]; float lbias = 0.f;
    if (loader) {
        const float* Wm = (mtx ? a.in(I_WICLR) : a.in(I_WDEC)) + (size_t)(l * 2 + d) * 64 * 1024 + hh * 64 + nb * 32 + r32;
#pragma unroll
        for (int ks = 0; ks < 4; ++ks) { float t_[8];
#pragma unroll
            for (int j = 0; j < 8; ++j) t_[j] = Wm[(size_t)(ks * 16 + hi * 8 + j) * 1024];
            Bf[ks] = __builtin_bit_cast(bf16x8, pack8(t_)); }
        lbias = (mtx ? a.in(I_A0) : a.in(I_W0))[l * 2048 + d * 1024 + hh * 64 + nb * 32 + r32];
    }
    if (loader) {
        const float* mu0 = a.in(I_MU) + (size_t)l * 2 * RWIN; const float* mu1 = mu0 + RWIN;
#define LD8F(dst, p) do { const f32x4 x0_ = *(const f32x4*)(p), x1_ = *(const f32x4*)((p) + 4); _Pragma("unroll") for (int i = 0; i < 4; ++i) { dst[i] = x0_[i]; dst[4 + i] = x1_[i]; } } while (0)
        LD8F(ka, a.in(I_KA) + l * 1024 + chn); LD8F(rk, a.in(I_RK) + ((size_t)(l * 2 + d) * 16 + hh) * 64 + lg * 8); LD8F(kkw, a.in(I_KK) + l * 1024 + chn);
        LD8F(m0r, mu0 + chn); LD8F(m1r, mu1 + chn); LD8F(m0k, mu0 + 1024 + chn); LD8F(m1k, mu1 + 1024 + chn); LD8F(m0v, mu0 + 2048 + chn); LD8F(m1v, mu1 + 2048 + chn);
#undef LD8F
    }
#define SC_TOK(step) (d ? (SEQ - 1 - (step)) : (step))
#define SC_ISSUE(cn) do { const int tok_ = SC_TOK((cn) * SCAN_T + lj), row_ = sq * SEQ + tok_; const bf16* rp_ = PRW + (size_t)row_ * W_RW + chn; \
        const int op_ = tok_ > 0 ? -W_RW : 0, on_ = tok_ < SEQ - 1 ? W_RW : 0; \
        g_r = *(const u32x4*)rp_; g_rp = *(const u32x4*)(rp_ + op_); g_rn = *(const u32x4*)(rp_ + on_); g_k = *(const u32x4*)(rp_ + 1024); g_kp = *(const u32x4*)(rp_ + 1024 + op_); g_kn = *(const u32x4*)(rp_ + 1024 + on_); \
        g_v = *(const u32x4*)(rp_ + 2048); g_vp = *(const u32x4*)(rp_ + 2048 + op_); g_vn = *(const u32x4*)(rp_ + 2048 + on_); } while (0)
#define ST8(p, x) do { *(LAS f32x4*)(p) = (f32x4){x[0], x[1], x[2], x[3]}; *(LAS f32x4*)((p) + 4) = (f32x4){x[4], x[5], x[6], x[7]}; } while (0)
#define SC_MIX(dst, gc, gp, gn, m0, m1) do { float x_[8], xp_[8], xn_[8]; unpack8(gc, x_); unpack8(gp, xp_); unpack8(gn, xn_); \
        _Pragma("unroll") for (int i = 0; i < 8; ++i) dst[i] = x_[i] + m0[i] * (xp_[i] * zp_ - x_[i]) + m1[i] * (xn_[i] * zn_ - x_[i]); } while (0)
#define SC_WRITE(cn) do { float r_[8], k_[8], v_[8], kk_[8], w_[8], a_[8]; unpack8(*(const LAS u32x4*)(xs + (((cn) & 1) * 2 + 0) * 2048 + lj * 64 + lg * 8), w_); unpack8(*(const LAS u32x4*)(xs + (((cn) & 1) * 2 + 1) * 2048 + lj * 64 + lg * 8), a_); \
        { const int tok_ = SC_TOK((cn) * SCAN_T + lj); const float zp_ = tok_ > 0 ? 1.f : 0.f, zn_ = tok_ < SEQ - 1 ? 1.f : 0.f; \
          SC_MIX(r_, g_r, g_rp, g_rn, m0r, m1r); SC_MIX(k_, g_k, g_kp, g_kn, m0k, m1k); SC_MIX(v_, g_v, g_vp, g_vn, m0v, m1v); \
          float ss_ = 0.f; _Pragma("unroll") for (int i = 0; i < 8; ++i) { kk_[i] = k_[i] * kkw[i]; ss_ += kk_[i] * kk_[i]; } \
          ss_ = reduce8(ss_); const float inv_ = 1.f / fmaxf(sqrtf(ss_), 1e-12f); _Pragma("unroll") for (int i = 0; i < 8; ++i) kk_[i] *= inv_; } \
        LAS float* bp_ = buf + ((cn) & 1) * SCAN_BUF_F + lj * SCAN_STEP_F + lg * 8; float bs_ = 0.f; \
        float G_[8], kt_[8], at_[8], bt_[8], rt_[8]; \
        _Pragma("unroll") for (int i = 0; i < 8; ++i) { G_[i] = __builtin_amdgcn_exp2f(-0.8750387749f * w_[i]); const float kd_ = k_[i] * (1.f + (a_[i] - 1.f) * ka[i]); bs_ += r_[i] * kd_ * rk[i]; bt_[i] = kd_; at_[i] = kk_[i] * a_[i]; } \
        _Pragma("unroll") for (int off_ = 8; off_ < 64; off_ <<= 1) { _Pragma("unroll") for (int i = 0; i < 8; ++i) { const float y_ = __shfl_up(G_[i], off_); if (lane >= off_) G_[i] *= y_; } } \
        _Pragma("unroll") for (int i = 0; i < 8; ++i) { float gp_ = __shfl_up(G_[i], 8); if (lane < 8) gp_ = 1.f; const float rg_ = 1.f / G_[i]; kt_[i] = kk_[i] * gp_; at_[i] *= rg_; bt_[i] *= rg_; rt_[i] = r_[i] * G_[i]; } \
        ST8(bp_, G_); ST8(bp_ + 64, kt_); ST8(bp_ + 128, at_); ST8(bp_ + 192, bt_); ST8(bp_ + 256, rt_); ST8(bp_ + 320, v_); \
        bs_ = reduce8(bs_); if (lg == 0) { const int row_ = sq * SEQ + SC_TOK((cn) * SCAN_T + lj); bonus[((size_t)d * GROWS + row_) * 16 + hh] = bs_; } } while (0)
#define SC_LORA(cn) do { const bf16* ap_ = AL + (size_t)(sq * SEQ + SC_TOK((cn) * SCAN_T + r32)) * LORA_K + mtx * 128 + d * 64 + hi * 8; f32x16 acc_ = {}; \
        _Pragma("unroll") for (int ks = 0; ks < 4; ++ks) acc_ = __builtin_amdgcn_mfma_f32_32x32x16_bf16(*(const bf16x8*)(ap_ + ks * 16), Bf[ks], acc_, 0, 0, 0); \
        LAS bf16* xp_ = xs + (((cn) & 1) * 2 + mtx) * 2048 + nb * 32 + r32; \
        _Pragma("unroll") for (int r = 0; r < 16; ++r) xp_[att::crow(r, hi) * 64] = (bf16)(cvt_pk_bf16(sigmoidf_(acc_[r] + lbias), 0.f) & 0xffffu); } while (0)
#define SC_OUT(cn) do { const LAS float* op_ = obuf + ((cn) & 1) * (SCAN_T * 64) + lj * 64 + lg * 8; const f32x4 o0_ = *(const LAS f32x4*)op_, o1_ = *(const LAS f32x4*)(op_ + 4); \
        const int row_ = sq * SEQ + SC_TOK((cn) * SCAN_T + lj); u32x4 w_; w_.x = cvt_pk_bf16(o0_[0], o0_[1]); w_.y = cvt_pk_bf16(o0_[2], o0_[3]); w_.z = cvt_pk_bf16(o1_[0], o1_[1]); w_.w = cvt_pk_bf16(o1_[2], o1_[3]); \
        *(u32x4*)(OD + (size_t)row_ * 1024 + hh * 64 + lg * 8) = w_; } while (0)
    constexpr int NCH = SEQ / SCAN_T;
    const int rloc = (C.wave & 3) * 8 + (lane >> 3), cg = lane & 7;
    f32x2 s01 = {0.f, 0.f}, s23 = {0.f, 0.f}, s45 = {0.f, 0.f}, s67 = {0.f, 0.f};
    f32x2 t01 = {0.f, 0.f}, t23 = {0.f, 0.f}, t45 = {0.f, 0.f}, t67 = {0.f, 0.f};
    if (loader) SC_LORA(0);
    __syncthreads();
    if (loader) { SC_ISSUE(0); SC_WRITE(0); SC_LORA(1); }
    __syncthreads();
#pragma unroll 1
    for (int cn = 0; cn < NCH; ++cn) {
        if (loader) {
            if (cn + 1 < NCH) SC_ISSUE(cn + 1);
            if (cn + 2 < NCH) SC_LORA(cn + 2);
            if (cn > 0) SC_OUT(cn - 1);
            if (cn + 1 < NCH) SC_WRITE(cn + 1);
        } else {
            const unsigned ba = (unsigned)(uintptr_t)(buf + (cn & 1) * SCAN_BUF_F + cg * 8);
            const unsigned va = (unsigned)(uintptr_t)(buf + (cn & 1) * SCAN_BUF_F + 320 + rloc);
            LAS float* op = obuf + (cn & 1) * (SCAN_T * 64) + rloc;
#define DSR128(dst, addr, off) asm volatile("ds_read_b128 %0, %1 offset:%2" : "=v"(dst) : "v"(addr), "n"(off))
#define DSR32(dst, addr, off) asm volatile("ds_read_b32 %0, %1 offset:%2" : "=v"(dst) : "v"(addr), "n"(off))
#define SC_LDE(j) do { DSR128(Ek0, ba, (j) * 1536 + 256); DSR128(Ek1, ba, (j) * 1536 + 272); DSR128(Ed0, ba, (j) * 1536 + 768); DSR128(Ed1, ba, (j) * 1536 + 784); DSR32(Evv, va, (j) * 1536); DSR32(Evu, va, (j) * 1536 + 128); } while (0)
#define SC_LDL(j) do { DSR128(La0, ba, (j) * 1536 + 512); DSR128(La1, ba, (j) * 1536 + 528); DSR128(Lr0, ba, (j) * 1536 + 1024); DSR128(Lr1, ba, (j) * 1536 + 1040); \
        if ((((j) & 7) == 7)) { DSR128(Lg0, ba, (j) * 1536); DSR128(Lg1, ba, (j) * 1536 + 16); } } while (0)
#define LO2(v) __builtin_shufflevector(v, v, 0, 1)
#define HI2(v) __builtin_shufflevector(v, v, 2, 3)
#define SC_STEP(j) do { \
        if ((((j) & 7) == 7)) asm volatile("s_waitcnt lgkmcnt(6)" : "+v"(Ek0), "+v"(Ek1), "+v"(Ed0), "+v"(Ed1), "+v"(Evv), "+v"(Evu)); \
        else asm volatile("s_waitcnt lgkmcnt(4)" : "+v"(Ek0), "+v"(Ek1), "+v"(Ed0), "+v"(Ed1), "+v"(Evv), "+v"(Evu)); \
        if ((j) > 0) { const float q_ = reduce8(cqs_); const float qv_ = reduce8(cqt_); op[((j) - 1) * 64] = q_; op[((j) - 1) * 64 + 32] = qv_; }     \
        f32x2 pp_ = s01 * LO2(Ek0); f32x2 pu_ = t01 * LO2(Ek0); pp_ = s23 * HI2(Ek0) + pp_; pu_ = t23 * HI2(Ek0) + pu_; pp_ = s45 * LO2(Ek1) + pp_; pu_ = t45 * LO2(Ek1) + pu_; pp_ = s67 * HI2(Ek1) + pp_; pu_ = t67 * HI2(Ek1) + pu_; \
        float p_ = reduce8(pp_[0] + pp_[1]); float pq_ = reduce8(pu_[0] + pu_[1]); const f32x2 v2_ = {Evv, Evv}, u2_ = {Evu, Evu}; \
        s01 = v2_ * LO2(Ed0) + s01; s23 = v2_ * HI2(Ed0) + s23; s45 = v2_ * LO2(Ed1) + s45; s67 = v2_ * HI2(Ed1) + s67; \
        t01 = u2_ * LO2(Ed0) + t01; t23 = u2_ * HI2(Ed0) + t23; t45 = u2_ * LO2(Ed1) + t45; t67 = u2_ * HI2(Ed1) + t67; \
        asm volatile("" : "+v"(s01), "+v"(s23), "+v"(s45), "+v"(s67), "+v"(t01), "+v"(t23), "+v"(t45), "+v"(t67), "+v"(p_), "+v"(pq_));     \
        SC_LDE((j) + 1); \
        if ((((j) & 7) == 7)) asm volatile("s_waitcnt lgkmcnt(6)" : "+v"(La0), "+v"(La1), "+v"(Lr0), "+v"(Lr1), "+v"(Lg0), "+v"(Lg1)); \
        else asm volatile("s_waitcnt lgkmcnt(6)" : "+v"(La0), "+v"(La1), "+v"(Lr0), "+v"(Lr1)); \
        { const f32x2 p2_ = {p_, p_}, q2_ = {pq_, pq_}; \
        s01 = s01 - p2_ * LO2(La0); s23 = s23 - p2_ * HI2(La0); s45 = s45 - p2_ * LO2(La1); s67 = s67 - p2_ * HI2(La1); \
        t01 = t01 - q2_ * LO2(La0); t23 = t23 - q2_ * HI2(La0); t45 = t45 - q2_ * LO2(La1); t67 = t67 - q2_ * HI2(La1); } \
        f32x2 qq_ = s01 * LO2(Lr0); f32x2 qu_ = t01 * LO2(Lr0); qq_ = s23 * HI2(Lr0) + qq_; qu_ = t23 * HI2(Lr0) + qu_; qq_ = s45 * LO2(Lr1) + qq_; qu_ = t45 * LO2(Lr1) + qu_; qq_ = s67 * HI2(Lr1) + qq_; qu_ = t67 * HI2(Lr1) + qu_; \
        if ((((j) & 7) == 7)) { s01 *= LO2(Lg0); s23 *= HI2(Lg0); s45 *= LO2(Lg1); s67 *= HI2(Lg1); t01 *= LO2(Lg0); t23 *= HI2(Lg0); t45 *= LO2(Lg1); t67 *= HI2(Lg1); }     \
        asm volatile("" : "+v"(qq_), "+v"(qu_), "+v"(s01), "+v"(s23), "+v"(s45), "+v"(s67), "+v"(t01), "+v"(t23), "+v"(t45), "+v"(t67));     \
        SC_LDL((j) + 1); \
        cqs_ = qq_[0] + qq_[1]; cqt_ = qu_[0] + qu_[1]; } while (0)
            f32x4 Ek0, Ek1, Ed0, Ed1, La0, La1, Lr0, Lr1, Lg0, Lg1; float Evv, Evu; float cqs_ = 0.f, cqt_ = 0.f;
            SC_LDE(0); SC_LDL(0);
#pragma unroll
            for (int j = 0; j < SCAN_T; ++j) SC_STEP(j);
            { const float q_ = reduce8(cqs_); const float qv_ = reduce8(cqt_); op[(SCAN_T - 1) * 64] = q_; op[(SCAN_T - 1) * 64 + 32] = qv_; }
            asm volatile("s_waitcnt lgkmcnt(0)" : "+v"(Ek0), "+v"(Ek1), "+v"(Ed0), "+v"(Ed1), "+v"(Evv), "+v"(Evu), "+v"(La0), "+v"(La1), "+v"(Lr0), "+v"(Lr1), "+v"(Lg0), "+v"(Lg1));
#undef DSR128
#undef DSR32
#undef SC_LDE
#undef SC_LDL
#undef SC_STEP
#undef LO2
#undef HI2
        }
        __syncthreads();
    }
    if (loader) SC_OUT(NCH - 1);
    __syncthreads();
#undef SC_TOK
#undef SC_ISSUE
#undef SC_LORA
#undef SC_MIX
#undef SC_WRITE
#undef SC_OUT
#undef ST8
}

constexpr int NT_STEPS = 12;
constexpr int N_STEPS = 1 + NLAYER * (1 + NGRP * NT_STEPS) + 1;
#ifndef NL_BUILD
#define NL_BUILD NLAYER
#endif
#ifndef NG_BUILD
#define NG_BUILD NGRP
#endif

#define IN_STEP(k) (lo <= (sbase + (k)) && (sbase + (k)) < hi)
#define END_STEP(k) do { if (sbase + (k) + 1 < hi) { const PT pb_(C); XcdBarrier bar_; bar_.bar = (unsigned*)(pb_.ws() + WS_CTL) + CW_BAR; bar_.x = xb_xcc_id(); bar_.st = (volatile LAS unsigned*)(C.lds + MISC_OFF) + 8; xcd_barrier(bar_); } } while (0)
#define STEP_PTRS const PT a(C); unsigned char* const ws = a.ws(); (void)ws; \
    const float* const mod = (const float*)(ws + WS_MOD); bf16* const wb = (bf16*)(ws + WS_W); (void)wb; \
    const float* const xsrc = (L == 0) ? ((GI < 2) ? a.in(I_XP) + grow0 * DM : a.in(I_XS) + (grow0 - 32768) * DM) : a.out() + grow0 * DM; (void)xsrc; \
    float* const xout = a.out() + grow0 * DM; (void)xout; \
    const float* const modb = mod + ((size_t)L * 12 + GI * 4) * NMOD; (void)modb;

template <int L, int GI>
__device__ __forceinline__ void group_program(const Ctx& C, const int lo, const int hi) {
    constexpr int sbase = 1 + L * (1 + NGRP * NT_STEPS) + 1 + GI * NT_STEPS;
    constexpr size_t grow0 = (size_t)GI * GROWS;
    const int gdim = gridDim.x, bidx = blockIdx.x;
    if (EN(2) && IN_STEP(0)) { if constexpr (L == 0 && GI == 0) { REPEAT(2) { STEP_PTRS; phase_modnorm(C, C.gw, C.ngw, xsrc, (bf16*)(ws + A_H), a.in(I_NMIXG) + L * DM, modb, 0, 1); } END_STEP(0); } }
    if (EN(3) && IN_STEP(1)) { REPEAT(3) { STEP_PTRS;
        pg8::Gemm gm{(const bf16*)(ws + A_H), (const bf16*)((char*)wb + WO_IN), GROWS, NPROJ - 256, DM, DM, DM}; pg8::StaticOrder S; S.init(GROWS, NPROJ - 256, gdim, bidx);
        pg8::EpiG<FProj> E{FProj{(bf16*)(ws + A_PMLA), (bf16*)(ws + A_PRW), (bf16*)(ws + A_PGATE)}};
        pg8::gemm_phase<pg8::EpiG<FProj>, pg8::StaticOrder, PG8_ALIGN, PG8_SP2>(C.lds, gm, S, E); }
        END_STEP(1); }
    if (EN(4) && IN_STEP(2)) { REPEAT(4) { phase_prep(C, L); } END_STEP(2); }
    if (EN(5) && IN_STEP(3)) { REPEAT(5) {
        { STEP_PTRS; pg8::Gemm gm{(const bf16*)(ws + A_ALORA) + 256, (const bf16*)((char*)wb + WO_LORA) + (size_t)4096 * LORA_KB, GROWS, 1024, LORA_KB, LORA_K, LORA_KB}; pg8::StaticOrder S; S.init(GROWS, 1024, gdim, bidx);
          pg8::EpiG<FLora> E{FLora{(bf16*)(ws + A_LORAOUT), a.in(I_W0) + L * 2048, a.in(I_A0) + L * 2048, 4096}};
          pg8::gemm_phase<pg8::EpiG<FLora>, pg8::StaticOrder, PG8_ALIGN, PG8_SP2>(C.lds, gm, S, E); }
        { STEP_PTRS; pg8::Gemm gm{(const bf16*)(ws + A_PMLA), (const bf16*)((char*)wb + WO_UQ), GROWS, QW, 512, W_MLA, 512}; pg8::SkewOrder<2, 0, 2> S; S.init(GROWS, QW, gdim, bidx);
          pg8::EpiG<FQ> E{FQ{(bf16*)(ws + A_Q), (const float*)(ws + WS_RSTD), (const float*)(ws + WS_ROPE), (const float*)(ws + WS_ROPE) + SEQ * 32}};
          pg8::gemm_phase<pg8::EpiG<FQ>, pg8::SkewOrder<2, 0, 2>, PG8_ALIGN, PG8_SP2>(C.lds, gm, S, E); }
        { STEP_PTRS; pg8::Gemm gm{(const bf16*)(ws + A_PMLA) + 512, (const bf16*)((char*)wb + WO_UKV), GROWS, 2048, 256, W_MLA, 256}; pg8::SkewOrder<3, 0, 2> S; S.init(GROWS, 2048, gdim, bidx);
          pg8::EpiG<FKV> E{FKV{(bf16*)(ws + A_KF), (bf16*)(ws + A_V), (const float*)(ws + WS_RSTD) + GROWS}};
          pg8::gemm_phase<pg8::EpiG<FKV>, pg8::SkewOrder<3, 0, 2>, PG8_ALIGN, PG8_SP2>(C.lds, gm, S, E); }
        { STEP_PTRS; pg8::Gemm gm{(const bf16*)(ws + A_H), (const bf16*)((char*)wb + WO_IN) + (size_t)(NPROJ - 256) * DM, GROWS, 256, DM, DM, DM}; pg8::SkewOrder<0, 1, 0> S; S.init(GROWS, 256, gdim, bidx);
          pg8::EpiG<FStore> E{FStore{(bf16*)(ws + A_PGATE) + (W_GATE - 256), W_GATE}};
          pg8::gemm_phase<pg8::EpiG<FStore>, pg8::SkewOrder<0, 1, 0>, PG8_ALIGN, PG8_SP2>(C.lds, gm, S, E); } }
        END_STEP(3); }
    if (EN(6) && IN_STEP(4)) { { STEP_PTRS;
        const bool split = (gdim == 256);
        const int xcd = bidx & 7, bi = (bidx >> 3) & 15;
        for (int rp_ = 0; rp_ < (((PROBE_MASK >> 6) & 1) ? 2 : 1); ++rp_)
        for (int pr = bidx; pr < 128; pr += gdim) scan_chain(C, L, pr);
        const int r0 = 0, nr = split ? (bidx < 128 ? 0 : 4) : (512 - bidx + gdim - 1) / gdim;
        for (int k = 0; k < nr * (((PROBE_MASK >> 7) & 1) ? 2 : 1); ++k) {
            const int kk = k % (nr > 0 ? nr : 1);
            int pi, qb;
            if (split) { pi = xcd + 8 * (r0 + kk); qb = bi; } else { const int u = bidx + kk * gdim; pi = u >> 4; qb = u & 15; }
            const int hh = pi & 7, sq = pi >> 3;
            const bf16* Qb = (const bf16*)(ws + A_Q) + ((size_t)sq * SEQ + qb * 256) * QW + hh * 192;
            const bf16* Kh = (const bf16*)(ws + A_KF) + (size_t)sq * SEQ * KFW + hh * 192;
            const bf16* Vh = (const bf16*)(ws + A_V) + (size_t)sq * SEQ * VW + hh * 128;
            bf16* Ob = (bf16*)(ws + A_ATTO) + ((size_t)sq * SEQ + qb * 256) * 1024 + hh * 128;
            att::attn_unit(Qb, Kh, Vh, Ob, SEQ, (LAS char*)C.lds);
        }
        constexpr int NL_ = (GI == NGRP - 1) ? L + 1 : L, NG_ = (GI == NGRP - 1) ? 0 : GI + 1;
        if constexpr (NL_ < NLAYER) {
            constexpr size_t ngrow0 = (size_t)NG_ * GROWS;
            const float* nx = (NL_ == 0) ? ((NG_ < 2) ? a.in(I_XP) + ngrow0 * DM : a.in(I_XS) + (ngrow0 - 32768) * DM) : a.out() + ngrow0 * DM;
            const float* nmodb = mod + ((size_t)NL_ * 12 + NG_ * 4) * NMOD;
            if (split) { if (bidx >= 128) phase_modnorm(C, (bidx - 128) * NWAVES + C.wave, 128 * NWAVES, nx, (bf16*)(ws + A_H), a.in(I_NMIXG) + NL_ * DM, nmodb, 0, 1); }
            else phase_modnorm(C, C.gw, C.ngw, nx, (bf16*)(ws + A_H), a.in(I_NMIXG) + NL_ * DM, nmodb, 0, 1);
        }
        if constexpr (L == NLAYER - 1 && GI >= 1) {
            if (split) { if (bidx >= 128) phase_final(C, (bidx - 128) * NWAVES + C.wave, 128 * NWAVES, (GI - 1) * GROWS, GI * GROWS, a.out(), a.in(I_FNG)); }
            else phase_final(C, C.gw, C.ngw, (GI - 1) * GROWS, GI * GROWS, a.out(), a.in(I_FNG));
        } }
        END_STEP(4); }
    if (EN(7) && IN_STEP(5)) { REPEAT(15) { phase_rwkv_post(C, L); } END_STEP(5); }
    if (EN(8) && IN_STEP(6)) { REPEAT(8) {
        { STEP_PTRS; pg8::Gemm gm{(const bf16*)(ws + A_ATTO), (const bf16*)((char*)wb + WO_OATT), GROWS, DM, 1024, 1024, 1024}; pg8::StaticOrder S; S.init(GROWS, DM, gdim, bidx);
          pg8::EpiG<FMergeA> E{FMergeA{(bf16*)(ws + A_MERGED), (const bf16*)(ws + A_PGATE)}};
          pg8::gemm_phase<pg8::EpiG<FMergeA>, pg8::StaticOrder, PG8_ALIGN, PG8_SP2>(C.lds, gm, S, E); }
        VM_WAIT(); __syncthreads();
        { STEP_PTRS; pg8::Gemm gm{(const bf16*)(ws + A_RWKVO), (const bf16*)((char*)wb + WO_ORWKV), GROWS, DM, 1024, 1024, 1024}; pg8::StaticOrder S; S.init(GROWS, DM, gdim, bidx);
          pg8::EpiG<FMergeB> E{FMergeB{(bf16*)(ws + A_MERGED), (const bf16*)(ws + A_PGATE)}};
          pg8::gemm_phase<pg8::EpiG<FMergeB>, pg8::StaticOrder, PG8_ALIGN, PG8_SP2>(C.lds, gm, S, E); }
          VM_WAIT(); __syncthreads(); }
        END_STEP(6); }
    if (EN(9) && IN_STEP(7)) { _Pragma("unroll") for (int rep_ = 0; rep_ < ((((PROBE_MASK >> 9) & 1) && L == 0) ? 2 : 1); ++rep_) { STEP_PTRS;
        pg8::Gemm gm{(const bf16*)(ws + A_MERGED), (const bf16*)((char*)wb + WO_OUT), GROWS, DM, DM, DM, DM}; pg8::StaticOrder S; S.init(GROWS, DM, gdim, bidx);
        pg8::EpiG<FResid> E{FResid{xsrc, xout, modb + 2 * DM}};
        pg8::gemm_phase<pg8::EpiG<FResid>, pg8::StaticOrder, false, PG8_SP2>(C.lds, gm, S, E); }
        END_STEP(7); }
    if (EN(10) && IN_STEP(8)) { REPEAT(10) { STEP_PTRS; phase_modnorm(C, C.gw, C.ngw, xout, (bf16*)(ws + A_H2), a.in(I_NFFNG) + L * DM, modb, 3, 4); } END_STEP(8); }
    if (EN(11) && IN_STEP(9)) { { STEP_PTRS;
        pg8::Gemm gm{(const bf16*)(ws + A_H2), (const bf16*)((char*)wb + WO_UP), GROWS, 2 * DFF, DM, DM, DM}; pg8::StaticOrder S; S.init(GROWS, 2 * DFF, gdim, bidx);
        EpiAct E{(bf16*)(ws + A_ACT), (bf16*)(ws + A_EA), (bf16*)(ws + A_EB), a.in(I_CONVW) + (size_t)L * 3 * DFF, a.in(I_CONVB) + (size_t)L * DFF};
        pg8::gemm_phase<EpiAct, pg8::StaticOrder, PG8_ALIGN, PG8_SP2, true>(C.lds, gm, S, E); }
        END_STEP(9); }
    if (EN(12) && IN_STEP(10)) { phase_act_fix(C, L); END_STEP(10); }
    if (EN(13) && IN_STEP(11)) { { STEP_PTRS;
        pg8::Gemm gm{(const bf16*)(ws + A_ACT), (const bf16*)((char*)wb + WO_DOWN), GROWS, DM, DFF, DFF, DFF}; pg8::StaticOrder S; S.init(GROWS, DM, gdim, bidx);
        pg8::EpiG<FResid> E{FResid{xout, xout, modb + 5 * DM}};
        pg8::gemm_phase<pg8::EpiG<FResid>, pg8::StaticOrder, false, PG8_SP2>(C.lds, gm, S, E); }
        if constexpr (GI == NGRP - 1) END_STEP(11);
    }
}
template <int L>
__device__ __forceinline__ void layer_program(const Ctx& C, const int lo, const int hi) {
    constexpr int sbase = 1 + L * (1 + NGRP * NT_STEPS);
    if (EN(1) && IN_STEP(0)) { if constexpr (L > 0) { phase_convert(C, L); END_STEP(0); } }
    group_program<L, 0>(C, lo, hi);
    if constexpr (NG_BUILD > 1) group_program<L, 1>(C, lo, hi);
    if constexpr (NG_BUILD > 2) group_program<L, 2>(C, lo, hi);
}

__global__ void __launch_bounds__(NWAVES * 64, 2) mk_fwd(Args a) {
    extern __shared__ __attribute__((aligned(16))) unsigned char lds_raw[];
    Ctx C;
    C.lds = (LAS unsigned char*)lds_raw;
    C.tid = threadIdx.x; C.lane = C.tid & 63; C.wave = __builtin_amdgcn_readfirstlane(C.tid >> 6);
    C.gw = blockIdx.x * NWAVES + C.wave; C.ngw = gridDim.x * NWAVES;
    for (int u = C.tid; u < (LDS_BYTES - LDSCTL_OFF) / 4; u += NWAVES * 64) ((LAS unsigned*)(C.lds + LDSCTL_OFF))[u] = 0u;
    __syncthreads();
    if (C.tid == 0) {
        LAS unsigned long long* t = (LAS unsigned long long*)(C.lds + ARGTAB_OFF);
#pragma unroll
        for (int i = 0; i < 32; ++i) t[i] = (unsigned long long)a.in[i];
        t[32] = (unsigned long long)a.out; t[33] = (unsigned long long)a.ws;
    }
    __syncthreads();
    const int lo = a.lo, hi = a.hi;
    if (hi - lo > 1) (void)xcd_barrier_post((unsigned*)(a.ws + WS_CTL) + CW_BAR, (volatile LAS unsigned*)(C.lds + MISC_OFF) + 8);
    { constexpr int sbase = 0; if (EN(0) && IN_STEP(0)) { phase_mod(C); __syncthreads(); phase_convert(C, 0); END_STEP(0); } }
    layer_program<0>(C, lo, hi);
    if constexpr (NL_BUILD > 1) layer_program<1>(C, lo, hi);
    { constexpr int sbase = N_STEPS - 1; if (EN(14) && IN_STEP(0)) { const PT p(C); phase_final(C, C.gw, C.ngw, (NGRP - 1) * GROWS, MALL, p.out(), p.in(I_FNG)); } }
}
#undef IN_STEP
#undef END_STEP

extern "C" void kernel_launch(void* const* d_in, const int* in_sizes, int n_in, void* d_out, int out_size, void* d_ws, size_t ws_size, hipStream_t stream) {
    static int grid = 0;
    if (grid == 0) {
        if (n_in != 32 || out_size != MALL * DM || ws_size < WS_NEED) { fprintf(stderr, "kernel_launch: unexpected shapes: n_in %d out %d ws %zu (need %zu)\n", n_in, out_size, ws_size, (size_t)WS_NEED); grid = -1; return; }
        int dev = 0, cus = 0, per_cu = 0;
        if (hipGetDevice(&dev) != hipSuccess || hipDeviceGetAttribute(&cus, hipDeviceAttributeMultiprocessorCount, dev) != hipSuccess) { grid = -1; return; }
        if (hipFuncSetAttribute((const void*)mk_fwd, hipFuncAttributeMaxDynamicSharedMemorySize, LDS_BYTES) != hipSuccess) { fprintf(stderr, "kernel_launch: hipFuncSetAttribute failed\n"); grid = -1; return; }
        if (hipOccupancyMaxActiveBlocksPerMultiprocessor(&per_cu, (const void*)mk_fwd, NWAVES * 64, LDS_BYTES) != hipSuccess || per_cu < 1) fprintf(stderr, "kernel_launch: occupancy query reports %d\n", per_cu);
        (void)hipGetLastError();
        grid = cus;
    }
    if (grid < 0) return;
    if (hipMemsetAsync((char*)d_ws + WS_CTL, 0, CTL_ZERO_BYTES, stream) != hipSuccess) return;
    Args a{};
    for (int i = 0; i < 32; ++i) a.in[i] = (const float*)d_in[i];
    a.out = (float*)d_out; a.ws = (unsigned char*)d_ws;
#if MK_MODE == 1
    a.lo = 0; a.hi = N_STEPS;
    hipLaunchKernelGGL(mk_fwd, dim3(grid), dim3(NWAVES * 64), LDS_BYTES, stream, a);
#else
    for (int s = 0; s < N_STEPS; ++s) { a.lo = s; a.hi = s + 1; hipLaunchKernelGGL(mk_fwd, dim3(grid), dim3(NWAVES * 64), LDS_BYTES, stream, a); }
#endif
}
```

```cpp
#include <hip/hip_runtime.h>
#include <cstdio>
#include <cstdint>

#ifndef MK_MODE
#define MK_MODE 1
#endif

#ifndef ONLY
#define ONLY -1
#endif
#ifndef PROBE_MASK
#define PROBE_MASK 0
#endif
#define REPEAT(k) _Pragma("unroll") for (int rep_ = 0; rep_ < (((PROBE_MASK >> (k)) & 1) ? 2 : 1); ++rep_)
#define EN(k) (ONLY < 0 || ONLY == (k))
#define LAS __attribute__((address_space(3)))
#define GAS __attribute__((address_space(1)))
typedef unsigned short bf16;
typedef short bf16x8 __attribute__((ext_vector_type(8)));
typedef short s16x4 __attribute__((ext_vector_type(4)));
typedef float f32x4 __attribute__((ext_vector_type(4)));
typedef float f32x2 __attribute__((ext_vector_type(2)));
typedef float f32x16 __attribute__((ext_vector_type(16)));
typedef unsigned u32x4 __attribute__((ext_vector_type(4)));
typedef unsigned u32x2 __attribute__((ext_vector_type(2)));
typedef GAS unsigned gu32;

constexpr int DM = 2048, NSEQ = 12, SEQ = 4096, MALL = NSEQ * SEQ;
constexpr int NLAYER = 2;
constexpr int GROWS = 16384, NGRP = MALL / GROWS;
constexpr int DIN = 8416, W_MLA = 832, W_RW = 3520, W_GATE = 4096, NPROJ = W_MLA + W_RW + W_GATE;
constexpr int RWIN = 3488;
constexpr int DFF = 5632;
constexpr int NMOD = 6 * DM;
constexpr int QW = 1536, KFW = 1536, VW = 1024;
constexpr int LORA_K = 512, LORA_N = 5120, LORA_KB = 256;
constexpr int NWAVES = 8;

constexpr size_t MiB = 1u << 20;
constexpr size_t WS_CTL = 0, CTL_ZERO_BYTES = 3 * MiB;
constexpr size_t WS_MOD = 1 * MiB;
constexpr size_t WS_ROPE = 3 * MiB;
constexpr size_t WS_RSTD = 4 * MiB;
constexpr size_t WS_BONUS = 5 * MiB;
constexpr size_t WS_W = 8 * MiB;
constexpr size_t WO_IN = 0, WO_UQ = WO_IN + (size_t)NPROJ * DM * 2, WO_UKV = WO_UQ + (size_t)QW * 512 * 2, WO_OATT = WO_UKV + (size_t)2048 * 256 * 2,
                 WO_ORWKV = WO_OATT + (size_t)DM * 1024 * 2, WO_OUT = WO_ORWKV + (size_t)DM * 1024 * 2, WO_UP = WO_OUT + (size_t)DM * DM * 2,
                 WO_DOWN = WO_UP + (size_t)2 * DFF * DM * 2, WO_LORA = WO_DOWN + (size_t)DM * DFF * 2, WO_END = WO_LORA + (size_t)LORA_N * LORA_K * 2;
static_assert(WO_END <= 124 * MiB, "weights");
constexpr size_t WS_A = 132 * MiB;
constexpr size_t A_H = WS_A;
constexpr size_t A_PMLA = WS_A + 64 * MiB;
constexpr size_t A_PGATE = A_PMLA + 32 * MiB;
constexpr size_t A_PRW = A_PGATE + 128 * MiB;
constexpr size_t A_RKVKK = A_PRW + 112 * MiB;
constexpr size_t A_OF = A_RKVKK;
constexpr size_t A_OB = A_RKVKK + 32 * MiB;
constexpr size_t A_RWKVO = A_RKVKK + 64 * MiB;
constexpr size_t A_ALORA = A_RKVKK + 96 * MiB;
constexpr size_t A_MERGED = A_RKVKK;
constexpr size_t A_LORAOUT = A_RKVKK + 128 * MiB;
constexpr size_t A_Q = A_LORAOUT + 160 * MiB;
constexpr size_t A_KF = A_Q + 48 * MiB;
constexpr size_t A_V = A_KF + 48 * MiB;
constexpr size_t A_ATTO = A_V + 32 * MiB;
constexpr size_t A_TM_END = A_ATTO + 32 * MiB;
constexpr size_t A_MID = WS_A + 64 * MiB;
constexpr size_t A_EA = A_MID;
constexpr size_t A_EB = A_MID + 16 * MiB;
constexpr size_t A_ACT = A_MID + 352 * MiB;
constexpr size_t A_H2 = A_ACT + 176 * MiB;
constexpr size_t A_FF_END = A_H2 + 64 * MiB;
constexpr size_t WS_NEED = (A_TM_END > A_FF_END ? A_TM_END : A_FF_END);
static_assert(WS_NEED <= 1000 * MiB, "workspace map");

constexpr int CW_BAR = 4096;

constexpr int RING_BYTES = 131072, LDSCTL_OFF = RING_BYTES, MISC_OFF = LDSCTL_OFF + 320, LDS_BYTES = 147456;

#define LDS_WAIT() asm volatile("s_waitcnt lgkmcnt(0)" ::: "memory")
#define VM_WAIT() asm volatile("s_waitcnt vmcnt(0)" ::: "memory")
typedef __bf16 bf16x2_t __attribute__((ext_vector_type(2)));
__device__ __forceinline__ unsigned cvt_pk_bf16(float lo, float hi) { const f32x2 v = {lo, hi}; const bf16x2_t b = __builtin_convertvector(v, bf16x2_t); return __builtin_bit_cast(unsigned, b); }
__device__ __forceinline__ float bf_lo(unsigned w) { return __uint_as_float(w << 16); }
__device__ __forceinline__ float bf_hi(unsigned w) { return __uint_as_float(w & 0xffff0000u); }
__device__ __forceinline__ void unpack8(const u32x4 w, float (&f)[8]) { f[0] = bf_lo(w.x); f[1] = bf_hi(w.x); f[2] = bf_lo(w.y); f[3] = bf_hi(w.y); f[4] = bf_lo(w.z); f[5] = bf_hi(w.z); f[6] = bf_lo(w.w); f[7] = bf_hi(w.w); }
__device__ __forceinline__ void load8(const bf16* p, float (&f)[8]) { unpack8(*(const u32x4*)p, f); }
__device__ __forceinline__ u32x4 pack8(const float (&f)[8]) { u32x4 w; w.x = cvt_pk_bf16(f[0], f[1]); w.y = cvt_pk_bf16(f[2], f[3]); w.z = cvt_pk_bf16(f[4], f[5]); w.w = cvt_pk_bf16(f[6], f[7]); return w; }
__device__ __forceinline__ void store8(bf16* p, const float (&f)[8]) { *(u32x4*)p = pack8(f); }
__device__ __forceinline__ float sigmoidf_(float x) { return __builtin_amdgcn_rcpf(1.f + __expf(-x)); }
__device__ __forceinline__ float sigmoid_div(float x) { return 1.f / (1.f + __expf(-x)); }
__device__ __forceinline__ float wave_sum(float v) {
#pragma unroll
    for (int o = 1; o < 64; o <<= 1) v += __shfl_xor(v, o);
    return v;
}
__device__ __forceinline__ float reduce8(float x) {
    x += __builtin_bit_cast(float, __builtin_amdgcn_update_dpp(0, __builtin_bit_cast(int, x), 0xB1, 0xF, 0xF, true));
    x += __builtin_bit_cast(float, __builtin_amdgcn_update_dpp(0, __builtin_bit_cast(int, x), 0x4E, 0xF, 0xF, true));
    x += __builtin_bit_cast(float, __builtin_amdgcn_update_dpp(0, __builtin_bit_cast(int, x), 0x141, 0xF, 0xF, true));
    return x;
}

namespace pg8 {
constexpr int BM = 256, BK = 64, HALF = 128, HTB = HALF * BK * 2, STAGE_BYTES = 8 * HTB, NXCD = 8, WGM = 4;
__host__ __device__ __forceinline__ int lds_byte(int r, int c) { const int st = (r >> 4) * 2 + (c >> 5), rr = r & 15, cc = c & 31, ob = rr * 64 + cc * 2; return st * 1024 + (ob ^ (((ob >> 9) & 1) << 5)); }
__host__ __device__ __forceinline__ void stage_rc(int b, int& R, int& C) { const int st = b / 1024, sb = b % 1024, swz = sb ^ (((sb >> 9) & 1) << 5); R = (st >> 1) * 16 + swz / 64; C = (st & 1) * 32 + (swz % 64) / 2; }
__host__ __device__ __forceinline__ int perm32(int rho) { const int n = rho >> 4, i = rho & 15; return 8 * (i >> 2) + 4 * n + (i & 3); }
struct Unit { int pm, pn; };
struct Gemm { const bf16* A; const bf16* Bt; int M, N, K, lda, ldb; };
struct StaticOrder {
    int nM, nN, nwg, G, c;
    __host__ __device__ void init(int M, int N, int G_, int c_) { nM = M / BM; nN = N / BM; nwg = nM * nN; G = G_; c = c_; }
    __host__ __device__ bool next(int i, Unit& u) const {
        const long L = (long)i * G + c; if (L >= nwg) return false;
        int wgid = (int)L; { const int q = nwg / NXCD, r = nwg % NXCD, xcd = wgid % NXCD, off = wgid / NXCD; wgid = (xcd < r ? xcd * (q + 1) : r * (q + 1) + (xcd - r) * q) + off; }
        const int nig = WGM * nN, gid = wgid / nig, fm = gid * WGM, gsz = (nM - fm) < WGM ? (nM - fm) : WGM;
        u.pm = fm + ((wgid % nig) % gsz); u.pn = (wgid % nig) / gsz; return true;
    }
    __device__ __forceinline__ void a_ready(const Unit&) const {}
    __device__ __forceinline__ void done(const Unit&) const {}
};
template <int N0, int N1, int N2> struct SkewOrder {
    int nM, nN, nwg, G, c;
    __host__ __device__ void init(int M, int N, int G_, int c_) { nM = M / BM; nN = N / BM; nwg = nM * nN; G = G_; c = c_; }
    __host__ __device__ bool next(int i, Unit& u) const {
        long L;
        if (G == 256 && nwg == 128 * N0 + 64 * N1 + 64 * N2) {
            if (c < 128) { if (i >= N0) return false; L = i * 128 + c; }
            else if (c < 192) { if (i >= N1) return false; L = N0 * 128 + i * 64 + (c - 128); }
            else { if (i >= N2) return false; L = N0 * 128 + N1 * 64 + i * 64 + (c - 192); }
        } else { L = (long)i * G + c; if (L >= nwg) return false; }
        int wgid = (int)L; { const int q = nwg / NXCD, r = nwg % NXCD, xcd = wgid % NXCD, off = wgid / NXCD; wgid = (xcd < r ? xcd * (q + 1) : r * (q + 1) + (xcd - r) * q) + off; }
        const int nig = WGM * nN, gid = wgid / nig, fm = gid * WGM, gsz = (nM - fm) < WGM ? (nM - fm) : WGM;
        u.pm = fm + ((wgid % nig) % gsz); u.pn = (wgid % nig) / gsz; return true;
    }
    __device__ __forceinline__ void a_ready(const Unit&) const {}
    __device__ __forceinline__ void done(const Unit&) const {}
};
template <class F> struct EpiG {
    static constexpr bool PERM = true, AFTER_DRAIN = false;
    F f;
    __device__ __forceinline__ void operator()(const f32x4 (&acc)[2][2][4][2], const Unit& u, int wr, int wc, int fr, int fq) const {
        const int row0 = u.pm * BM + wr * 64 + fr, col0 = u.pn * BM + wc * 32 + 8 * fq;
#pragma unroll
        for (int ai = 0; ai < 2; ++ai)
#pragma unroll
            for (int m = 0; m < 4; ++m) {
                const int row = row0 + ai * HALF + m * 16;
#pragma unroll
                for (int bj = 0; bj < 2; ++bj) {
                    float v[8]; const f32x4 a0 = acc[ai][bj][m][0], a1 = acc[ai][bj][m][1];
                    v[0] = a0[0]; v[1] = a0[1]; v[2] = a0[2]; v[3] = a0[3]; v[4] = a1[0]; v[5] = a1[1]; v[6] = a1[2]; v[7] = a1[3];
                    f(row, col0 + bj * HALF, v);
                }
                asm volatile("" ::: "memory");
            }
    }
};

template <class Epi, class Sched, bool ALIGN_EPI = false, bool SP2 = false, bool PERMA = false>
__device__ __forceinline__ void gemm_phase(LAS unsigned char* lds, const Gemm g, const Sched& S, const Epi& E) {
    const int tid = threadIdx.x, wid = __builtin_amdgcn_readfirstlane(tid >> 6), lane = tid & 63, wr = wid >> 2, wc = wid & 3, fr = lane & 15, fq = lane >> 4;
    const int K = g.K, nt = K / BK;
    unsigned voffA[2], voffB[2];
#pragma unroll
    for (int i = 0; i < 2; ++i) { int R, C; stage_rc(tid * 16 + i * 8192, R, C); const int Rb = Epi::PERM ? ((R & ~31) + perm32(R & 31)) : R;
        const int Ra = PERMA ? ((R & 64) | ((R & 15) << 2) | ((R >> 4) & 3)) : R;
        voffA[i] = (unsigned)(Ra * g.lda + C) * 2u; voffB[i] = (unsigned)(Rb * g.ldb + C) * 2u; }
    const size_t kstep = (size_t)(BK * 2);
    const size_t hstepA = (size_t)HALF * g.lda * 2, hstepB = (size_t)HALF * g.ldb * 2;
    const size_t tstepA = 2 * hstepA, tstepB = 2 * hstepB;
    const unsigned ldsw = (unsigned)wid * 1024u;
    const int aoff = lds_byte(wr * 64 + fr, fq * 8), boff = lds_byte(wc * 32 + fr, fq * 8);
#define PG8_SA(b, h) (((b) * 2 + (h)) * HTB)
#define PG8_SB(b, h) ((4 + (b) * 2 + (h)) * HTB)
#define PG8_STAGE(bufoff, gbase, voff) do { _Pragma("unroll") for (int _i = 0; _i < 2; ++_i) \
        __builtin_amdgcn_global_load_lds((const unsigned*)((const char*)(gbase) + (voff)[_i]), (LAS unsigned*)(lds + (bufoff) + ldsw + _i * 8192), 16, 0, 0); } while (0)
#define PG8_LDA(dst, b, h) do { _Pragma("unroll") for (int m = 0; m < 4; ++m) _Pragma("unroll") for (int k = 0; k < 2; ++k) dst[m][k] = *(const LAS bf16x8*)(lds + PG8_SA(b, h) + aoff + m * 2048 + k * 1024); } while (0)
#define PG8_LDB(dst, b, h) do { _Pragma("unroll") for (int n = 0; n < 2; ++n) _Pragma("unroll") for (int k = 0; k < 2; ++k) dst[n][k] = *(const LAS bf16x8*)(lds + PG8_SB(b, h) + boff + n * 2048 + k * 1024); } while (0)
#define PG8_MMA(ai, bj, At, Bt) do { __builtin_amdgcn_s_setprio(1); _Pragma("unroll") for (int m = 0; m < 4; ++m) _Pragma("unroll") for (int n = 0; n < 2; ++n) _Pragma("unroll") for (int k = 0; k < 2; ++k) \
        acc[ai][bj][m][n] = __builtin_amdgcn_mfma_f32_16x16x32_bf16(Bt[n][k], At[m][k], acc[ai][bj][m][n], 0, 0, 0); __builtin_amdgcn_s_setprio(0); } while (0)
#define PG8_WAIT_V(n) asm volatile("s_waitcnt vmcnt(" #n ")" ::: "memory")
#define PG8_WAIT_L(n) asm volatile("s_waitcnt lgkmcnt(" #n ")" ::: "memory")
#define PG8_BAR __builtin_amdgcn_s_barrier()
#define PG8_SCHED __builtin_amdgcn_sched_barrier(0)
    Unit cur, nxt; int ui = 0;
    if (!S.next(0, cur)) return;
    f32x4 acc[2][2][4][2];
#pragma unroll
    for (int a = 0; a < 2; ++a)
#pragma unroll
        for (int b = 0; b < 2; ++b)
#pragma unroll
            for (int m = 0; m < 4; ++m)
#pragma unroll
                for (int n = 0; n < 2; ++n) acc[a][b][m][n] = (f32x4){0.f, 0.f, 0.f, 0.f};
    bf16x8 At[4][2], B0[2][2], B1[2][2];
    const char* cA = (const char*)g.A + (size_t)cur.pm * tstepA; const char* cB = (const char*)g.Bt + (size_t)cur.pn * tstepB;
    S.a_ready(cur);
    if constexpr (SP2) {
        PG8_STAGE(PG8_SB(0, 0), cB, voffB); PG8_STAGE(PG8_SB(0, 1), cB + hstepB, voffB); PG8_STAGE(PG8_SA(0, 0), cA, voffA); PG8_STAGE(PG8_SA(0, 1), cA + hstepA, voffA);
        if (wr == 1) PG8_BAR;
        PG8_WAIT_V(2); PG8_BAR;
        PG8_STAGE(PG8_SB(1, 0), cB + kstep, voffB); PG8_STAGE(PG8_SA(1, 0), cA + kstep, voffA); PG8_STAGE(PG8_SB(1, 1), cB + hstepB + kstep, voffB);
        PG8_WAIT_V(6); PG8_BAR;
    } else {
        PG8_STAGE(PG8_SB(0, 0), cB, voffB); PG8_STAGE(PG8_SA(0, 0), cA, voffA); PG8_STAGE(PG8_SB(0, 1), cB + hstepB, voffB); PG8_STAGE(PG8_SA(0, 1), cA + hstepA, voffA);
        if (wr == 1) PG8_BAR;
        PG8_WAIT_V(4); PG8_BAR;
        PG8_STAGE(PG8_SB(1, 0), cB + kstep, voffB); PG8_STAGE(PG8_SA(1, 0), cA + kstep, voffA); PG8_STAGE(PG8_SB(1, 1), cB + hstepB + kstep, voffB);
        PG8_WAIT_V(6); PG8_BAR;
    }
    for (;;) {
        const bool has_next = S.next(ui + 1, nxt);
        const char* nA = has_next ? (const char*)g.A + (size_t)nxt.pm * tstepA : cA; const char* nB = has_next ? (const char*)g.Bt + (size_t)nxt.pn * tstepB : cB;
#pragma unroll 1
        for (int t = 0; t < nt; t += 2) {
            const bool last = (t == nt - 2);
            const char* a1 = cA + (size_t)(t + 1) * kstep;
            const char* a2 = last ? nA : cA + (size_t)(t + 2) * kstep; const char* b2 = last ? nB : cB + (size_t)(t + 2) * kstep;
            const char* a3 = a2 + kstep; const char* b3 = b2 + kstep;
            if (last && has_next) S.a_ready(nxt);
            if constexpr (SP2) {
            PG8_LDB(B0, 0, 0); PG8_LDB(B1, 0, 1); PG8_SCHED; PG8_LDA(At, 0, 0); PG8_STAGE(PG8_SA(1, 1), a1 + hstepA, voffA);
            PG8_WAIT_V(8); PG8_WAIT_L(0); PG8_BAR; PG8_MMA(0, 0, At, B0); PG8_MMA(0, 1, At, B1); PG8_BAR; PG8_SCHED;
            PG8_LDA(At, 0, 1); PG8_STAGE(PG8_SB(0, 0), b2, voffB); PG8_STAGE(PG8_SB(0, 1), b2 + hstepB, voffB); PG8_STAGE(PG8_SA(0, 0), a2, voffA);
            PG8_WAIT_V(8); PG8_WAIT_L(0); PG8_BAR; PG8_MMA(1, 0, At, B0); PG8_MMA(1, 1, At, B1); PG8_BAR; PG8_SCHED;
            PG8_LDB(B0, 1, 0); PG8_LDB(B1, 1, 1); PG8_SCHED; PG8_LDA(At, 1, 0); PG8_STAGE(PG8_SA(0, 1), a2 + hstepA, voffA);
            PG8_WAIT_V(8); PG8_WAIT_L(0); PG8_BAR; PG8_MMA(0, 0, At, B0); PG8_MMA(0, 1, At, B1); PG8_BAR; PG8_SCHED;
            PG8_LDA(At, 1, 1); PG8_STAGE(PG8_SB(1, 0), b3, voffB); PG8_STAGE(PG8_SB(1, 1), b3 + hstepB, voffB); PG8_STAGE(PG8_SA(1, 0), a3, voffA);
            PG8_WAIT_V(8); PG8_WAIT_L(0); PG8_BAR; PG8_MMA(1, 0, At, B0); PG8_MMA(1, 1, At, B1); PG8_BAR; PG8_SCHED;
            } else {
            PG8_LDB(B0, 0, 0); PG8_SCHED; PG8_LDA(At, 0, 0); PG8_STAGE(PG8_SA(1, 1), a1 + hstepA, voffA);
            PG8_WAIT_L(8); PG8_BAR; PG8_WAIT_L(0); PG8_MMA(0, 0, At, B0); PG8_BAR; PG8_SCHED;
            PG8_LDB(B1, 0, 1); PG8_STAGE(PG8_SB(0, 0), b2, voffB);
            PG8_BAR; PG8_WAIT_L(0); PG8_MMA(0, 1, At, B1); PG8_BAR;
            PG8_LDA(At, 0, 1); PG8_STAGE(PG8_SA(0, 0), a2, voffA);
            PG8_BAR; PG8_WAIT_L(0); PG8_MMA(1, 0, At, B0); PG8_BAR; PG8_SCHED;
            PG8_STAGE(PG8_SB(0, 1), b2 + hstepB, voffB);
            PG8_WAIT_V(6); PG8_BAR; PG8_MMA(1, 1, At, B1); PG8_BAR;
            PG8_LDB(B0, 1, 0); PG8_SCHED; PG8_LDA(At, 1, 0); PG8_STAGE(PG8_SA(0, 1), a2 + hstepA, voffA);
            PG8_WAIT_L(8); PG8_BAR; PG8_WAIT_L(0); PG8_MMA(0, 0, At, B0); PG8_BAR; PG8_SCHED;
            PG8_LDB(B1, 1, 1); PG8_STAGE(PG8_SB(1, 0), b3, voffB);
            PG8_BAR; PG8_WAIT_L(0); PG8_MMA(0, 1, At, B1); PG8_BAR;
            PG8_LDA(At, 1, 1); PG8_STAGE(PG8_SA(1, 0), a3, voffA);
            PG8_BAR; PG8_WAIT_L(0); PG8_MMA(1, 0, At, B0); PG8_BAR; PG8_SCHED;
            PG8_STAGE(PG8_SB(1, 1), b3 + hstepB, voffB);
            PG8_WAIT_V(6); PG8_BAR; PG8_MMA(1, 1, At, B1); PG8_BAR;
            }
        }
        if constexpr (ALIGN_EPI) { if (wr == 0) PG8_BAR; }
        E(acc, cur, wr, wc, fr, fq); S.done(cur);
        if (!has_next) break;
#pragma unroll
        for (int a = 0; a < 2; ++a)
#pragma unroll
            for (int b = 0; b < 2; ++b)
#pragma unroll
                for (int m = 0; m < 4; ++m)
#pragma unroll
                    for (int n = 0; n < 2; ++n) acc[a][b][m][n] = (f32x4){0.f, 0.f, 0.f, 0.f};
        cur = nxt; cA = nA; cB = nB; ++ui;
        if constexpr (ALIGN_EPI) { if (wr == 1) PG8_BAR; }
    }
    PG8_WAIT_V(0);
    if constexpr (!ALIGN_EPI) { if (wr == 0) PG8_BAR; }
    PG8_BAR;
#undef PG8_SA
#undef PG8_SB
#undef PG8_STAGE
#undef PG8_LDA
#undef PG8_LDB
#undef PG8_MMA
#undef PG8_WAIT_V
#undef PG8_WAIT_L
#undef PG8_BAR
#undef PG8_SCHED
}
}
#define PG8_SP2 true
#define PG8_ALIGN true

struct FProj {
    bf16* mla; bf16* rw; bf16* gate;
    __device__ __forceinline__ void operator()(int row, int col, const float (&v)[8]) const {
        bf16* p;
        if (col < W_MLA) p = mla + (size_t)row * W_MLA + col;
        else if (col < W_MLA + W_RW) p = rw + (size_t)row * W_RW + (col - W_MLA);
        else p = gate + (size_t)row * W_GATE + (col - W_MLA - W_RW);
        store8(p, v);
    }
};
struct FStore {
    bf16* O; int ldc;
    __device__ __forceinline__ void operator()(int row, int col, const float (&v)[8]) const { store8(O + (size_t)row * ldc + col, v); }
};
struct FQ {
    bf16* Q; const float* rstd; const float* rc; const float* rs;
    __device__ __forceinline__ void operator()(int row, int col, const float (&v)[8]) const {
        const float s = rstd[row]; float o[8];
        const int c = col % 192;
        if (c >= 128) {
            const int j0 = ((c - 128) >> 3) * 4, pos = row & (SEQ - 1);
            const f32x4 cs = *(const f32x4*)(rc + pos * 32 + j0), sn = *(const f32x4*)(rs + pos * 32 + j0);
#pragma unroll
            for (int i = 0; i < 4; ++i) { const float x1 = v[i] * s, x2 = v[4 + i] * s; o[i] = x1 * cs[i] - x2 * sn[i]; o[4 + i] = x2 * cs[i] + x1 * sn[i]; }
        } else {
#pragma unroll
            for (int i = 0; i < 8; ++i) o[i] = v[i] * s;
        }
        store8(Q + (size_t)row * QW + col, o);
    }
};
struct FKV {
    bf16* KF; bf16* V; const float* rstd;
    __device__ __forceinline__ void operator()(int row, int col, const float (&v)[8]) const {
        const float s = rstd[row]; float o[8];
#pragma unroll
        for (int i = 0; i < 8; ++i) o[i] = v[i] * s;
        const int hh = col >> 8, w = col & 255;
        bf16* p = (w < 128) ? KF + (size_t)row * KFW + hh * 192 + w : V + (size_t)row * VW + hh * 128 + (w - 128);
        store8(p, o);
    }
};
struct FLora {
    bf16* O; const float* w0; const float* a0; int col0;
    __device__ __forceinline__ void operator()(int row, int colr, const float (&v)[8]) const {
        float o[8]; const int col = colr + col0;
        if (col < 4096) {
            const float* b = (col < 2048) ? w0 + col : a0 + (col - 2048);
            const f32x4 b0 = *(const f32x4*)b, b1 = *(const f32x4*)(b + 4);
#pragma unroll
            for (int i = 0; i < 4; ++i) { o[i] = sigmoidf_(v[i] + b0[i]); o[4 + i] = sigmoidf_(v[4 + i] + b1[i]); }
        } else {
#pragma unroll
            for (int i = 0; i < 8; ++i) o[i] = v[i];
        }
        store8(O + (size_t)row * LORA_N + col, o);
    }
};
struct FMergeA {
    bf16* MG; const bf16* gate;
    __device__ __forceinline__ void operator()(int row, int col, const float (&v)[8]) const {
        float gt[8], o[8]; load8(gate + (size_t)row * W_GATE + col, gt);
#pragma unroll
        for (int i = 0; i < 8; ++i) o[i] = sigmoidf_(gt[i]) * v[i];
        store8(MG + (size_t)row * DM + col, o);
    }
};
struct FMergeB {
    bf16* MG; const bf16* gate;
    __device__ __forceinline__ void operator()(int row, int col, const float (&v)[8]) const {
        float gt[8], o[8], m[8]; load8(gate + (size_t)row * W_GATE + DM + col, gt); load8(MG + (size_t)row * DM + col, m);
#pragma unroll
        for (int i = 0; i < 8; ++i) o[i] = m[i] + sigmoidf_(gt[i]) * v[i];
        store8(MG + (size_t)row * DM + col, o);
    }
};
struct FResid {
    const float* xin; float* out; const float* gt;
    __device__ __forceinline__ void operator()(int row, int col, const float (&v)[8]) const {
        const float* gp = gt + (size_t)(row >> 12) * NMOD + col;
        const f32x4 g0 = *(const f32x4*)gp, g1 = *(const f32x4*)(gp + 4);
        const float* xp = xin + (size_t)row * DM + col;
        const f32x4 x0 = *(const f32x4*)xp, x1 = *(const f32x4*)(xp + 4);
        f32x4 o0, o1;
#pragma unroll
        for (int i = 0; i < 4; ++i) { o0[i] = x0[i] + g0[i] * v[i]; o1[i] = x1[i] + g1[i] * v[4 + i]; }
        float* op = out + (size_t)row * DM + col;
        *(f32x4*)op = o0; *(f32x4*)(op + 4) = o1;
    }
};
struct EpiResid {
    static constexpr bool PERM = true, AFTER_DRAIN = false;
    FResid f;
    __device__ __forceinline__ void operator()(const f32x4 (&acc)[2][2][4][2], const pg8::Unit& u, int wr, int wc, int fr, int fq) const {
        const int row0 = u.pm * pg8::BM + wr * 64 + fr, col0 = u.pn * pg8::BM + wc * 32 + 8 * fq;
        const float* gp = f.gt + (size_t)(row0 >> 12) * NMOD + col0;
        f32x4 g[2][2], xc[2][2], xn[2][2];
#pragma unroll
        for (int bj = 0; bj < 2; ++bj) { g[bj][0] = *(const f32x4*)(gp + bj * pg8::HALF); g[bj][1] = *(const f32x4*)(gp + bj * pg8::HALF + 4); }
        { const float* xp = f.xin + (size_t)row0 * DM + col0;
#pragma unroll
          for (int bj = 0; bj < 2; ++bj) { xc[bj][0] = *(const f32x4*)(xp + bj * pg8::HALF); xc[bj][1] = *(const f32x4*)(xp + bj * pg8::HALF + 4); } }
#pragma unroll
        for (int s = 0; s < 8; ++s) {
            const int ai = s >> 2, m = s & 3, row = row0 + ai * pg8::HALF + m * 16;
            if (s + 1 < 8) { const int rown = row0 + ((s + 1) >> 2) * pg8::HALF + ((s + 1) & 3) * 16; const float* xp = f.xin + (size_t)rown * DM + col0;
#pragma unroll
                for (int bj = 0; bj < 2; ++bj) { xn[bj][0] = *(const f32x4*)(xp + bj * pg8::HALF); xn[bj][1] = *(const f32x4*)(xp + bj * pg8::HALF + 4); } }
            float* op = f.out + (size_t)row * DM + col0;
#pragma unroll
            for (int bj = 0; bj < 2; ++bj) {
                const f32x4 a0 = acc[ai][bj][m][0], a1 = acc[ai][bj][m][1]; f32x4 o0, o1;
#pragma unroll
                for (int i = 0; i < 4; ++i) { o0[i] = xc[bj][0][i] + g[bj][0][i] * a0[i]; o1[i] = xc[bj][1][i] + g[bj][1][i] * a1[i]; }
                *(f32x4*)(op + bj * pg8::HALF) = o0; *(f32x4*)(op + bj * pg8::HALF + 4) = o1;
            }
            if (s + 1 < 8) {
#pragma unroll
                for (int bj = 0; bj < 2; ++bj) { xc[bj][0] = xn[bj][0]; xc[bj][1] = xn[bj][1]; } }
        }
    }
};

__device__ __forceinline__ float dpp_shr1(float x) { return __builtin_bit_cast(float, __builtin_amdgcn_update_dpp(0, __builtin_bit_cast(int, x), 0x111, 0xF, 0xF, true)); }
__device__ __forceinline__ float dpp_shl1(float x) { return __builtin_bit_cast(float, __builtin_amdgcn_update_dpp(0, __builtin_bit_cast(int, x), 0x101, 0xF, 0xF, true)); }
struct EpiAct {
    static constexpr bool PERM = true, AFTER_DRAIN = false;
    bf16* ACT; bf16* EA; bf16* EB; const float* cw; const float* cb;
    __device__ __forceinline__ void operator()(const f32x4 (&acc)[2][2][4][2], const pg8::Unit& u, int wr, int wc, int fr, int fq) const {
        const int j0 = u.pn * 128 + wc * 32 + 8 * fq;
        float w0[8], w1[8], w2[8], bb[8];
#pragma unroll
        for (int h = 0; h < 2; ++h) { const f32x4 x0 = *(const f32x4*)(cw + j0 + 4 * h), x1 = *(const f32x4*)(cw + DFF + j0 + 4 * h), x2 = *(const f32x4*)(cw + 2 * DFF + j0 + 4 * h), x3 = *(const f32x4*)(cb + j0 + 4 * h);
#pragma unroll
            for (int i = 0; i < 4; ++i) { w0[4 * h + i] = x0[i]; w1[4 * h + i] = x1[i]; w2[4 * h + i] = x2[i]; bb[4 * h + i] = x3[i]; } }
#pragma unroll
        for (int ai = 0; ai < 2; ++ai) {
            float av[4][8], bv[4][8];
#pragma unroll
            for (int m = 0; m < 4; ++m)
#pragma unroll
                for (int i = 0; i < 4; ++i) { av[m][i] = acc[ai][0][m][0][i]; av[m][4 + i] = acc[ai][0][m][1][i]; bv[m][i] = acc[ai][1][m][0][i]; bv[m][4 + i] = acc[ai][1][m][1][i]; }
            float ap[8], an[8];
#pragma unroll
            for (int i = 0; i < 8; ++i) { ap[i] = dpp_shr1(av[3][i]); an[i] = dpp_shl1(av[0][i]); }
            const int blk = ai * 2 + wr; const size_t tok0 = (size_t)u.pm * 256 + blk * 64 + 4 * fr;
#pragma unroll
            for (int m = 0; m < 4; ++m) {
                float o[8];
#pragma unroll
                for (int i = 0; i < 8; ++i) { const float xm = (m == 0) ? ap[i] : av[m == 0 ? 0 : m - 1][i], xp = (m == 3) ? an[i] : av[m == 3 ? 3 : m + 1][i];
                    const float c = w0[i] * xm + w1[i] * av[m][i] + w2[i] * xp + bb[i]; o[i] = c * sigmoidf_(c) * bv[m][i]; }
                store8(ACT + (tok0 + m) * DFF + j0, o);
            }
            const size_t eb = ((size_t)u.pm * 4 + blk);
            if (fr == 0) { store8(EA + (eb * 4 + 0) * DFF + j0, av[0]); store8(EA + (eb * 4 + 1) * DFF + j0, av[1]); store8(EB + (eb * 2 + 0) * DFF + j0, bv[0]); }
            if (fr == 15) { store8(EA + (eb * 4 + 2) * DFF + j0, av[2]); store8(EA + (eb * 4 + 3) * DFF + j0, av[3]); store8(EB + (eb * 2 + 1) * DFF + j0, bv[3]); }
            asm volatile("" ::: "memory");
        }
    }
};

namespace att {
constexpr int DQK = 192, DV = 128, NW = 8, QBLK = 32, KVBLK = 64;
constexpr float SCALE = 0.07216878364870322f;
constexpr float THR = 8.f;
constexpr int LDQ = QW, LDK = KFW, LDV = VW, LDO = 1024;
constexpr int SHM_V = KVBLK * DV * 2, SHM_K = KVBLK * DQK * 2, SHM_ATTN = 2 * SHM_V + 2 * SHM_K + NW * 64 * 4;
#define KSWZ(row, colB) ((row) * 384 + ((colB) ^ (((row) & 7) << 4)))
#define SBAR() __builtin_amdgcn_sched_barrier(0)
__device__ __forceinline__ int crow(int r, int hi) { return (r & 3) + 8 * (r >> 2) + 4 * hi; }
__device__ __forceinline__ void partialSM(f32x16& p0, f32x16& p1, float& m_reg, float& mn, float& alpha) {
    constexpr float C = SCALE * 1.4426950408889634f;
    float pmax = p0[0];
#pragma unroll
    for (int r = 1; r < 16; ++r) pmax = fmaxf(pmax, p0[r]);
#pragma unroll
    for (int r = 0; r < 16; ++r) pmax = fmaxf(pmax, p1[r]);
    { auto rr = __builtin_amdgcn_permlane32_swap(__float_as_uint(pmax), __float_as_uint(pmax), false, false);
      pmax = fmaxf(__uint_as_float(rr[0]), __uint_as_float(rr[1])); }
    if (__builtin_expect(__all(pmax - m_reg <= THR / SCALE), 1)) { mn = m_reg; alpha = 1.f; }
    else { mn = fmaxf(m_reg, pmax); alpha = __builtin_amdgcn_exp2f((m_reg - mn) * C); m_reg = mn; }
    const float mnC = -mn * C;
#pragma unroll
    for (int r = 0; r < 16; ++r) p0[r] = fmaf(p0[r], C, mnC);
#pragma unroll
    for (int r = 0; r < 16; ++r) p1[r] = fmaf(p1[r], C, mnC);
#pragma unroll
    for (int r = 0; r < 16; ++r) p0[r] = __builtin_amdgcn_exp2f(p0[r]);
}
__device__ __forceinline__ void finishSM(f32x16& p0, f32x16& p1, float alpha, float& l_reg, bf16x8& pa0, bf16x8& pa1, bf16x8& pa2, bf16x8& pa3) {
#pragma unroll
    for (int r = 0; r < 16; ++r) p1[r] = __builtin_amdgcn_exp2f(p1[r]);
    float ps = 0;
#pragma unroll
    for (int r = 0; r < 16; ++r) ps += p0[r];
#pragma unroll
    for (int r = 0; r < 16; ++r) ps += p1[r];
    { auto rr = __builtin_amdgcn_permlane32_swap(__float_as_uint(ps), __float_as_uint(ps), false, false);
      ps = __uint_as_float(rr[0]) + __uint_as_float(rr[1]); }
    l_reg = l_reg * alpha + ps;
#define PK4(P, BASE, OUT) do { unsigned a0 = cvt_pk_bf16(P[BASE + 0], P[BASE + 1]), a1 = cvt_pk_bf16(P[BASE + 2], P[BASE + 3]);   \
    unsigned b0 = cvt_pk_bf16(P[BASE + 4], P[BASE + 5]), b1 = cvt_pk_bf16(P[BASE + 6], P[BASE + 7]);                              \
    auto r0 = __builtin_amdgcn_permlane32_swap(a0, b0, false, false); auto r1 = __builtin_amdgcn_permlane32_swap(a1, b1, false, false); \
    u32x4 w = {r0[0], r1[0], r0[1], r1[1]}; OUT = __builtin_bit_cast(bf16x8, w); } while (0)
    PK4(p0, 0, pa0); PK4(p0, 8, pa1); PK4(p1, 0, pa2); PK4(p1, 8, pa3);
#undef PK4
}
__device__ __forceinline__ void qkt(f32x16& p0, f32x16& p1, const LAS char* Ks, const bf16x8* qr, int r32, int hi) {
    p0 = f32x16{}; p1 = f32x16{};
#pragma unroll
    for (int d0 = 0; d0 < 12; ++d0) { const int cb = (d0 * 16 + hi * 8) * 2;
        const bf16x8 b0 = *(const LAS bf16x8*)(Ks + KSWZ(r32, cb));
        const bf16x8 b1 = *(const LAS bf16x8*)(Ks + KSWZ(32 + r32, cb));
        p0 = __builtin_amdgcn_mfma_f32_32x32x16_bf16(b0, qr[d0], p0, 0, 0, 0);
        p1 = __builtin_amdgcn_mfma_f32_32x32x16_bf16(b1, qr[d0], p1, 0, 0, 0); }
}
__device__ __forceinline__ int v_st(int k, int c) { const int kk = (k & ~0xC) | ((k & 4) << 1) | ((k & 8) >> 1); return ((kk >> 3) * 4 + (c >> 5)) * 512 + ((kk & 7) * 32 + (c & 31)) * 2; }
__device__ __forceinline__ int v_rd_base(int lane) { return ((lane & 3) << 3) | (((lane >> 2) & 3) << 6) | (((lane >> 4) & 1) << 5) | (((lane >> 5) & 1) << 8); }
constexpr int v_rd_off(int d0, int ks, int half) { return d0 * 512 + ks * 4096 + half * 2048; }
template <int OFF> __device__ __forceinline__ s16x4 tr_read(int vb) {
    s16x4 r; asm volatile("ds_read_b64_tr_b16 %0, %1 offset:%2" : "=&v"(r) : "v"(vb), "i"(OFF) : "memory"); return r;
}
template <int D0> __device__ __forceinline__ void pv_one(f32x16& od, int vb, bf16x8 pa0, bf16x8 pa1, bf16x8 pa2, bf16x8 pa3) {
    const s16x4 l0 = tr_read<v_rd_off(D0, 0, 0)>(vb), h0 = tr_read<v_rd_off(D0, 0, 1)>(vb), l1 = tr_read<v_rd_off(D0, 1, 0)>(vb), h1 = tr_read<v_rd_off(D0, 1, 1)>(vb);
    const s16x4 l2 = tr_read<v_rd_off(D0, 2, 0)>(vb), h2 = tr_read<v_rd_off(D0, 2, 1)>(vb), l3 = tr_read<v_rd_off(D0, 3, 0)>(vb), h3 = tr_read<v_rd_off(D0, 3, 1)>(vb);
    asm volatile("s_waitcnt lgkmcnt(0)" ::: "memory"); SBAR();
#define PK(L, H) (bf16x8){L[0], L[1], L[2], L[3], H[0], H[1], H[2], H[3]}
    od = __builtin_amdgcn_mfma_f32_32x32x16_bf16(pa0, PK(l0, h0), od, 0, 0, 0);
    od = __builtin_amdgcn_mfma_f32_32x32x16_bf16(pa1, PK(l1, h1), od, 0, 0, 0);
    od = __builtin_amdgcn_mfma_f32_32x32x16_bf16(pa2, PK(l2, h2), od, 0, 0, 0);
    od = __builtin_amdgcn_mfma_f32_32x32x16_bf16(pa3, PK(l3, h3), od, 0, 0, 0);
#undef PK
}
__device__ __forceinline__ void pv_d0(f32x16* o, int vb, bf16x8 pa0, bf16x8 pa1, bf16x8 pa2, bf16x8 pa3) {
    pv_one<0>(o[0], vb, pa0, pa1, pa2, pa3); pv_one<1>(o[1], vb, pa0, pa1, pa2, pa3); pv_one<2>(o[2], vb, pa0, pa1, pa2, pa3); pv_one<3>(o[3], vb, pa0, pa1, pa2, pa3);
}
__device__ __forceinline__ void attn_unit(const bf16* __restrict__ Qb, const bf16* __restrict__ Kh, const bf16* __restrict__ Vh, bf16* __restrict__ Ob, int seq, LAS char* lds) {
    const int tid = threadIdx.x, wid = tid >> 6, lane = tid & 63, r32 = lane & 31, hi = lane >> 5;
    LAS char* V_lds = lds; LAS char* K_lds = lds + 2 * SHM_V;
    LAS float* ws = (LAS float*)(lds + 2 * SHM_V + 2 * SHM_K) + wid * 64; LAS float* li_l = ws; LAS float* al_l = ws + 32;
    float m_reg = -1e30f, l_reg = 0; f32x16 o[4] = {}; bf16x8 qr[12];
    const bf16* Qw = Qb + (long)(wid * QBLK + r32) * LDQ + hi * 8;
#pragma unroll
    for (int d0 = 0; d0 < 12; ++d0) qr[d0] = *(const bf16x8*)(Qw + d0 * 16);
    const int sr = tid >> 4, sc = (tid & 15) * 8, vst0 = v_st(sr, sc), vst1 = v_st(32 + sr, sc);
    const int krow0 = tid >> 3, kch0 = tid & 7;
    const int vb0 = (int)(unsigned)(uintptr_t)V_lds + v_rd_base(lane);
    bf16x8 vs0, vs1, ks0, ks1, ks2;
#define SLOAD(k0) do { vs0 = *(const bf16x8*)(&Vh[(long)((k0) + sr) * LDV + sc]); vs1 = *(const bf16x8*)(&Vh[(long)((k0) + 32 + sr) * LDV + sc]); \
    { const bf16* kp_ = &Kh[(long)((k0) + krow0) * LDK + kch0 * 8]; ks0 = *(const bf16x8*)kp_; ks1 = *(const bf16x8*)(kp_ + 64); ks2 = *(const bf16x8*)(kp_ + 128); } } while (0)
#define SWRITE(b) do { *(LAS bf16x8*)(V_lds + (b) * SHM_V + vst0) = vs0; *(LAS bf16x8*)(V_lds + (b) * SHM_V + vst1) = vs1; \
    *(LAS bf16x8*)(K_lds + (b) * SHM_K + KSWZ(krow0, kch0 * 16)) = ks0; *(LAS bf16x8*)(K_lds + (b) * SHM_K + KSWZ(krow0, (kch0 + 8) * 16)) = ks1; \
    *(LAS bf16x8*)(K_lds + (b) * SHM_K + KSWZ(krow0, (kch0 + 16) * 16)) = ks2; } while (0)
#define RESC(a) do { if (__any((a) < 1.f)) { if (hi == 0) al_l[r32] = (a); asm volatile("s_waitcnt lgkmcnt(0)" ::: "memory"); \
    _Pragma("unroll") for (int d = 0; d < 4; ++d) _Pragma("unroll") for (int r = 0; r < 16; ++r) o[d][r] *= al_l[crow(r, hi)]; } } while (0)
    f32x16 p0, p1; float mn, al; bf16x8 pa0, pa1, pa2, pa3; const int NT = seq / KVBLK;
    SLOAD(0); VM_WAIT(); SWRITE(0); __syncthreads();
    for (int j = 0; j < NT; ++j) {
        const int b = j & 1;
        if (j + 1 < NT) SLOAD((j + 1) * KVBLK);
        SBAR(); qkt(p0, p1, K_lds + b * SHM_K, qr, r32, hi);
        partialSM(p0, p1, m_reg, mn, al);
        finishSM(p0, p1, al, l_reg, pa0, pa1, pa2, pa3); SBAR();
        RESC(al);
        pv_d0(o, vb0 + b * SHM_V, pa0, pa1, pa2, pa3);
        if (j + 1 < NT) { VM_WAIT(); SWRITE(b ^ 1); }
        __syncthreads();
    }
    if (hi == 0) li_l[r32] = l_reg; asm volatile("s_waitcnt lgkmcnt(0)" ::: "memory");
    float rli[16];
#pragma unroll
    for (int r = 0; r < 16; ++r) rli[r] = __builtin_amdgcn_rcpf(li_l[crow(r, hi)]);
    LAS char* ost = lds + wid * (QBLK * 272);
#pragma unroll
    for (int r = 0; r < 16; ++r) { const int orow = crow(r, hi);
#pragma unroll
        for (int d0 = 0; d0 < 4; ++d0) *(LAS bf16*)(ost + orow * 272 + (d0 * 32 + r32) * 2) = (bf16)(cvt_pk_bf16(o[d0][r] * rli[r], 0.f) & 0xffffu); }
    asm volatile("s_waitcnt lgkmcnt(0)" ::: "memory");
    bf16* Ow = Ob + (long)(wid * QBLK) * LDO;
#pragma unroll
    for (int i = 0; i < 8; ++i) { const int id = lane + 64 * i, orow = id >> 4, ch = id & 15;
        *(u32x4*)(Ow + (long)orow * LDO + ch * 8) = *(const LAS u32x4*)(ost + orow * 272 + ch * 16); }
    __syncthreads();
#undef SLOAD
#undef SWRITE
#undef RESC
}
}

#define XB_TMO      128
#define XB_XCNT(j)  (256  + 64 * (j))
#define XB_XSUB(j)  (1280 + 64 * (j))
#define XB_XGEN(j)  (2304 + 64 * (j))
#define XB_TOP      3328
#define XB_TOPGEN   3392
#define XCD_BAR_WORDS 3456
#define XB_SPIN_CAP (1u << 22)
__device__ __forceinline__ unsigned xb_ld(unsigned* p)              { return __hip_atomic_load(p, __ATOMIC_RELAXED, __HIP_MEMORY_SCOPE_AGENT); }
__device__ __forceinline__ unsigned xb_add(unsigned* p, unsigned v) { return __hip_atomic_fetch_add(p, v, __ATOMIC_RELAXED, __HIP_MEMORY_SCOPE_AGENT); }
__device__ __forceinline__ unsigned xb_xcc_id() { return (unsigned)__builtin_amdgcn_s_getreg((3 << 11) | 20) & 0xFu; }
#define XB_SPIN(cond, bar) do { unsigned _sp = 0; while (cond) { __builtin_amdgcn_s_sleep(1); \
    if ((++_sp & 255u) == 0u) { if (xb_ld(&(bar)[XB_TMO])) break; if (_sp > XB_SPIN_CAP) { atomicAdd(&(bar)[XB_TMO], 1u); break; } } } } while (0)
struct XcdBarrier { unsigned* bar; unsigned x; volatile LAS unsigned* st; };
__device__ __forceinline__ XcdBarrier xcd_barrier_post(unsigned* bar, volatile LAS unsigned* st) {
    XcdBarrier b; b.bar = bar; b.x = xb_xcc_id(); b.st = st;
    if (threadIdx.x == 0) (void)xb_add(&bar[XB_XCNT(b.x)], 1u);
    return b;
}
__device__ __forceinline__ void xcd_barrier_complete(unsigned* bar, unsigned x, unsigned& nloc, unsigned& nx) {
    const unsigned G = gridDim.x * gridDim.y * gridDim.z;
    unsigned sum, cnt, mine, sp = 0u;
    for (;;) {
        sum = 0u; cnt = 0u; mine = 0u;
#pragma unroll
        for (unsigned j = 0; j < 16; ++j) { const unsigned c = xb_ld(&bar[XB_XCNT(j)]); sum += c; cnt += (c > 0u) ? 1u : 0u; mine = (j == x) ? c : mine; }
        if (sum == G) break;
        __builtin_amdgcn_s_sleep(1);
        if ((++sp & 255u) == 0u) { if (xb_ld(&bar[XB_TMO])) break; if (sp > XB_SPIN_CAP) { atomicAdd(&bar[XB_TMO], 1u); break; } }
    }
    nloc = mine > 0u ? mine : 1u; nx = cnt > 0u ? cnt : 1u;
}
__device__ __forceinline__ void xcd_barrier(const XcdBarrier& b) {
    asm volatile("s_waitcnt vmcnt(0)" ::: "memory");
    __syncthreads();
    if (threadIdx.x == 0) {
        unsigned* bar = b.bar;
        __builtin_amdgcn_s_waitcnt(0);
        unsigned nloc = b.st[0], nx = b.st[1];
        if (nloc == 0u) { xcd_barrier_complete(bar, b.x, nloc, nx); b.st[0] = nloc; b.st[1] = nx; }
        const unsigned old = xb_add(&bar[XB_XSUB(b.x)], 1u);
        const unsigned gen = old / nloc;
        if (old + 1u == (gen + 1u) * nloc) {
            __builtin_amdgcn_fence(__ATOMIC_RELEASE, "agent");
            asm volatile("s_waitcnt vmcnt(0)" ::: "memory");
            const unsigned og = xb_add(&bar[XB_TOP], 1u);
            const unsigned tg = og / nx;
            if (og + 1u == (tg + 1u) * nx) xb_add(&bar[XB_TOPGEN], 1u);
            else XB_SPIN(xb_ld(&bar[XB_TOPGEN]) == tg, bar);
            __builtin_amdgcn_fence(__ATOMIC_ACQUIRE, "agent");
            xb_add(&bar[XB_XGEN(b.x)], 1u);
            asm volatile("s_waitcnt vmcnt(0)" ::: "memory");
        } else {
            XB_SPIN(xb_ld(&bar[XB_XGEN(b.x)]) == gen, bar);
            __builtin_amdgcn_fence(__ATOMIC_ACQUIRE, "agent");
            asm volatile("s_waitcnt vmcnt(0)" ::: "memory");
        }
    }
    __syncthreads();
}

struct Args {
    const float* in[32];
    float* out; unsigned char* ws;
    int lo, hi, pad0, pad1;
};
enum { I_XP = 0, I_XS, I_CP, I_CS, I_ADAW, I_ADAB, I_NMIXG, I_WIN, I_QNG, I_WUQ, I_KVNG, I_WUKV, I_WOATT, I_MU, I_W0, I_WDEC, I_A0, I_WICLR, I_WGATE,
       I_KK, I_KA, I_RK, I_GNG, I_GNB, I_WORWKV, I_WOUT, I_NFFNG, I_WUP, I_CONVW, I_CONVB, I_WDOWN, I_FNG };

constexpr int ARGTAB_OFF = MISC_OFF + 256;
struct Ctx { LAS unsigned char* lds; int tid, lane, wave, gw, ngw; };
struct PT {
    LAS unsigned char* lds; int toff;
    __device__ __forceinline__ explicit PT(const Ctx& C) { lds = C.lds; int t = ARGTAB_OFF; asm volatile("" : "+s"(t)); toff = t; }
    __device__ __forceinline__ unsigned long long raw(int i) const { const LAS unsigned* p = (const LAS unsigned*)(lds + toff) + 2 * i;
        const unsigned lo = __builtin_amdgcn_readfirstlane(p[0]), hi = __builtin_amdgcn_readfirstlane(p[1]); return ((unsigned long long)hi << 32) | lo; }
    __device__ __forceinline__ const float* in(int i) const { return (const float*)raw(i); }
    __device__ __forceinline__ float* out() const { return (float*)raw(32); }
    __device__ __forceinline__ unsigned char* ws() const { return (unsigned char*)raw(33); }
};

__device__ __forceinline__ void phase_mod(const Ctx& C) {
    const PT a(C);
    float* mod = (float*)(a.ws() + WS_MOD);
    LAS float* sil = (LAS float*)C.lds;
    for (int u = blockIdx.x; u < 192; u += gridDim.x) {
        const int cu = u % 96, kh = u / 96, l = cu / 48, n0 = (cu % 48) * 256;
        for (int i = C.tid; i < 1024 * 12; i += 512) { const int kk = i / 12, s = i % 12;
            const float c = (s < 8) ? a.in(I_CP)[s * DM + kh * 1024 + kk] : a.in(I_CS)[(s - 8) * DM + kh * 1024 + kk];
            sil[i] = c / (1.f + __expf(-c)); }
        __syncthreads();
        f32x4 acc[12];
#pragma unroll
        for (int s = 0; s < 12; ++s) acc[s] = (f32x4){0.f, 0.f, 0.f, 0.f};
        const int kb = C.wave * 128;
        const float* wp = a.in(I_ADAW) + ((size_t)l * DM + kh * 1024 + kb) * NMOD + n0 + C.lane * 4;
        for (int kk = 0; kk < 128; kk += 4) {
            f32x4 wv[4];
#pragma unroll
            for (int i = 0; i < 4; ++i) wv[i] = *(const f32x4*)(wp + (size_t)(kk + i) * NMOD);
#pragma unroll
            for (int i = 0; i < 4; ++i) {
                const LAS f32x4* sp = (const LAS f32x4*)(sil + (kb + kk + i) * 12);
                const f32x4 s0 = sp[0], s1 = sp[1], s2 = sp[2];
                acc[0] += wv[i] * s0[0]; acc[1] += wv[i] * s0[1]; acc[2] += wv[i] * s0[2]; acc[3] += wv[i] * s0[3];
                acc[4] += wv[i] * s1[0]; acc[5] += wv[i] * s1[1]; acc[6] += wv[i] * s1[2]; acc[7] += wv[i] * s1[3];
                acc[8] += wv[i] * s2[0]; acc[9] += wv[i] * s2[1]; acc[10] += wv[i] * s2[2]; acc[11] += wv[i] * s2[3];
            }
        }
        __syncthreads();
        LAS f32x4* part = (LAS f32x4*)C.lds;
#pragma unroll
        for (int s = 0; s < 12; ++s) part[(C.wave * 12 + s) * 64 + C.lane] = acc[s];
        __syncthreads();
        for (int i = C.tid; i < 12 * 64; i += 512) {
            f32x4 t = part[i];
#pragma unroll
            for (int w = 1; w < 8; ++w) t += part[w * 12 * 64 + i];
            const int s_ = i >> 6, ln = i & 63;
            if (kh == 0) t += *(const f32x4*)(a.in(I_ADAB) + (size_t)l * NMOD + n0 + ln * 4);
            float* mp = mod + ((size_t)l * 12 + s_) * NMOD + n0 + ln * 4;
#pragma unroll
            for (int j = 0; j < 4; ++j) __hip_atomic_fetch_add(mp + j, t[j], __ATOMIC_RELAXED, __HIP_MEMORY_SCOPE_AGENT);
        }
        __syncthreads();
    }
    float* rc = (float*)(a.ws() + WS_ROPE); float* rs = rc + SEQ * 32;
    for (int i = blockIdx.x * 512 + C.tid; i < SEQ * 32; i += gridDim.x * 512) {
        const int pos = i >> 5, j = i & 31;
        const double inv = 1.0 / pow(10000.0, (double)j / 32.0), ang = (double)pos * inv;
        rc[i] = (float)cos(ang); rs[i] = (float)sin(ang);
    }
}

constexpr f32x4 ZERO4 = {0.f, 0.f, 0.f, 0.f};
template <class Get> __device__ __forceinline__ void tr_tile(const Get& get, bf16* WT, int ldt, int n0, int k0, LAS float* T, int tid) {
    const int n4 = (tid & 63) * 4, kq = tid >> 6;
    f32x4 v[8];
#pragma unroll
    for (int i = 0; i < 8; ++i) v[i] = get.get4(n0 + n4, k0 + kq + 8 * i);
#pragma unroll
    for (int i = 0; i < 8; ++i) *(LAS f32x4*)(T + (kq + 8 * i) * 260 + n4) = v[i];
    __syncthreads();
    const int n = tid >> 1, kh = (tid & 1) * 32;
#pragma unroll
    for (int j = 0; j < 4; ++j) { const LAS float* t = T + (kh + 8 * j) * 260 + n;
        u32x4 o; o.x = cvt_pk_bf16(t[0], t[260]); o.y = cvt_pk_bf16(t[2 * 260], t[3 * 260]); o.z = cvt_pk_bf16(t[4 * 260], t[5 * 260]); o.w = cvt_pk_bf16(t[6 * 260], t[7 * 260]);
        *(u32x4*)(WT + (size_t)(n0 + n) * ldt + k0 + kh + 8 * j) = o; }
    __syncthreads();
}
struct GetPlain { const float* W; int ldw; __device__ __forceinline__ f32x4 get4(int n, int k) const { return *(const f32x4*)(W + (size_t)k * ldw + n); } };
struct GetWin { const float* W; __device__ __forceinline__ f32x4 get4(int n, int k) const {
    int s;
    if (n < 832) s = n; else if (n < W_MLA) s = -1; else if (n < W_MLA + RWIN) s = 832 + (n - W_MLA); else if (n < W_MLA + W_RW) s = -1; else s = 4320 + (n - W_MLA - W_RW);
    return s < 0 ? ZERO4 : *(const f32x4*)(W + (size_t)k * DIN + s); } };
struct GetUq { const float* W; const float* g; __device__ __forceinline__ f32x4 get4(int n, int k) const {
    const int hh = n / 192, c = n % 192; int s;
    if (c < 128) s = hh * 192 + c; else { const int p = c - 128, grp = p >> 3, w = p & 7; s = hh * 192 + 128 + (w >> 2) * 32 + grp * 4; }
    return *(const f32x4*)(W + (size_t)k * QW + s) * g[k]; } };
struct GetUp { const float* W; __device__ __forceinline__ f32x4 get4(int n, int k) const {
    const int t = n >> 8, w = n & 255; const int sc = (w < 128) ? t * 128 + w : DFF + t * 128 + (w - 128); return *(const f32x4*)(W + (size_t)k * (2 * DFF) + sc); } };
struct GetUkv { const float* W; const float* g; __device__ __forceinline__ f32x4 get4(int n, int k) const { return *(const f32x4*)(W + (size_t)k * 2048 + n) * g[k]; } };
struct GetLora { const float* wdec; const float* wiclr; const float* wgate;
    __device__ __forceinline__ f32x4 get4(int n, int k) const {
        if (n < 2048) { const int d = n >> 10, c = n & 1023, kk = k - d * 64; return (kk >= 0 && kk < 64) ? *(const f32x4*)(wdec + ((size_t)d * 64 + kk) * 1024 + c) : ZERO4; }
        if (n < 4096) { const int d = (n - 2048) >> 10, c = n & 1023, kk = k - 128 - d * 64; return (kk >= 0 && kk < 64) ? *(const f32x4*)(wiclr + ((size_t)d * 64 + kk) * 1024 + c) : ZERO4; }
        const int c = n - 4096; return (k < 160) ? *(const f32x4*)(wgate + (size_t)k * 1024 + c) : ZERO4; } };

__device__ __forceinline__ void phase_convert(const Ctx& C, int l) {
    const PT a(C);
    LAS float* T = (LAS float*)C.lds;
    bf16* wb = (bf16*)(a.ws() + WS_W);
    constexpr int I0 = (NPROJ / 256) * (DM / 64), I1 = (QW / 256) * (512 / 64), I2 = (2048 / 256) * (256 / 64), I3 = (DM / 256) * (1024 / 64), I4 = I3,
                  I5 = (DM / 256) * (DM / 64), I6 = (2 * DFF / 256) * (DM / 64), I7 = (DM / 256) * (DFF / 64), I8 = (LORA_N / 256) * (LORA_KB / 64);
    constexpr int NIT = I0 + I1 + I2 + I3 + I4 + I5 + I6 + I7 + I8;
    for (int it = blockIdx.x; it < NIT; it += gridDim.x) {
        int r = it;
#define ITEM(CNT, GET, OFF, KD) if (r < (CNT)) { const int nblk_k = (KD) / 64; const int nb = r / nblk_k, kb = r % nblk_k; tr_tile(GET, (bf16*)((char*)wb + (OFF)), (KD), nb * 256, kb * 64, T, C.tid); continue; } r -= (CNT);
        ITEM(I0, (GetWin{a.in(I_WIN) + (size_t)l * DM * DIN}), WO_IN, DM)
        ITEM(I1, (GetUq{a.in(I_WUQ) + (size_t)l * 512 * QW, a.in(I_QNG) + l * 512}), WO_UQ, 512)
        ITEM(I2, (GetUkv{a.in(I_WUKV) + (size_t)l * 256 * 2048, a.in(I_KVNG) + l * 256}), WO_UKV, 256)
        ITEM(I3, (GetPlain{a.in(I_WOATT) + (size_t)l * 1024 * DM, DM}), WO_OATT, 1024)
        ITEM(I4, (GetPlain{a.in(I_WORWKV) + (size_t)l * 1024 * DM, DM}), WO_ORWKV, 1024)
        ITEM(I5, (GetPlain{a.in(I_WOUT) + (size_t)l * DM * DM, DM}), WO_OUT, DM)
        ITEM(I6, (GetUp{a.in(I_WUP) + (size_t)l * DM * 2 * DFF}), WO_UP, DM)
        ITEM(I7, (GetPlain{a.in(I_WDOWN) + (size_t)l * DFF * DM, DM}), WO_DOWN, DFF)
        ITEM(I8, (GetLora{a.in(I_WDEC) + (size_t)l * 2 * 64 * 1024, a.in(I_WICLR) + (size_t)l * 2 * 64 * 1024, a.in(I_WGATE) + (size_t)l * 160 * 1024}), WO_LORA, LORA_KB)
#undef ITEM
    }
}

__device__ __forceinline__ void phase_modnorm(const Ctx& C, int gw, int ngw, const float* xsrc, bf16* H, const float* g, const float* modb, int ksh, int ksc) {
    const int per = GROWS / ngw, r0 = gw * per;
    const float* mb = modb + (size_t)(r0 >> 12) * NMOD;
    f32x4 gm[8], sh[8];
#pragma unroll
    for (int j = 0; j < 8; ++j) { const int c = 256 * j + 4 * C.lane; const f32x4 gg = *(const f32x4*)(g + c), sc = *(const f32x4*)(mb + ksc * DM + c); sh[j] = *(const f32x4*)(mb + ksh * DM + c);
#pragma unroll
        for (int i = 0; i < 4; ++i) gm[j][i] = gg[i] * (1.f + sc[i]); }
    for (int row = r0; row < r0 + per; row += 2) {
        f32x4 v[2][8];
#pragma unroll
        for (int k = 0; k < 2; ++k)
#pragma unroll
            for (int j = 0; j < 8; ++j) v[k][j] = *(const f32x4*)(xsrc + (size_t)(row + k) * DM + 256 * j + 4 * C.lane);
#pragma unroll
        for (int k = 0; k < 2; ++k) {
            float ss = 0.f;
#pragma unroll
            for (int j = 0; j < 8; ++j) ss += (v[k][j][0] * v[k][j][0] + v[k][j][1] * v[k][j][1]) + (v[k][j][2] * v[k][j][2] + v[k][j][3] * v[k][j][3]);
            const float rstd = rsqrtf(wave_sum(ss) * (1.f / DM) + 1e-6f);
#pragma unroll
            for (int j = 0; j < 8; ++j) { const int c = 256 * j + 4 * C.lane;
                f32x4 y;
#pragma unroll
                for (int i = 0; i < 4; ++i) y[i] = v[k][j][i] * rstd * gm[j][i] + sh[j][i];
                u32x2 w; w.x = cvt_pk_bf16(y[0], y[1]); w.y = cvt_pk_bf16(y[2], y[3]);
                *(u32x2*)(H + (size_t)(row + k) * DM + c) = w; }
        }
    }
}
__device__ __forceinline__ void phase_final(const Ctx& C, int gw, int ngw, int row_lo, int row_hi, float* out, const float* g) {
    f32x4 gv[8];
#pragma unroll
    for (int j = 0; j < 8; ++j) gv[j] = *(const f32x4*)(g + 256 * j + 4 * C.lane);
    for (int row = row_lo + gw; row < row_hi; row += 2 * ngw) {
        const int row2 = row + ngw; const bool two = row2 < row_hi;
        float* xr[2] = {out + (size_t)row * DM, out + (size_t)(two ? row2 : row) * DM};
        f32x4 v[2][8];
#pragma unroll
        for (int k = 0; k < 2; ++k)
#pragma unroll
            for (int j = 0; j < 8; ++j) v[k][j] = *(const f32x4*)(xr[k] + 256 * j + 4 * C.lane);
#pragma unroll
        for (int k = 0; k < 2; ++k) {
            if (k == 1 && !two) break;
            float ss = 0.f;
#pragma unroll
            for (int j = 0; j < 8; ++j) ss += (v[k][j][0] * v[k][j][0] + v[k][j][1] * v[k][j][1]) + (v[k][j][2] * v[k][j][2] + v[k][j][3] * v[k][j][3]);
            const float rstd = rsqrtf(wave_sum(ss) * (1.f / DM) + 1e-6f);
#pragma unroll
            for (int j = 0; j < 8; ++j) { const int c = 256 * j + 4 * C.lane;
                f32x4 y;
#pragma unroll
                for (int i = 0; i < 4; ++i) y[i] = v[k][j][i] * rstd * gv[j][i];
                *(f32x4*)(xr[k] + c) = y; }
        }
    }
}
__device__ __forceinline__ void phase_prep(const Ctx& C, int l) {
    const PT a(C);
    const bf16* PRW = (const bf16*)(a.ws() + A_PRW); const bf16* PMLA = (const bf16*)(a.ws() + A_PMLA);
    bf16* AL = (bf16*)(a.ws() + A_ALORA); bf16* KF = (bf16*)(a.ws() + A_KF);
    float* rstd_q = (float*)(a.ws() + WS_RSTD); float* rstd_kv = rstd_q + GROWS;
    const float* rc = (const float*)(a.ws() + WS_ROPE); const float* rs = rc + SEQ * 32;
    const float* mu0 = a.in(I_MU) + (size_t)l * 2 * RWIN; const float* mu1 = mu0 + RWIN;
    const int lane = C.lane;
    constexpr int RB = 8, NU = GROWS / RB;
    for (int u = C.gw; u < NU; u += C.ngw) {
        const int r0 = u * RB, t0 = r0 & (SEQ - 1), c0 = (384 + lane) * 8;
        const bool act = lane < 52;
        float m0[8], m1[8];
#pragma unroll
        for (int i = 0; i < 8; ++i) { m0[i] = 0.f; m1[i] = 0.f; }
        if (act) {
#pragma unroll
            for (int h = 0; h < 2; ++h) { const f32x4 x0 = *(const f32x4*)(mu0 + c0 + 4 * h), x1 = *(const f32x4*)(mu1 + c0 + 4 * h);
#pragma unroll
                for (int i = 0; i < 4; ++i) { m0[4 * h + i] = x0[i]; m1[4 * h + i] = x1[i]; } }
        }
        const bf16* xr = PRW + (size_t)r0 * W_RW + c0;
        u32x4 rwn[RB + 2];
        rwn[0] = (u32x4){0u, 0u, 0u, 0u}; rwn[RB + 1] = (u32x4){0u, 0u, 0u, 0u};
        if (t0 > 0) rwn[0] = *(const u32x4*)(xr - W_RW);
#pragma unroll
        for (int r = 0; r < RB; ++r) rwn[r + 1] = *(const u32x4*)(xr + (size_t)r * W_RW);
        if (t0 + RB < SEQ) rwn[RB + 1] = *(const u32x4*)(xr + (size_t)RB * W_RW);
#pragma unroll
        for (int r = 0; r < RB; ++r) {
            const int row = r0 + r;
            float xp[8], x[8], xn[8], p[8], o[8];
            unpack8(rwn[r], xp); unpack8(rwn[r + 1], x); unpack8(rwn[r + 2], xn);
#pragma unroll
            for (int i = 0; i < 8; ++i) p[i] = x[i] + m0[i] * (xp[i] - x[i]) + m1[i] * (xn[i] - x[i]);
            if (lane < 16) {
#pragma unroll
                for (int i = 0; i < 8; ++i) o[i] = tanhf(p[i]);
                store8(AL + (size_t)row * LORA_K + lane * 8, o);
            } else if (lane < 32) { store8(AL + (size_t)row * LORA_K + 128 + (lane - 16) * 8, p); }
            else if (lane < 52) {
#pragma unroll
                for (int i = 0; i < 8; ++i) o[i] = sigmoidf_(p[i]);
                store8(AL + (size_t)row * LORA_K + 256 + (lane - 32) * 8, o);
            } else {
#pragma unroll
                for (int i = 0; i < 8; ++i) o[i] = 0.f;
                store8(AL + (size_t)row * LORA_K + 416 + (lane - 52) * 8, o);
            }
        }
    }
    for (int row0 = C.gw * 4; row0 < GROWS; row0 += C.ngw * 4) {
        u32x4 qv[4], kv4[4]; u32x2 w1[4], w2[4];
#pragma unroll
        for (int j = 0; j < 4; ++j) { const bf16* mr = PMLA + (size_t)(row0 + j) * W_MLA;
            qv[j] = *(const u32x4*)(mr + lane * 8); kv4[j] = *(const u32x4*)(mr + 512 + (lane & 31) * 8);
            w1[j] = *(const u32x2*)(mr + 768 + 4 * (lane & 7)); w2[j] = *(const u32x2*)(mr + 800 + 4 * (lane & 7)); }
#pragma unroll
        for (int j = 0; j < 4; ++j) {
            const int row = row0 + j, t = row & (SEQ - 1);
            { float q[8]; unpack8(qv[j], q); float ss = 0.f;
#pragma unroll
              for (int i = 0; i < 8; ++i) ss += q[i] * q[i];
              ss = wave_sum(ss); if (lane == 0) rstd_q[row] = rsqrtf(ss * (1.f / 512.f) + 1e-6f); }
            { float q[8]; unpack8(kv4[j], q); float ss = 0.f;
#pragma unroll
              for (int i = 0; i < 8; ++i) ss += q[i] * q[i];
              ss = wave_sum(lane < 32 ? ss : 0.f); if (lane == 0) rstd_kv[row] = rsqrtf(ss * (1.f / 256.f) + 1e-6f); }
            if (lane < 8) {
                const float x1[4] = {bf_lo(w1[j].x), bf_hi(w1[j].x), bf_lo(w1[j].y), bf_hi(w1[j].y)}, x2[4] = {bf_lo(w2[j].x), bf_hi(w2[j].x), bf_lo(w2[j].y), bf_hi(w2[j].y)};
                const f32x4 cs = *(const f32x4*)(rc + t * 32 + 4 * lane), sn = *(const f32x4*)(rs + t * 32 + 4 * lane);
                float o[8];
#pragma unroll
                for (int i = 0; i < 4; ++i) { o[i] = x1[i] * cs[i] - x2[i] * sn[i]; o[4 + i] = x2[i] * cs[i] + x1[i] * sn[i]; }
                const u32x4 pk = pack8(o);
#pragma unroll
                for (int hh = 0; hh < 8; ++hh) *(u32x4*)(KF + (size_t)row * KFW + hh * 192 + 128 + 8 * lane) = pk;
            }
        }
    }
}
__device__ __forceinline__ void phase_rwkv_post(const Ctx& C, int l) {
    const PT a(C);
    const bf16* OF = (const bf16*)(a.ws() + A_OF); const bf16* OB = (const bf16*)(a.ws() + A_OB); const bf16* PRW = (const bf16*)(a.ws() + A_PRW);
    const float* mu0 = a.in(I_MU) + (size_t)l * 2 * RWIN + 2048; const float* mu1 = mu0 + RWIN;
    const bf16* LO = (const bf16*)(a.ws() + A_LORAOUT); bf16* RO = (bf16*)(a.ws() + A_RWKVO);
    const float* bonus = (const float*)(a.ws() + WS_BONUS);
    const float* gng = a.in(I_GNG) + l * 1024; const float* gnb = a.in(I_GNB) + l * 1024;
    const int lane = C.lane;
    f32x4 maK[2], mbK[2], naK[2], nbK[2], g0K[2], g1K[2], b0K[2], b1K[2];
#pragma unroll
    for (int it = 0; it < 2; ++it) { const int c0 = (it * 64 + lane) * 8;
        maK[it] = *(const f32x4*)(mu0 + c0); mbK[it] = *(const f32x4*)(mu0 + c0 + 4); naK[it] = *(const f32x4*)(mu1 + c0); nbK[it] = *(const f32x4*)(mu1 + c0 + 4);
        g0K[it] = *(const f32x4*)(gng + c0); g1K[it] = *(const f32x4*)(gng + c0 + 4); b0K[it] = *(const f32x4*)(gnb + c0); b1K[it] = *(const f32x4*)(gnb + c0 + 4); }
    for (int row = C.gw; row < GROWS; row += C.ngw) {
        const int t = row & (SEQ - 1);
        u32x4 ofv[2], obv[2], xv[2], xpv[2], xnv[2], ggv[2]; float bnv[2];
#pragma unroll
        for (int it = 0; it < 2; ++it) {
            const int c0 = (it * 64 + lane) * 8, hh = c0 >> 6; const bf16* vr = PRW + (size_t)row * W_RW + 2048 + c0;
            ofv[it] = *(const u32x4*)(OF + (size_t)row * 1024 + c0); obv[it] = *(const u32x4*)(OB + (size_t)row * 1024 + c0);
            xv[it] = *(const u32x4*)vr; xpv[it] = *(const u32x4*)(t > 0 ? vr - W_RW : vr); xnv[it] = *(const u32x4*)(t < SEQ - 1 ? vr + W_RW : vr);
            ggv[it] = *(const u32x4*)(LO + (size_t)row * LORA_N + 4096 + c0);
            bnv[it] = bonus[(size_t)row * 16 + hh] + bonus[(size_t)(GROWS + row) * 16 + hh]; }
#pragma unroll
        for (int it = 0; it < 2; ++it) {
            const int c0 = (it * 64 + lane) * 8;
            float of[8], ob[8], o[8], vv[8], gg[8];
            unpack8(ofv[it], of); unpack8(obv[it], ob);
            { float x[8], xp[8], xn[8]; unpack8(xv[it], x); unpack8(xpv[it], xp); unpack8(xnv[it], xn);
              const f32x4 ma = maK[it], mb = mbK[it], na = naK[it], nb = nbK[it];
              const float zp = t > 0 ? 1.f : 0.f, zn = t < SEQ - 1 ? 1.f : 0.f;
#pragma unroll
              for (int i = 0; i < 4; ++i) { vv[i] = x[i] + ma[i] * (xp[i] * zp - x[i]) + na[i] * (xn[i] * zn - x[i]); vv[4 + i] = x[4 + i] + mb[i] * (xp[4 + i] * zp - x[4 + i]) + nb[i] * (xn[4 + i] * zn - x[4 + i]); } }
            unpack8(ggv[it], gg);
            float s = 0.f;
#pragma unroll
            for (int i = 0; i < 8; ++i) { o[i] = of[i] + ob[i]; s += o[i]; }
            const float mean = reduce8(s) * (1.f / 64.f);
            float q = 0.f;
#pragma unroll
            for (int i = 0; i < 8; ++i) { o[i] -= mean; q += o[i] * o[i]; }
            const float rstd = rsqrtf(reduce8(q) * (1.f / 64.f) + 64e-5f);
            const float bn = bnv[it];
            const f32x4 g0 = g0K[it], g1 = g1K[it], b0 = b0K[it], b1 = b1K[it];
            float y[8];
#pragma unroll
            for (int i = 0; i < 4; ++i) { y[i] = (o[i] * rstd * g0[i] + b0[i] + bn * vv[i]) * gg[i]; y[4 + i] = (o[4 + i] * rstd * g1[i] + b1[i] + bn * vv[4 + i]) * gg[4 + i]; }
            store8(RO + (size_t)row * 1024 + c0, y);
        }
    }
}
__device__ __forceinline__ void phase_act_fix(const Ctx& C, int l) {
    const PT a(C);
    const bf16* EA = (const bf16*)(a.ws() + A_EA); const bf16* EB = (const bf16*)(a.ws() + A_EB); bf16* ACT = (bf16*)(a.ws() + A_ACT);
    const float* cw = a.in(I_CONVW) + (size_t)l * 3 * DFF; const float* cb = a.in(I_CONVB) + (size_t)l * DFF;
    constexpr int NT = GROWS / 256, NR = NT * 8;
    for (int u4 = C.gw; u4 < NR * 4; u4 += C.ngw) {
        const int u = u4 >> 2, part = u4 & 3;
        const int tile = u >> 3, blk = (u >> 1) & 3, e = u & 1;
        const size_t eb = (size_t)tile * 4 + blk, tok = (size_t)tile * 256 + blk * 64 + (e ? 63 : 0);
        const bf16* ac = EA + (eb * 4 + (e ? 3 : 0)) * DFF; const bf16* bc = EB + (eb * 2 + e) * DFF;
        const bf16* apv; const bf16* anx; float zp = 1.f, zn = 1.f;
        if (e == 0) { anx = EA + (eb * 4 + 1) * DFF;
            if (blk > 0) apv = EA + ((eb - 1) * 4 + 3) * DFF; else if ((tile & 15) != 0) apv = EA + ((eb - 1) * 4 + 3) * DFF; else { apv = ac; zp = 0.f; } }
        else { apv = EA + (eb * 4 + 2) * DFF;
            if (blk < 3) anx = EA + ((eb + 1) * 4 + 0) * DFF; else if ((tile & 15) != 15) anx = EA + ((eb + 1) * 4 + 0) * DFF; else { anx = ac; zn = 0.f; } }
#pragma unroll 1
        for (int it = part; it < 11; it += 4) {
            const int c0 = (it * 64 + C.lane) * 8;
            float x[8], xp[8], xn[8], b[8], o[8];
            load8(ac + c0, x); load8(apv + c0, xp); load8(anx + c0, xn); load8(bc + c0, b);
#pragma unroll
            for (int h = 0; h < 2; ++h) {
                const f32x4 w0 = *(const f32x4*)(cw + c0 + 4 * h), w1 = *(const f32x4*)(cw + DFF + c0 + 4 * h), w2 = *(const f32x4*)(cw + 2 * DFF + c0 + 4 * h), bb = *(const f32x4*)(cb + c0 + 4 * h);
#pragma unroll
                for (int i = 0; i < 4; ++i) { const int j = 4 * h + i; const float cc = xp[j] * zp * w0[i] + x[j] * w1[i] + xn[j] * zn * w2[i] + bb[i]; o[j] = cc * sigmoidf_(cc) * b[j]; }
            }
            store8(ACT + tok * DFF + c0, o);
        }
    }
}

constexpr int SCAN_T = 32, SCAN_STEP_F = 384, SCAN_BUF_F = SCAN_T * SCAN_STEP_F;
static_assert((2 * SCAN_BUF_F + 2 * SCAN_T * 64) * 4 + 2 * 2 * SCAN_T * 64 * 2 <= RING_BYTES, "scan LDS");
__device__ __forceinline__ void scan_chain(const Ctx& C, int l, int ch) {
    const PT a(C);
    const bf16* PRW = (const bf16*)(a.ws() + A_PRW); const bf16* AL = (const bf16*)(a.ws() + A_ALORA);
    float* bonus = (float*)(a.ws() + WS_BONUS);
    LAS float* buf = (LAS float*)C.lds;
    LAS float* obuf = buf + 2 * SCAN_BUF_F;
    LAS bf16* xs = (LAS bf16*)(obuf + 2 * SCAN_T * 64);
    const int tid = C.tid, lane = C.lane;
    const int d = ch & 1, hh = (ch >> 1) & 15, sq = ch >> 5;
    bf16* OD = (bf16*)(a.ws() + (d ? A_OB : A_OF));
    const bool loader = tid >= 256;
    const int lid = tid - 256, lj = lid >> 3, lg = lid & 7, chn = hh * 64 + lg * 8;
    float ka[8], rk[8], kkw[8], m0r[8], m1r[8], m0k[8], m1k[8], m0v[8], m1v[8];
    u32x4 g_r, g_rp, g_rn, g_k, g_kp, g_kn, g_v, g_vp, g_vn;
    const int mtx = (C.wave >> 1) & 1, nb = C.wave & 1, r32 = lane & 31, hi = lane >> 5;
    bf16x8 Bf[4]; float lbias = 0.f;
    if (loader) {
        const float* Wm = (mtx ? a.in(I_WICLR) : a.in(I_WDEC)) + (size_t)(l * 2 + d) * 64 * 1024 + hh * 64 + nb * 32 + r32;
#pragma unroll
        for (int ks = 0; ks < 4; ++ks) { float t_[8];
#pragma unroll
            for (int j = 0; j < 8; ++j) t_[j] = Wm[(size_t)(ks * 16 + hi * 8 + j) * 1024];
            Bf[ks] = __builtin_bit_cast(bf16x8, pack8(t_)); }
        lbias = (mtx ? a.in(I_A0) : a.in(I_W0))[l * 2048 + d * 1024 + hh * 64 + nb * 32 + r32];
    }
    if (loader) {
        const float* mu0 = a.in(I_MU) + (size_t)l * 2 * RWIN; const float* mu1 = mu0 + RWIN;
#define LD8F(dst, p) do { const f32x4 x0_ = *(const f32x4*)(p), x1_ = *(const f32x4*)((p) + 4); _Pragma("unroll") for (int i = 0; i < 4; ++i) { dst[i] = x0_[i]; dst[4 + i] = x1_[i]; } } while (0)
        LD8F(ka, a.in(I_KA) + l * 1024 + chn); LD8F(rk, a.in(I_RK) + ((size_t)(l * 2 + d) * 16 + hh) * 64 + lg * 8); LD8F(kkw, a.in(I_KK) + l * 1024 + chn);
        LD8F(m0r, mu0 + chn); LD8F(m1r, mu1 + chn); LD8F(m0k, mu0 + 1024 + chn); LD8F(m1k, mu1 + 1024 + chn); LD8F(m0v, mu0 + 2048 + chn); LD8F(m1v, mu1 + 2048 + chn);
#undef LD8F
    }
#define SC_TOK(step) (d ? (SEQ - 1 - (step)) : (step))
#define SC_ISSUE(cn) do { const int tok_ = SC_TOK((cn) * SCAN_T + lj), row_ = sq * SEQ + tok_; const bf16* rp_ = PRW + (size_t)row_ * W_RW + chn; \
        const int op_ = tok_ > 0 ? -W_RW : 0, on_ = tok_ < SEQ - 1 ? W_RW : 0; \
        g_r = *(const u32x4*)rp_; g_rp = *(const u32x4*)(rp_ + op_); g_rn = *(const u32x4*)(rp_ + on_); g_k = *(const u32x4*)(rp_ + 1024); g_kp = *(const u32x4*)(rp_ + 1024 + op_); g_kn = *(const u32x4*)(rp_ + 1024 + on_); \
        g_v = *(const u32x4*)(rp_ + 2048); g_vp = *(const u32x4*)(rp_ + 2048 + op_); g_vn = *(const u32x4*)(rp_ + 2048 + on_); } while (0)
#define ST8(p, x) do { *(LAS f32x4*)(p) = (f32x4){x[0], x[1], x[2], x[3]}; *(LAS f32x4*)((p) + 4) = (f32x4){x[4], x[5], x[6], x[7]}; } while (0)
#define SC_MIX(dst, gc, gp, gn, m0, m1) do { float x_[8], xp_[8], xn_[8]; unpack8(gc, x_); unpack8(gp, xp_); unpack8(gn, xn_); \
        _Pragma("unroll") for (int i = 0; i < 8; ++i) dst[i] = x_[i] + m0[i] * (xp_[i] * zp_ - x_[i]) + m1[i] * (xn_[i] * zn_ - x_[i]); } while (0)
#define SC_WRITE(cn) do { float r_[8], k_[8], v_[8], kk_[8], w_[8], a_[8]; unpack8(*(const LAS u32x4*)(xs + (((cn) & 1) * 2 + 0) * 2048 + lj * 64 + lg * 8), w_); unpack8(*(const LAS u32x4*)(xs + (((cn) & 1) * 2 + 1) * 2048 + lj * 64 + lg * 8), a_); \
        { const int tok_ = SC_TOK((cn) * SCAN_T + lj); const float zp_ = tok_ > 0 ? 1.f : 0.f, zn_ = tok_ < SEQ - 1 ? 1.f : 0.f; \
          SC_MIX(r_, g_r, g_rp, g_rn, m0r, m1r); SC_MIX(k_, g_k, g_kp, g_kn, m0k, m1k); SC_MIX(v_, g_v, g_vp, g_vn, m0v, m1v); \
          float ss_ = 0.f; _Pragma("unroll") for (int i = 0; i < 8; ++i) { kk_[i] = k_[i] * kkw[i]; ss_ += kk_[i] * kk_[i]; } \
          ss_ = reduce8(ss_); const float inv_ = 1.f / fmaxf(sqrtf(ss_), 1e-12f); _Pragma("unroll") for (int i = 0; i < 8; ++i) kk_[i] *= inv_; } \
        LAS float* bp_ = buf + ((cn) & 1) * SCAN_BUF_F + lj * SCAN_STEP_F + lg * 8; float bs_ = 0.f; \
        float G_[8], kt_[8], at_[8], bt_[8], rt_[8]; \
        _Pragma("unroll") for (int i = 0; i < 8; ++i) { G_[i] = __builtin_amdgcn_exp2f(-0.8750387749f * w_[i]); const float kd_ = k_[i] * (1.f + (a_[i] - 1.f) * ka[i]); bs_ += r_[i] * kd_ * rk[i]; bt_[i] = kd_; at_[i] = kk_[i] * a_[i]; } \
        _Pragma("unroll") for (int off_ = 8; off_ < 64; off_ <<= 1) { _Pragma("unroll") for (int i = 0; i < 8; ++i) { const float y_ = __shfl_up(G_[i], off_); if (lane >= off_) G_[i] *= y_; } } \
        _Pragma("unroll") for (int i = 0; i < 8; ++i) { float gp_ = __shfl_up(G_[i], 8); if (lane < 8) gp_ = 1.f; const float rg_ = 1.f / G_[i]; kt_[i] = kk_[i] * gp_; at_[i] *= rg_; bt_[i] *= rg_; rt_[i] = r_[i] * G_[i]; } \
        ST8(bp_, G_); ST8(bp_ + 64, kt_); ST8(bp_ + 128, at_); ST8(bp_ + 192, bt_); ST8(bp_ + 256, rt_); ST8(bp_ + 320, v_); \
        bs_ = reduce8(bs_); if (lg == 0) { const int row_ = sq * SEQ + SC_TOK((cn) * SCAN_T + lj); bonus[((size_t)d * GROWS + row_) * 16 + hh] = bs_; } } while (0)
#define SC_LORA(cn) do { const bf16* ap_ = AL + (size_t)(sq * SEQ + SC_TOK((cn) * SCAN_T + r32)) * LORA_K + mtx * 128 + d * 64 + hi * 8; f32x16 acc_ = {}; \
        _Pragma("unroll") for (int ks = 0; ks < 4; ++ks) acc_ = __builtin_amdgcn_mfma_f32_32x32x16_bf16(*(const bf16x8*)(ap_ + ks * 16), Bf[ks], acc_, 0, 0, 0); \
        LAS bf16* xp_ = xs + (((cn) & 1) * 2 + mtx) * 2048 + nb * 32 + r32; \
        _Pragma("unroll") for (int r = 0; r < 16; ++r) xp_[att::crow(r, hi) * 64] = (bf16)(cvt_pk_bf16(sigmoidf_(acc_[r] + lbias), 0.f) & 0xffffu); } while (0)
#define SC_OUT(cn) do { const LAS float* op_ = obuf + ((cn) & 1) * (SCAN_T * 64) + lj * 64 + lg * 8; const f32x4 o0_ = *(const LAS f32x4*)op_, o1_ = *(const LAS f32x4*)(op_ + 4); \
        const int row_ = sq * SEQ + SC_TOK((cn) * SCAN_T + lj); u32x4 w_; w_.x = cvt_pk_bf16(o0_[0], o0_[1]); w_.y = cvt_pk_bf16(o0_[2], o0_[3]); w_.z = cvt_pk_bf16(o1_[0], o1_[1]); w_.w = cvt_pk_bf16(o1_[2], o1_[3]); \
        *(u32x4*)(OD + (size_t)row_ * 1024 + hh * 64 + lg * 8) = w_; } while (0)
    constexpr int NCH = SEQ / SCAN_T;
    const int rloc = (C.wave & 3) * 8 + (lane >> 3), cg = lane & 7;
    f32x2 s01 = {0.f, 0.f}, s23 = {0.f, 0.f}, s45 = {0.f, 0.f}, s67 = {0.f, 0.f};
    f32x2 t01 = {0.f, 0.f}, t23 = {0.f, 0.f}, t45 = {0.f, 0.f}, t67 = {0.f, 0.f};
    if (loader) SC_LORA(0);
    __syncthreads();
    if (loader) { SC_ISSUE(0); SC_WRITE(0); SC_LORA(1); }
    __syncthreads();
#pragma unroll 1
    for (int cn = 0; cn < NCH; ++cn) {
        if (loader) {
            if (cn + 1 < NCH) SC_ISSUE(cn + 1);
            if (cn + 2 < NCH) SC_LORA(cn + 2);
            if (cn > 0) SC_OUT(cn - 1);
            if (cn + 1 < NCH) SC_WRITE(cn + 1);
        } else {
            const unsigned ba = (unsigned)(uintptr_t)(buf + (cn & 1) * SCAN_BUF_F + cg * 8);
            const unsigned va = (unsigned)(uintptr_t)(buf + (cn & 1) * SCAN_BUF_F + 320 + rloc);
            LAS float* op = obuf + (cn & 1) * (SCAN_T * 64) + rloc;
#define DSR128(dst, addr, off) asm volatile("ds_read_b128 %0, %1 offset:%2" : "=v"(dst) : "v"(addr), "n"(off))
#define DSR32(dst, addr, off) asm volatile("ds_read_b32 %0, %1 offset:%2" : "=v"(dst) : "v"(addr), "n"(off))
#define SC_LDE(j) do { DSR128(Ek0, ba, (j) * 1536 + 256); DSR128(Ek1, ba, (j) * 1536 + 272); DSR128(Ed0, ba, (j) * 1536 + 768); DSR128(Ed1, ba, (j) * 1536 + 784); DSR32(Evv, va, (j) * 1536); DSR32(Evu, va, (j) * 1536 + 128); } while (0)
#define SC_LDL(j) do { DSR128(La0, ba, (j) * 1536 + 512); DSR128(La1, ba, (j) * 1536 + 528); DSR128(Lr0, ba, (j) * 1536 + 1024); DSR128(Lr1, ba, (j) * 1536 + 1040); \
        if ((((j) & 7) == 7)) { DSR128(Lg0, ba, (j) * 1536); DSR128(Lg1, ba, (j) * 1536 + 16); } } while (0)
#define LO2(v) __builtin_shufflevector(v, v, 0, 1)
#define HI2(v) __builtin_shufflevector(v, v, 2, 3)
#define SC_STEP(j) do { \
        if ((((j) & 7) == 7)) asm volatile("s_waitcnt lgkmcnt(6)" : "+v"(Ek0), "+v"(Ek1), "+v"(Ed0), "+v"(Ed1), "+v"(Evv), "+v"(Evu)); \
        else asm volatile("s_waitcnt lgkmcnt(4)" : "+v"(Ek0), "+v"(Ek1), "+v"(Ed0), "+v"(Ed1), "+v"(Evv), "+v"(Evu)); \
        if ((j) > 0) { const float q_ = reduce8(cqs_); const float qv_ = reduce8(cqt_); op[((j) - 1) * 64] = q_; op[((j) - 1) * 64 + 32] = qv_; }     \
        f32x2 pp_ = s01 * LO2(Ek0); f32x2 pu_ = t01 * LO2(Ek0); pp_ = s23 * HI2(Ek0) + pp_; pu_ = t23 * HI2(Ek0) + pu_; pp_ = s45 * LO2(Ek1) + pp_; pu_ = t45 * LO2(Ek1) + pu_; pp_ = s67 * HI2(Ek1) + pp_; pu_ = t67 * HI2(Ek1) + pu_; \
        float p_ = reduce8(pp_[0] + pp_[1]); float pq_ = reduce8(pu_[0] + pu_[1]); const f32x2 v2_ = {Evv, Evv}, u2_ = {Evu, Evu}; \
        s01 = v2_ * LO2(Ed0) + s01; s23 = v2_ * HI2(Ed0) + s23; s45 = v2_ * LO2(Ed1) + s45; s67 = v2_ * HI2(Ed1) + s67; \
        t01 = u2_ * LO2(Ed0) + t01; t23 = u2_ * HI2(Ed0) + t23; t45 = u2_ * LO2(Ed1) + t45; t67 = u2_ * HI2(Ed1) + t67; \
        asm volatile("" : "+v"(s01), "+v"(s23), "+v"(s45), "+v"(s67), "+v"(t01), "+v"(t23), "+v"(t45), "+v"(t67), "+v"(p_), "+v"(pq_));     \
        SC_LDE((j) + 1); \
        if ((((j) & 7) == 7)) asm volatile("s_waitcnt lgkmcnt(6)" : "+v"(La0), "+v"(La1), "+v"(Lr0), "+v"(Lr1), "+v"(Lg0), "+v"(Lg1)); \
        else asm volatile("s_waitcnt lgkmcnt(6)" : "+v"(La0), "+v"(La1), "+v"(Lr0), "+v"(Lr1)); \
        { const f32x2 p2_ = {p_, p_}, q2_ = {pq_, pq_}; \
        s01 = s01 - p2_ * LO2(La0); s23 = s23 - p2_ * HI2(La0); s45 = s45 - p2_ * LO2(La1); s67 = s67 - p2_ * HI2(La1); \
        t01 = t01 - q2_ * LO2(La0); t23 = t23 - q2_ * HI2(La0); t45 = t45 - q2_ * LO2(La1); t67 = t67 - q2_ * HI2(La1); } \
        f32x2 qq_ = s01 * LO2(Lr0); f32x2 qu_ = t01 * LO2(Lr0); qq_ = s23 * HI2(Lr0) + qq_; qu_ = t23 * HI2(Lr0) + qu_; qq_ = s45 * LO2(Lr1) + qq_; qu_ = t45 * LO2(Lr1) + qu_; qq_ = s67 * HI2(Lr1) + qq_; qu_ = t67 * HI2(Lr1) + qu_; \
        if ((((j) & 7) == 7)) { s01 *= LO2(Lg0); s23 *= HI2(Lg0); s45 *= LO2(Lg1); s67 *= HI2(Lg1); t01 *= LO2(Lg0); t23 *= HI2(Lg0); t45 *= LO2(Lg1); t67 *= HI2(Lg1); }     \
        asm volatile("" : "+v"(qq_), "+v"(qu_), "+v"(s01), "+v"(s23), "+v"(s45), "+v"(s67), "+v"(t01), "+v"(t23), "+v"(t45), "+v"(t67));     \
        SC_LDL((j) + 1); \
        cqs_ = qq_[0] + qq_[1]; cqt_ = qu_[0] + qu_[1]; } while (0)
            f32x4 Ek0, Ek1, Ed0, Ed1, La0, La1, Lr0, Lr1, Lg0, Lg1; float Evv, Evu; float cqs_ = 0.f, cqt_ = 0.f;
            SC_LDE(0); SC_LDL(0);
#pragma unroll
            for (int j = 0; j < SCAN_T; ++j) SC_STEP(j);
            { const float q_ = reduce8(cqs_); const float qv_ = reduce8(cqt_); op[(SCAN_T - 1) * 64] = q_; op[(SCAN_T - 1) * 64 + 32] = qv_; }
            asm volatile("s_waitcnt lgkmcnt(0)" : "+v"(Ek0), "+v"(Ek1), "+v"(Ed0), "+v"(Ed1), "+v"(Evv), "+v"(Evu), "+v"(La0), "+v"(La1), "+v"(Lr0), "+v"(Lr1), "+v"(Lg0), "+v"(Lg1));
#undef DSR128
#undef DSR32
#undef SC_LDE
#undef SC_LDL
#undef SC_STEP
#undef LO2
#undef HI2
        }
        __syncthreads();
    }
    if (loader) SC_OUT(NCH - 1);
    __syncthreads();
#undef SC_TOK
#undef SC_ISSUE
#undef SC_LORA
#undef SC_MIX
#undef SC_WRITE
#undef SC_OUT
#undef ST8
}

constexpr int NT_STEPS = 12;
constexpr int N_STEPS = 1 + NLAYER * (1 + NGRP * NT_STEPS) + 1;
#ifndef NL_BUILD
#define NL_BUILD NLAYER
#endif
#ifndef NG_BUILD
#define NG_BUILD NGRP
#endif

#define IN_STEP(k) (lo <= (sbase + (k)) && (sbase + (k)) < hi)
#define END_STEP(k) do { if (sbase + (k) + 1 < hi) { const PT pb_(C); XcdBarrier bar_; bar_.bar = (unsigned*)(pb_.ws() + WS_CTL) + CW_BAR; bar_.x = xb_xcc_id(); bar_.st = (volatile LAS unsigned*)(C.lds + MISC_OFF) + 8; xcd_barrier(bar_); } } while (0)
#define STEP_PTRS const PT a(C); unsigned char* const ws = a.ws(); (void)ws; \
    const float* const mod = (const float*)(ws + WS_MOD); bf16* const wb = (bf16*)(ws + WS_W); (void)wb; \
    const float* const xsrc = (L == 0) ? ((GI < 2) ? a.in(I_XP) + grow0 * DM : a.in(I_XS) + (grow0 - 32768) * DM) : a.out() + grow0 * DM; (void)xsrc; \
    float* const xout = a.out() + grow0 * DM; (void)xout; \
    const float* const modb = mod + ((size_t)L * 12 + GI * 4) * NMOD; (void)modb;

template <int L, int GI>
__device__ __forceinline__ void group_program(const Ctx& C, const int lo, const int hi) {
    constexpr int sbase = 1 + L * (1 + NGRP * NT_STEPS) + 1 + GI * NT_STEPS;
    constexpr size_t grow0 = (size_t)GI * GROWS;
    const int gdim = gridDim.x, bidx = blockIdx.x;
    if (EN(2) && IN_STEP(0)) { if constexpr (L == 0 && GI == 0) { REPEAT(2) { STEP_PTRS; phase_modnorm(C, C.gw, C.ngw, xsrc, (bf16*)(ws + A_H), a.in(I_NMIXG) + L * DM, modb, 0, 1); } END_STEP(0); } }
    if (EN(3) && IN_STEP(1)) { REPEAT(3) { STEP_PTRS;
        pg8::Gemm gm{(const bf16*)(ws + A_H), (const bf16*)((char*)wb + WO_IN), GROWS, NPROJ - 256, DM, DM, DM}; pg8::StaticOrder S; S.init(GROWS, NPROJ - 256, gdim, bidx);
        pg8::EpiG<FProj> E{FProj{(bf16*)(ws + A_PMLA), (bf16*)(ws + A_PRW), (bf16*)(ws + A_PGATE)}};
        pg8::gemm_phase<pg8::EpiG<FProj>, pg8::StaticOrder, PG8_ALIGN, PG8_SP2>(C.lds, gm, S, E); }
        END_STEP(1); }
    if (EN(4) && IN_STEP(2)) { REPEAT(4) { phase_prep(C, L); } END_STEP(2); }
    if (EN(5) && IN_STEP(3)) { REPEAT(5) {
        { STEP_PTRS; pg8::Gemm gm{(const bf16*)(ws + A_ALORA) + 256, (const bf16*)((char*)wb + WO_LORA) + (size_t)4096 * LORA_KB, GROWS, 1024, LORA_KB, LORA_K, LORA_KB}; pg8::StaticOrder S; S.init(GROWS, 1024, gdim, bidx);
          pg8::EpiG<FLora> E{FLora{(bf16*)(ws + A_LORAOUT), a.in(I_W0) + L * 2048, a.in(I_A0) + L * 2048, 4096}};
          pg8::gemm_phase<pg8::EpiG<FLora>, pg8::StaticOrder, PG8_ALIGN, PG8_SP2>(C.lds, gm, S, E); }
        { STEP_PTRS; pg8::Gemm gm{(const bf16*)(ws + A_PMLA), (const bf16*)((char*)wb + WO_UQ), GROWS, QW, 512, W_MLA, 512}; pg8::SkewOrder<2, 0, 2> S; S.init(GROWS, QW, gdim, bidx);
          pg8::EpiG<FQ> E{FQ{(bf16*)(ws + A_Q), (const float*)(ws + WS_RSTD), (const float*)(ws + WS_ROPE), (const float*)(ws + WS_ROPE) + SEQ * 32}};
          pg8::gemm_phase<pg8::EpiG<FQ>, pg8::SkewOrder<2, 0, 2>, PG8_ALIGN, PG8_SP2>(C.lds, gm, S, E); }
        { STEP_PTRS; pg8::Gemm gm{(const bf16*)(ws + A_PMLA) + 512, (const bf16*)((char*)wb + WO_UKV), GROWS, 2048, 256, W_MLA, 256}; pg8::SkewOrder<3, 0, 2> S; S.init(GROWS, 2048, gdim, bidx);
          pg8::EpiG<FKV> E{FKV{(bf16*)(ws + A_KF), (bf16*)(ws + A_V), (const float*)(ws + WS_RSTD) + GROWS}};
          pg8::gemm_phase<pg8::EpiG<FKV>, pg8::SkewOrder<3, 0, 2>, PG8_ALIGN, PG8_SP2>(C.lds, gm, S, E); }
        { STEP_PTRS; pg8::Gemm gm{(const bf16*)(ws + A_H), (const bf16*)((char*)wb + WO_IN) + (size_t)(NPROJ - 256) * DM, GROWS, 256, DM, DM, DM}; pg8::SkewOrder<0, 1, 0> S; S.init(GROWS, 256, gdim, bidx);
          pg8::EpiG<FStore> E{FStore{(bf16*)(ws + A_PGATE) + (W_GATE - 256), W_GATE}};
          pg8::gemm_phase<pg8::EpiG<FStore>, pg8::SkewOrder<0, 1, 0>, PG8_ALIGN, PG8_SP2>(C.lds, gm, S, E); } }
        END_STEP(3); }
    if (EN(6) && IN_STEP(4)) { { STEP_PTRS;
        const bool split = (gdim == 256);
        const int xcd = bidx & 7, bi = (bidx >> 3) & 15;
        for (int rp_ = 0; rp_ < (((PROBE_MASK >> 6) & 1) ? 2 : 1); ++rp_)
        for (int pr = bidx; pr < 128; pr += gdim) scan_chain(C, L, pr);
        const int r0 = 0, nr = split ? (bidx < 128 ? 0 : 4) : (512 - bidx + gdim - 1) / gdim;
        for (int k = 0; k < nr * (((PROBE_MASK >> 7) & 1) ? 2 : 1); ++k) {
            const int kk = k % (nr > 0 ? nr : 1);
            int pi, qb;
            if (split) { pi = xcd + 8 * (r0 + kk); qb = bi; } else { const int u = bidx + kk * gdim; pi = u >> 4; qb = u & 15; }
            const int hh = pi & 7, sq = pi >> 3;
            const bf16* Qb = (const bf16*)(ws + A_Q) + ((size_t)sq * SEQ + qb * 256) * QW + hh * 192;
            const bf16* Kh = (const bf16*)(ws + A_KF) + (size_t)sq * SEQ * KFW + hh * 192;
            const bf16* Vh = (const bf16*)(ws + A_V) + (size_t)sq * SEQ * VW + hh * 128;
            bf16* Ob = (bf16*)(ws + A_ATTO) + ((size_t)sq * SEQ + qb * 256) * 1024 + hh * 128;
            att::attn_unit(Qb, Kh, Vh, Ob, SEQ, (LAS char*)C.lds);
        }
        constexpr int NL_ = (GI == NGRP - 1) ? L + 1 : L, NG_ = (GI == NGRP - 1) ? 0 : GI + 1;
        if constexpr (NL_ < NLAYER) {
            constexpr size_t ngrow0 = (size_t)NG_ * GROWS;
            const float* nx = (NL_ == 0) ? ((NG_ < 2) ? a.in(I_XP) + ngrow0 * DM : a.in(I_XS) + (ngrow0 - 32768) * DM) : a.out() + ngrow0 * DM;
            const float* nmodb = mod + ((size_t)NL_ * 12 + NG_ * 4) * NMOD;
            if (split) { if (bidx >= 128) phase_modnorm(C, (bidx - 128) * NWAVES + C.wave, 128 * NWAVES, nx, (bf16*)(ws + A_H), a.in(I_NMIXG) + NL_ * DM, nmodb, 0, 1); }
            else phase_modnorm(C, C.gw, C.ngw, nx, (bf16*)(ws + A_H), a.in(I_NMIXG) + NL_ * DM, nmodb, 0, 1);
        }
        if constexpr (L == NLAYER - 1 && GI >= 1) {
            if (split) { if (bidx >= 128) phase_final(C, (bidx - 128) * NWAVES + C.wave, 128 * NWAVES, (GI - 1) * GROWS, GI * GROWS, a.out(), a.in(I_FNG)); }
            else phase_final(C, C.gw, C.ngw, (GI - 1) * GROWS, GI * GROWS, a.out(), a.in(I_FNG));
        } }
        END_STEP(4); }
    if (EN(7) && IN_STEP(5)) { REPEAT(15) { phase_rwkv_post(C, L); } END_STEP(5); }
    if (EN(8) && IN_STEP(6)) { REPEAT(8) {
        { STEP_PTRS; pg8::Gemm gm{(const bf16*)(ws + A_ATTO), (const bf16*)((char*)wb + WO_OATT), GROWS, DM, 1024, 1024, 1024}; pg8::StaticOrder S; S.init(GROWS, DM, gdim, bidx);
          pg8::EpiG<FMergeA> E{FMergeA{(bf16*)(ws + A_MERGED), (const bf16*)(ws + A_PGATE)}};
          pg8::gemm_phase<pg8::EpiG<FMergeA>, pg8::StaticOrder, PG8_ALIGN, PG8_SP2>(C.lds, gm, S, E); }
        VM_WAIT(); __syncthreads();
        { STEP_PTRS; pg8::Gemm gm{(const bf16*)(ws + A_RWKVO), (const bf16*)((char*)wb + WO_ORWKV), GROWS, DM, 1024, 1024, 1024}; pg8::StaticOrder S; S.init(GROWS, DM, gdim, bidx);
          pg8::EpiG<FMergeB> E{FMergeB{(bf16*)(ws + A_MERGED), (const bf16*)(ws + A_PGATE)}};
          pg8::gemm_phase<pg8::EpiG<FMergeB>, pg8::StaticOrder, PG8_ALIGN, PG8_SP2>(C.lds, gm, S, E); }
          VM_WAIT(); __syncthreads(); }
        END_STEP(6); }
    if (EN(9) && IN_STEP(7)) { _Pragma("unroll") for (int rep_ = 0; rep_ < ((((PROBE_MASK >> 9) & 1) && L == 0) ? 2 : 1); ++rep_) { STEP_PTRS;
        pg8::Gemm gm{(const bf16*)(ws + A_MERGED), (const bf16*)((char*)wb + WO_OUT), GROWS, DM, DM, DM, DM}; pg8::StaticOrder S; S.init(GROWS, DM, gdim, bidx);
        EpiResid E{FResid{xsrc, xout, modb + 2 * DM}};
        pg8::gemm_phase<EpiResid, pg8::StaticOrder, false, PG8_SP2>(C.lds, gm, S, E); }
        END_STEP(7); }
    if (EN(10) && IN_STEP(8)) { REPEAT(10) { STEP_PTRS; phase_modnorm(C, C.gw, C.ngw, xout, (bf16*)(ws + A_H2), a.in(I_NFFNG) + L * DM, modb, 3, 4); } END_STEP(8); }
    if (EN(11) && IN_STEP(9)) { { STEP_PTRS;
        pg8::Gemm gm{(const bf16*)(ws + A_H2), (const bf16*)((char*)wb + WO_UP), GROWS, 2 * DFF, DM, DM, DM}; pg8::StaticOrder S; S.init(GROWS, 2 * DFF, gdim, bidx);
        EpiAct E{(bf16*)(ws + A_ACT), (bf16*)(ws + A_EA), (bf16*)(ws + A_EB), a.in(I_CONVW) + (size_t)L * 3 * DFF, a.in(I_CONVB) + (size_t)L * DFF};
        pg8::gemm_phase<EpiAct, pg8::StaticOrder, PG8_ALIGN, PG8_SP2, true>(C.lds, gm, S, E); }
        END_STEP(9); }
    if (EN(12) && IN_STEP(10)) { phase_act_fix(C, L); END_STEP(10); }
    if (EN(13) && IN_STEP(11)) { { STEP_PTRS;
        pg8::Gemm gm{(const bf16*)(ws + A_ACT), (const bf16*)((char*)wb + WO_DOWN), GROWS, DM, DFF, DFF, DFF}; pg8::StaticOrder S; S.init(GROWS, DM, gdim, bidx);
        EpiResid E{FResid{xout, xout, modb + 5 * DM}};
        pg8::gemm_phase<EpiResid, pg8::StaticOrder, false, PG8_SP2>(C.lds, gm, S, E); }
        if constexpr (GI == NGRP - 1) END_STEP(11);
    }
}
template <int L>
__device__ __forceinline__ void layer_program(const Ctx& C, const int lo, const int hi) {
    constexpr int sbase = 1 + L * (1 + NGRP * NT_STEPS);
    if (EN(1) && IN_STEP(0)) { if constexpr (L > 0) { phase_convert(C, L); END_STEP(0); } }
    group_program<L, 0>(C, lo, hi);
    if constexpr (NG_BUILD > 1) group_program<L, 1>(C, lo, hi);
    if constexpr (NG_BUILD > 2) group_program<L, 2>(C, lo, hi);
}

__global__ void __launch_bounds__(NWAVES * 64, 2) mk_fwd(Args a) {
    extern __shared__ __attribute__((aligned(16))) unsigned char lds_raw[];
    Ctx C;
    C.lds = (LAS unsigned char*)lds_raw;
    C.tid = threadIdx.x; C.lane = C.tid & 63; C.wave = __builtin_amdgcn_readfirstlane(C.tid >> 6);
    C.gw = blockIdx.x * NWAVES + C.wave; C.ngw = gridDim.x * NWAVES;
    for (int u = C.tid; u < (LDS_BYTES - LDSCTL_OFF) / 4; u += NWAVES * 64) ((LAS unsigned*)(C.lds + LDSCTL_OFF))[u] = 0u;
    __syncthreads();
    if (C.tid == 0) {
        LAS unsigned long long* t = (LAS unsigned long long*)(C.lds + ARGTAB_OFF);
#pragma unroll
        for (int i = 0; i < 32; ++i) t[i] = (unsigned long long)a.in[i];
        t[32] = (unsigned long long)a.out; t[33] = (unsigned long long)a.ws;
    }
    __syncthreads();
    const int lo = a.lo, hi = a.hi;
    if (hi - lo > 1) (void)xcd_barrier_post((unsigned*)(a.ws + WS_CTL) + CW_BAR, (volatile LAS unsigned*)(C.lds + MISC_OFF) + 8);
    { constexpr int sbase = 0; if (EN(0) && IN_STEP(0)) { phase_mod(C); __syncthreads(); phase_convert(C, 0); END_STEP(0); } }
    layer_program<0>(C, lo, hi);
    if constexpr (NL_BUILD > 1) layer_program<1>(C, lo, hi);
    { constexpr int sbase = N_STEPS - 1; if (EN(14) && IN_STEP(0)) { const PT p(C); phase_final(C, C.gw, C.ngw, (NGRP - 1) * GROWS, MALL, p.out(), p.in(I_FNG)); } }
}
#undef IN_STEP
#undef END_STEP

extern "C" void kernel_launch(void* const* d_in, const int* in_sizes, int n_in, void* d_out, int out_size, void* d_ws, size_t ws_size, hipStream_t stream) {
    static int grid = 0;
    if (grid == 0) {
        if (n_in != 32 || out_size != MALL * DM || ws_size < WS_NEED) { fprintf(stderr, "kernel_launch: unexpected shapes: n_in %d out %d ws %zu (need %zu)\n", n_in, out_size, ws_size, (size_t)WS_NEED); grid = -1; return; }
        int dev = 0, cus = 0, per_cu = 0;
        if (hipGetDevice(&dev) != hipSuccess || hipDeviceGetAttribute(&cus, hipDeviceAttributeMultiprocessorCount, dev) != hipSuccess) { grid = -1; return; }
        if (hipFuncSetAttribute((const void*)mk_fwd, hipFuncAttributeMaxDynamicSharedMemorySize, LDS_BYTES) != hipSuccess) { fprintf(stderr, "kernel_launch: hipFuncSetAttribute failed\n"); grid = -1; return; }
        if (hipOccupancyMaxActiveBlocksPerMultiprocessor(&per_cu, (const void*)mk_fwd, NWAVES * 64, LDS_BYTES) != hipSuccess || per_cu < 1) fprintf(stderr, "kernel_launch: occupancy query reports %d\n", per_cu);
        (void)hipGetLastError();
        grid = cus;
    }
    if (grid < 0) return;
    if (hipMemsetAsync((char*)d_ws + WS_CTL, 0, CTL_ZERO_BYTES, stream) != hipSuccess) return;
    Args a{};
    for (int i = 0; i < 32; ++i) a.in[i] = (const float*)d_in[i];
    a.out = (float*)d_out; a.ws = (unsigned char*)d_ws;
#if MK_MODE == 1
    a.lo = 0; a.hi = N_STEPS;
    hipLaunchKernelGGL(mk_fwd, dim3(grid), dim3(NWAVES * 64), LDS_BYTES, stream, a);
#else
    for (int s = 0; s < N_STEPS; ++s) { a.lo = s; a.hi = s + 1; hipLaunchKernelGGL(mk_fwd, dim3(grid), dim3(NWAVES * 64), LDS_BYTES, stream, a); }
#endif
}
```
